# Optimizing an MI355X kernel written in HIP

```python
import jax, jax.numpy as jnp
from jax import lax
import numpy as np

D_MODEL = 1024
BATCH = 8
SEQ = 4096
DEPTH = 2

MIX_WIDTH = D_MODEL
MLA_HEADS = 8
MLA_V = (MIX_WIDTH // 2) // MLA_HEADS
MLA_NOPE = 64
MLA_ROPE = 32
MLA_Q_LORA = D_MODEL // 4
MLA_KV_LORA = D_MODEL // 8
FOX_HEADS = 8
FOX_HEAD_DIM = (MIX_WIDTH // 2) // FOX_HEADS
FOX_W = FOX_HEADS * FOX_HEAD_DIM
IN_SPLITS = (MLA_Q_LORA, MLA_KV_LORA, MLA_ROPE, FOX_W, FOX_W, FOX_W, FOX_HEADS)
IN_COLS = sum(IN_SPLITS)
Q_BLOCK = 128
ROPE_THETA = 10000.0
D_FF = D_MODEL * 7 // 2
N_EXPERTS = 8
TOP_K = 2
EPS = 1e-6

kernel_name = "hybrid_mla_fox_adaln_moe_trunk"


def rms_norm(x, g):
    xf = x.astype(jnp.float32)
    y = xf * lax.rsqrt(jnp.mean(xf * xf, axis=-1, keepdims=True) + EPS)
    return (y * g.astype(jnp.float32)).astype(x.dtype)


def rope(x, positions):
    half = x.shape[-1] // 2
    inv_freq = ROPE_THETA ** (-jnp.arange(half, dtype=jnp.float32) / half)
    ang = positions.astype(jnp.float32)[..., None] * inv_freq
    cos, sin = jnp.cos(ang)[:, :, None, :], jnp.sin(ang)[:, :, None, :]
    xf = x.astype(jnp.float32)
    x1, x2 = xf[..., :half], xf[..., half:]
    return jnp.concatenate([x1 * cos - x2 * sin, x1 * sin + x2 * cos], axis=-1).astype(x.dtype)


def causal_block_attention(score_fn, v):
    B, S, H, dv = v.shape
    n_blocks = S // Q_BLOCK
    kpos = jnp.arange(S)

    def one_block(i):
        start = i * Q_BLOCK
        s = score_fn(start)
        qpos = start + jnp.arange(Q_BLOCK)
        s = jnp.where(kpos[None, :] <= qpos[:, None], s, -jnp.inf)
        p = jax.nn.softmax(s, axis=-1)
        return jnp.einsum('bhqk,bkhd->bqhd', p.astype(v.dtype), v)

    out = lax.map(one_block, jnp.arange(n_blocks))
    return out.transpose(1, 0, 2, 3, 4).reshape(B, S, H, dv)


def hybrid_mixer(h, positions, w_in, q_norm_g, w_uq, kv_norm_g, w_ukv,
                 fox_forget_b, mla_out_g, fox_out_g, w_o):
    B, S, _ = h.shape
    proj = h @ w_in
    cuts = [int(v) for v in np.cumsum(IN_SPLITS)[:-1]]
    c_q, c_kv, k_r, f_q, f_k, f_v, f_logit = jnp.split(proj, cuts, axis=-1)

    q = (rms_norm(c_q, q_norm_g) @ w_uq).reshape(B, S, MLA_HEADS, MLA_NOPE + MLA_ROPE)
    q_nope = q[..., :MLA_NOPE]
    q_rope = rope(q[..., MLA_NOPE:], positions)
    kv = (rms_norm(c_kv, kv_norm_g) @ w_ukv).reshape(B, S, MLA_HEADS, MLA_NOPE + MLA_V)
    k_nope, v_mla = kv[..., :MLA_NOPE], kv[..., MLA_NOPE:]
    k_rope = rope(k_r[:, :, None, :], positions)[:, :, 0, :]
    mla_scale = (MLA_NOPE + MLA_ROPE) ** -0.5

    def mla_scores(start):
        qn = lax.dynamic_slice_in_dim(q_nope, start, Q_BLOCK, axis=1)
        qr = lax.dynamic_slice_in_dim(q_rope, start, Q_BLOCK, axis=1)
        s = (jnp.einsum('bqhd,bkhd->bhqk', qn, k_nope, preferred_element_type=jnp.float32)
             + jnp.einsum('bqhr,bkr->bhqk', qr, k_rope, preferred_element_type=jnp.float32))
        return s * mla_scale

    o_mla = causal_block_attention(mla_scores, v_mla).reshape(B, S, MLA_HEADS * MLA_V)

    fq = f_q.reshape(B, S, FOX_HEADS, FOX_HEAD_DIM)
    fk = f_k.reshape(B, S, FOX_HEADS, FOX_HEAD_DIM)
    fv = f_v.reshape(B, S, FOX_HEADS, FOX_HEAD_DIM)
    log_f = jax.nn.log_sigmoid(f_logit.astype(jnp.float32) + fox_forget_b.astype(jnp.float32))
    F = jnp.cumsum(log_f, axis=1).transpose(0, 2, 1)
    fox_scale = FOX_HEAD_DIM ** -0.5

    def fox_scores(start):
        qb = lax.dynamic_slice_in_dim(fq, start, Q_BLOCK, axis=1)
        Fq = lax.dynamic_slice_in_dim(F, start, Q_BLOCK, axis=2)
        s = jnp.einsum('bqhd,bkhd->bhqk', qb, fk, preferred_element_type=jnp.float32)
        return s * fox_scale + Fq[..., None] - F[:, :, None, :]

    o_fox = causal_block_attention(fox_scores, fv).reshape(B, S, FOX_W)

    o = jnp.concatenate([rms_norm(o_mla, mla_out_g), rms_norm(o_fox, fox_out_g)], axis=-1)
    return o @ w_o


def swiglu(h, w_gate, w_up, w_down):
    return (jax.nn.silu(h @ w_gate) * (h @ w_up)) @ w_down


def moe_swiglu(h, router_w, w_gate, w_up, w_down):
    B, S, D = h.shape
    t = h.reshape(B * S, D)
    logits = (t @ router_w).astype(jnp.float32)
    top_v, top_i = lax.top_k(logits, TOP_K)
    top_w = jax.nn.softmax(top_v, axis=-1)
    gates = jnp.sum(jax.nn.one_hot(top_i, N_EXPERTS, dtype=jnp.float32) * top_w[..., None], axis=1)
    gates = gates.astype(t.dtype)
    y = jnp.zeros_like(t)
    for e in range(N_EXPERTS):
        y = y + gates[:, e:e + 1] * swiglu(t, w_gate[e], w_up[e], w_down[e])
    return y.reshape(B, S, D)


def modulate(h, shift, scale):
    return h * (1 + scale[:, None, :]) + shift[:, None, :]


def setup_inputs(seed: int = 0) -> dict:
    key = jax.random.key(seed)
    ks = jax.random.split(key, 24)
    L, LD, LM = DEPTH, (DEPTH + 1) // 2, DEPTH // 2
    D, F, E = D_MODEL, D_FF, N_EXPERTS

    def nrm(k, shape, scale):
        return jax.random.normal(k, shape, jnp.float32) * scale

    def gain(k, shape):
        return 1.0 + 0.05 * jax.random.normal(k, shape, jnp.float32)

    positions = (jnp.arange(SEQ, dtype=jnp.int32)[None, :]
                 + jax.random.randint(ks[2], (BATCH, 1), 0, 1024, dtype=jnp.int32))
    return {
        "x": nrm(ks[0], (BATCH, SEQ, D), 1.0),
        "c": nrm(ks[1], (BATCH, D), 1.0),
        "positions": positions,
        "ada_w": nrm(ks[3], (L, D, 6 * D), 0.5 * D ** -0.5),
        "ada_b": nrm(ks[4], (L, 6 * D), 0.02),
        "attn_norm_g": gain(ks[5], (L, D)),
        "w_in": nrm(ks[6], (L, D, IN_COLS), D ** -0.5),
        "q_norm_g": gain(ks[7], (L, MLA_Q_LORA)),
        "w_uq": nrm(ks[8], (L, MLA_Q_LORA, MLA_HEADS * (MLA_NOPE + MLA_ROPE)), MLA_Q_LORA ** -0.5),
        "kv_norm_g": gain(ks[9], (L, MLA_KV_LORA)),
        "w_ukv": nrm(ks[10], (L, MLA_KV_LORA, MLA_HEADS * (MLA_NOPE + MLA_V)), MLA_KV_LORA ** -0.5),
        "fox_forget_b": jax.random.uniform(ks[11], (L, FOX_HEADS), jnp.float32, 1.0, 4.0),
        "mla_out_g": gain(ks[12], (L, MLA_HEADS * MLA_V)),
        "fox_out_g": gain(ks[13], (L, FOX_W)),
        "w_o": nrm(ks[14], (L, MIX_WIDTH, D), MIX_WIDTH ** -0.5),
        "ffn_norm_g": gain(ks[15], (L, D)),
        "dense_w_gate": nrm(ks[16], (LD, D, F), D ** -0.5),
        "dense_w_up": nrm(ks[17], (LD, D, F), D ** -0.5),
        "dense_w_down": nrm(ks[18], (LD, F, D), F ** -0.5),
        "router_w": nrm(ks[19], (LM, D, E), D ** -0.5),
        "moe_w_gate": nrm(ks[20], (LM, E, D, F), D ** -0.5),
        "moe_w_up": nrm(ks[21], (LM, E, D, F), D ** -0.5),
        "moe_w_down": nrm(ks[22], (LM, E, F, D), F ** -0.5),
        "final_norm_g": gain(ks[23], (D,)),
    }


def reference(x, c, positions, ada_w, ada_b, attn_norm_g, w_in, q_norm_g, w_uq,
              kv_norm_g, w_ukv, fox_forget_b, mla_out_g, fox_out_g, w_o, ffn_norm_g,
              dense_w_gate, dense_w_up, dense_w_down, router_w, moe_w_gate, moe_w_up,
              moe_w_down, final_norm_g):
    c_act = jax.nn.silu(c)
    for l in range(DEPTH):
        mod = c_act @ ada_w[l] + ada_b[l]
        sh_a, sc_a, g_a, sh_f, sc_f, g_f = jnp.split(mod, 6, axis=-1)
        h = modulate(rms_norm(x, attn_norm_g[l]), sh_a, sc_a)
        mix = hybrid_mixer(h, positions, w_in[l], q_norm_g[l], w_uq[l], kv_norm_g[l],
                           w_ukv[l], fox_forget_b[l], mla_out_g[l], fox_out_g[l], w_o[l])
        x = x + g_a[:, None, :] * mix
        h = modulate(rms_norm(x, ffn_norm_g[l]), sh_f, sc_f)
        j = l // 2
        if l % 2 == 0:
            f = swiglu(h, dense_w_gate[j], dense_w_up[j], dense_w_down[j])
        else:
            f = moe_swiglu(h, router_w[j], moe_w_gate[j], moe_w_up[j], moe_w_down[j])
        x = x + g_f[:, None, :] * f
    return rms_norm(x, final_norm_g)
```

```cpp
#include <hip/hip_runtime.h>
#include <cstdio>
#include <cstdint>
#include <cmath>

#ifndef MK_ONE_LAUNCH
#define MK_ONE_LAUNCH 1
#endif

#define GAS __attribute__((address_space(1)))
#define LAS __attribute__((address_space(3)))
typedef unsigned short bf16;
typedef unsigned v4u __attribute__((ext_vector_type(4)));
typedef unsigned v2u __attribute__((ext_vector_type(2)));
typedef float f32x4 __attribute__((ext_vector_type(4)));
typedef float f32x2 __attribute__((ext_vector_type(2)));
typedef short bf16x8 __attribute__((ext_vector_type(8)));
typedef GAS unsigned gu32;
typedef int v8i __attribute__((ext_vector_type(8)));
typedef int v4i __attribute__((ext_vector_type(4)));
typedef v8i v8i_a16 __attribute__((aligned(16)));

constexpr int NB = 8, SEQ = 4096, DM = 1024, M = NB * SEQ, NH = 8, FF = 3584, NE = 8;
constexpr int INC = 2048;
constexpr int PA_P = 512, QM_P = 768, KM_P = 768, VM_P = 512, QF_P = 640, KF_P = 640, VF_P = 512, O_P = 1024;
constexpr float LOG2E = 1.4426950408889634f;
constexpr float C2M = 0.10206207261596575f * LOG2E;
constexpr float C2F = 0.125f * LOG2E;
constexpr float EPS = 1e-6f;

constexpr size_t MiB = 1u << 20;
constexpr size_t WS_CTL = 0, CTL_ZERO_BYTES = 1 * MiB;
constexpr size_t WS_MOD = 1 * MiB;
constexpr size_t WS_WIN = 4 * MiB, WS_WUQ = 12 * MiB, WS_WUKV = 13 * MiB, WS_WO = 14 * MiB, WS_WGU0 = 18 * MiB, WS_WD0 = 32 * MiB;
constexpr size_t WS_XN = 40 * MiB;
constexpr size_t WS_R = 104 * MiB;
constexpr size_t WS_PA = WS_R, WS_CQN = 168 * MiB, WS_CKVN = 184 * MiB, WS_QM = 200 * MiB, WS_KM = 248 * MiB, WS_VM = 296 * MiB,
                 WS_QF = 328 * MiB, WS_KF = 368 * MiB, WS_VF = 408 * MiB, WS_O = 440 * MiB, WS_ROPE = 504 * MiB;
constexpr size_t WS_SSQQ = WS_PA, WS_SSQKV = WS_PA + 1 * MiB, WS_FLOG = WS_PA + 2 * MiB, WS_SSQO = WS_PA + 4 * MiB;
constexpr size_t WS_H0 = WS_R;
constexpr size_t WS_WGU8 = WS_R, WS_WD8 = 160 * MiB, WS_H8 = 192 * MiB;
constexpr size_t WS_XN8 = WS_XN;
constexpr int MOE_MAXTILE = 136, MOE_MAXROW = MOE_MAXTILE * 256;
constexpr size_t H8_ROUND = (size_t)MOE_MAXROW * FF;
constexpr float SC_WGU = 32.f, SC_WD = 64.f, SC_H = 4.f;
constexpr size_t WS_T1 = 200 * MiB, WS_T2 = 328 * MiB;
constexpr size_t WS_YP = WS_R;
constexpr size_t WS_Y = 432 * MiB;
constexpr size_t WS_RT = 570 * MiB;
constexpr size_t WS_ROWTOK = WS_RT, WS_TOKSLOT = WS_RT + 512 * 1024, WS_TOKE = WS_RT + 1024 * 1024, WS_TOKW = WS_RT + 1280 * 1024, WS_CNT = WS_RT + 1536 * 1024, WS_TEXP = WS_RT + 1600 * 1024;
constexpr size_t WS_END = 572 * MiB;
constexpr int LCNT_OFF = 126976;
constexpr int CW_BAR = 4096;

constexpr int RING_BYTES = 131072;
constexpr int LDSCTL_OFF = RING_BYTES, MISC_OFF = LDSCTL_OFF + 320;
constexpr int LDS_BYTES = 147456;
constexpr int NWAVES = 8;

#define LDS_WAIT() asm volatile("s_waitcnt lgkmcnt(0)" ::: "memory")
#define VM_WAIT() asm volatile("s_waitcnt vmcnt(0)" ::: "memory")
__device__ __forceinline__ unsigned f2bf(float f) { unsigned u = __builtin_bit_cast(unsigned, f); return (u + 0x7fffu + ((u >> 16) & 1u)) >> 16; }
__device__ __forceinline__ unsigned pk2(float lo, float hi) { return f2bf(lo) | (f2bf(hi) << 16); }
__device__ __forceinline__ float bf2f(unsigned h) { return __builtin_bit_cast(float, h << 16); }
__device__ __forceinline__ float wave_sum(float v) {
#pragma unroll
    for (int o = 1; o < 64; o <<= 1) v += __shfl_xor(v, o);
    return v;
}

namespace pg8 {
#define PG8_LAS __attribute__((address_space(3)))
typedef unsigned short bf16_t;
typedef unsigned u32x4 __attribute__((ext_vector_type(4)));
constexpr int BM = 256, BK = 64, HALF = 128, HTB = HALF * BK * 2, STAGE_BYTES = 8 * HTB, NXCD = 8, WGM = 8;

__host__ __device__ __forceinline__ int lds_byte(int r, int c) { const int st = (r >> 4) * 2 + (c >> 5), rr = r & 15, cc = c & 31, ob = rr * 64 + cc * 2; return st * 1024 + (ob ^ (((ob >> 9) & 1) << 5)); }
__host__ __device__ __forceinline__ void stage_rc(int b, int& R, int& C) { const int st = b / 1024, sb = b % 1024, swz = sb ^ (((sb >> 9) & 1) << 5); R = (st >> 1) * 16 + swz / 64; C = (st & 1) * 32 + (swz % 64) / 2; }
__host__ __device__ __forceinline__ int perm32(int rho) { const int n = rho >> 4, i = rho & 15; return 8 * (i >> 2) + 4 * n + (i & 3); }

struct Unit { int pm, pn, bsel, part, nt; };
struct Gemm { const bf16_t* A; const bf16_t* Bt; int K; size_t bstride; const int* rowidx; };

struct StaticOrder {
    int nM, nN, nwg, G, c;
    __host__ __device__ void init(int M_, int N_, int G_, int c_) { nM = M_ / BM; nN = N_ / BM; nwg = nM * nN; G = G_; c = c_; }
    __host__ __device__ bool next(int i, Unit& u) const {
        const long L = (long)i * G + c; if (L >= nwg) return false;
        int wgid = (int)L; { const int q = nwg / NXCD, r = nwg % NXCD, xcd = wgid % NXCD, off = wgid / NXCD; wgid = (xcd < r ? xcd * (q + 1) : r * (q + 1) + (xcd - r) * q) + off; }
        const int nig = WGM * nN, gid = wgid / nig, fm = gid * WGM, gsz = (nM - fm) < WGM ? (nM - fm) : WGM;
        u.pm = fm + ((wgid % nig) % gsz); u.pn = (wgid % nig) / gsz; u.bsel = 0; u.part = 0; u.nt = 0; return true;
    }
};

__device__ __forceinline__ unsigned cvt_pk_bf16(float lo, float hi) { unsigned r; asm volatile("v_cvt_pk_bf16_f32 %0, %1, %2" : "=v"(r) : "v"(lo), "v"(hi)); return r; }

template <class Epi, class Sched, bool ALIGN_EPI = false, bool SP2 = false, bool GATHER = false, bool F8 = false, bool SPLITK = false>
__device__ __forceinline__ void gemm_phase(PG8_LAS unsigned char* lds, const Gemm g, const Sched& S, const Epi& E) {
    int tid_ = threadIdx.x; asm volatile("" : "+v"(tid_));
    const int tid = tid_, wid = __builtin_amdgcn_readfirstlane(tid >> 6), lane = tid & 63, wr = wid >> 2, wc = wid & 3, fr = lane & 15, fq = lane >> 4;
    const int K = g.K, nt = K / BK;
    unsigned voffA[2], voffB[2];
#pragma unroll
    for (int i = 0; i < 2; ++i) { int R, C; stage_rc(tid * 16 + i * 8192, R, C); const int Rb = Epi::PERM ? ((R & ~31) + perm32(R & 31)) : R;
        voffA[i] = (unsigned)(R * K + C) * 2u; voffB[i] = (unsigned)(Rb * K + C) * 2u; }
    asm volatile("" : "+v"(voffA[0]), "+v"(voffA[1]), "+v"(voffB[0]), "+v"(voffB[1]));
    const size_t kstep = (size_t)(BK * 2);
    const size_t hstep = (size_t)HALF * K * 2;
    const size_t tstep = 2 * hstep;
    const unsigned ldsw = (unsigned)wid * 1024u;
    int aoff = lds_byte(wr * 64 + fr, F8 ? fq * 16 : fq * 8), boff = lds_byte(wc * 32 + fr, F8 ? fq * 16 : fq * 8);
    asm volatile("" : "+v"(aoff), "+v"(boff));
#define PG8_SA(b, h) (((b) * 2 + (h)) * HTB)
#define PG8_SB(b, h) ((4 + (b) * 2 + (h)) * HTB)
#define PG8_STAGE(bufoff, gbase, voff) do { _Pragma("unroll") for (int _i = 0; _i < 2; ++_i) \
        __builtin_amdgcn_global_load_lds((const unsigned*)((const char*)(gbase) + (voff)[_i]), (PG8_LAS unsigned*)(lds + (bufoff) + ldsw + _i * 8192), 16, 0, 0); } while (0)
    unsigned gofC[2][2] = {{0u, 0u}, {0u, 0u}}, gofN[2][2] = {{0u, 0u}, {0u, 0u}}; int gR[2] = {0, 0}; unsigned gC[2] = {0u, 0u};
    if constexpr (GATHER) {
#pragma unroll
        for (int i = 0; i < 2; ++i) { int R, C; stage_rc(tid * 16 + i * 8192, R, C); gR[i] = R; gC[i] = (unsigned)C * 2u; }
        asm volatile("" : "+v"(gR[0]), "+v"(gR[1]), "+v"(gC[0]), "+v"(gC[1]));
    }
#define PG8_GOF(dst, unit) do { _Pragma("unroll") for (int _h = 0; _h < 2; ++_h) _Pragma("unroll") for (int _i = 0; _i < 2; ++_i) { int _t = g.rowidx[(unit).pm * BM + _h * HALF + gR[_i]]; _t = _t < 0 ? 0 : _t; \
        dst[_h][_i] = (unsigned)_t * (unsigned)(K * 2) + gC[_i]; } } while (0)
#define PG8_GTOK(dst, unit) do { _Pragma("unroll") for (int _h = 0; _h < 2; ++_h) _Pragma("unroll") for (int _i = 0; _i < 2; ++_i) dst[_h][_i] = (unsigned)g.rowidx[(unit).pm * BM + _h * HALF + gR[_i]]; } while (0)
#define PG8_GCVT(dst) do { _Pragma("unroll") for (int _h = 0; _h < 2; ++_h) _Pragma("unroll") for (int _i = 0; _i < 2; ++_i) { int _t = (int)dst[_h][_i]; _t = _t < 0 ? 0 : _t; dst[_h][_i] = (unsigned)_t * (unsigned)(K * 2) + gC[_i]; } } while (0)
#define PG8_STAGE_A(bufoff, tptr, h, kb, nx) do { if constexpr (GATHER) { _Pragma("unroll") for (int _i = 0; _i < 2; ++_i) { const unsigned _o = (nx) ? gofN[h][_i] : gofC[h][_i]; \
        __builtin_amdgcn_global_load_lds((const unsigned*)((const char*)g.A + (kb) + _o), (PG8_LAS unsigned*)(lds + (bufoff) + ldsw + _i * 8192), 16, 0, 0); } } \
        else PG8_STAGE(bufoff, (tptr) + (h) * hstep, voffA); } while (0)
#define PG8_LDA(dst, b, h) do { if constexpr (F8) { _Pragma("unroll") for (int m = 0; m < 4; ++m) dst##8[m] = *(const PG8_LAS v8i_a16*)(lds + PG8_SA(b, h) + aoff + m * 2048); } \
        else { _Pragma("unroll") for (int m = 0; m < 4; ++m) _Pragma("unroll") for (int k = 0; k < 2; ++k) dst[m][k] = *(const PG8_LAS bf16x8*)(lds + PG8_SA(b, h) + aoff + m * 2048 + k * 1024); } } while (0)
#define PG8_LDB(dst, b, h) do { if constexpr (F8) { _Pragma("unroll") for (int n = 0; n < 2; ++n) dst##8[n] = *(const PG8_LAS v8i_a16*)(lds + PG8_SB(b, h) + boff + n * 2048); } \
        else { _Pragma("unroll") for (int n = 0; n < 2; ++n) _Pragma("unroll") for (int k = 0; k < 2; ++k) dst[n][k] = *(const PG8_LAS bf16x8*)(lds + PG8_SB(b, h) + boff + n * 2048 + k * 1024); } } while (0)
#define PG8_MMA(ai, bj, At, Bt) do { __builtin_amdgcn_s_setprio(1); if constexpr (F8) { _Pragma("unroll") for (int m = 0; m < 4; ++m) _Pragma("unroll") for (int n = 0; n < 2; ++n) \
            asm volatile("v_mfma_scale_f32_16x16x128_f8f6f4 %0, %1, %2, %0, %3, %4 op_sel_hi:[0,0,0]" : "+v"(acc[ai][bj][m][n]) : "v"(Bt##8[n]), "v"(At##8[m]), "v"((bj) == 0 ? f8scl : f8scl1), "v"(f8one)); } \
        else { _Pragma("unroll") for (int m = 0; m < 4; ++m) _Pragma("unroll") for (int n = 0; n < 2; ++n) _Pragma("unroll") for (int k = 0; k < 2; ++k) \
            acc[ai][bj][m][n] = __builtin_amdgcn_mfma_f32_16x16x32_bf16(Bt[n][k], At[m][k], acc[ai][bj][m][n], 0, 0, 0); } __builtin_amdgcn_s_setprio(0); } while (0)
#define PG8_WAIT_V(n) asm volatile("s_waitcnt vmcnt(" #n ")" ::: "memory")
#define PG8_WAIT_L(n) asm volatile("s_waitcnt lgkmcnt(" #n ")" ::: "memory")
#define PG8_WAIT_V8P(post) do { if (post) asm volatile("s_waitcnt vmcnt(%0)" :: "n"(8 + Epi::NS) : "memory"); else asm volatile("s_waitcnt vmcnt(8)" ::: "memory"); } while (0)
#define PG8_BAR __builtin_amdgcn_s_barrier()
#define PG8_SCHED __builtin_amdgcn_sched_barrier(0)
    Unit cur, nxt; int ui = 0;
    if (!S.next(0, cur)) return;
    f32x4 acc[2][2][4][2];
#pragma unroll
    for (int a = 0; a < 2; ++a)
#pragma unroll
        for (int b = 0; b < 2; ++b)
#pragma unroll
            for (int m = 0; m < 4; ++m)
#pragma unroll
                for (int n = 0; n < 2; ++n) acc[a][b][m][n] = (f32x4){0.f, 0.f, 0.f, 0.f};
    bf16x8 At[4][2], B0[2][2], B1[2][2]; v8i At8[4], B08[2], B18[2];
    int f8scl = 0x7F7F7F7F, f8scl1 = 0x7F7F7F7F, f8one = 0x7F7F7F7F;
    if constexpr (F8) { f8scl = Epi::SCL0; f8scl1 = Epi::SCL1; }
    asm volatile("" : "+v"(f8scl), "+v"(f8scl1), "+v"(f8one));
    int ntc = nt; size_t kofc = 0;
    if constexpr (SPLITK) { ntc = cur.nt; kofc = (size_t)(cur.part * cur.nt) * kstep; }
    const char* cA = (const char*)g.A + (size_t)cur.pm * tstep + kofc; const char* cB = (const char*)g.Bt + (size_t)cur.bsel * g.bstride + (size_t)cur.pn * tstep + kofc;
    if constexpr (GATHER) { PG8_GOF(gofC, cur); }
    if constexpr (SP2) {
        PG8_STAGE(PG8_SB(0, 0), cB, voffB); PG8_STAGE(PG8_SB(0, 1), cB + hstep, voffB); PG8_STAGE_A(PG8_SA(0, 0), cA, 0, 0, false); PG8_STAGE_A(PG8_SA(0, 1), cA, 1, 0, false);
        if (wr == 1) PG8_BAR;
        PG8_WAIT_V(2); PG8_BAR;
        PG8_STAGE(PG8_SB(1, 0), cB + kstep, voffB); PG8_STAGE_A(PG8_SA(1, 0), cA + kstep, 0, kstep, false); PG8_STAGE(PG8_SB(1, 1), cB + hstep + kstep, voffB);
        PG8_WAIT_V(6); PG8_BAR;
    } else {
        PG8_STAGE(PG8_SB(0, 0), cB, voffB); PG8_STAGE(PG8_SA(0, 0), cA, voffA); PG8_STAGE(PG8_SB(0, 1), cB + hstep, voffB); PG8_STAGE(PG8_SA(0, 1), cA + hstep, voffA);
        if (wr == 1) PG8_BAR;
        PG8_WAIT_V(4); PG8_BAR;
        PG8_STAGE(PG8_SB(1, 0), cB + kstep, voffB); PG8_STAGE(PG8_SA(1, 0), cA + kstep, voffA); PG8_STAGE(PG8_SB(1, 1), cB + hstep + kstep, voffB);
        PG8_WAIT_V(6); PG8_BAR;
    }
    for (;;) {
        const bool has_next = S.next(ui + 1, nxt);
        if constexpr (GATHER) { if (has_next) { PG8_GTOK(gofN, nxt); } }
        size_t kofn = 0; if constexpr (SPLITK) { if (has_next) kofn = (size_t)(nxt.part * nxt.nt) * kstep; }
        const char* nA = has_next ? (const char*)g.A + (size_t)nxt.pm * tstep + kofn : cA; const char* nB = has_next ? (const char*)g.Bt + (size_t)nxt.bsel * g.bstride + (size_t)nxt.pn * tstep + kofn : cB;
#pragma unroll 1
        for (int t = 0; t < ntc; t += 2) {
            const bool last = (t == ntc - 2);
            const char* a1 = cA + (size_t)(t + 1) * kstep;
            const char* a2 = last ? nA : cA + (size_t)(t + 2) * kstep; const char* b2 = last ? nB : cB + (size_t)(t + 2) * kstep;
            const char* a3 = a2 + kstep; const char* b3 = b2 + kstep;
            if constexpr (GATHER) { if (last && has_next) { PG8_GCVT(gofN); } }
            if constexpr (Epi::MID) { if (t == nt / 2) E.mid(acc, cur, wr, wc, fr, fq); }
            const size_t k1 = (size_t)(t + 1) * kstep, k2 = last ? (size_t)0 : (size_t)(t + 2) * kstep, k3 = k2 + kstep; const bool nx = last && has_next;
            if constexpr (SP2) {
            const bool post = (t == 0) && (ui > 0);
            PG8_LDB(B0, 0, 0); PG8_LDB(B1, 0, 1); PG8_SCHED; PG8_LDA(At, 0, 0); PG8_STAGE_A(PG8_SA(1, 1), a1, 1, k1, false);
            PG8_WAIT_V8P(post); PG8_WAIT_L(0); PG8_BAR; PG8_MMA(0, 0, At, B0); PG8_MMA(0, 1, At, B1); PG8_BAR; PG8_SCHED;
            PG8_LDA(At, 0, 1); PG8_STAGE(PG8_SB(0, 0), b2, voffB); PG8_STAGE(PG8_SB(0, 1), b2 + hstep, voffB); PG8_STAGE_A(PG8_SA(0, 0), a2, 0, k2, nx);
            PG8_WAIT_V8P(post); PG8_WAIT_L(0); PG8_BAR; PG8_MMA(1, 0, At, B0); PG8_MMA(1, 1, At, B1); PG8_BAR; PG8_SCHED;
            PG8_LDB(B0, 1, 0); PG8_LDB(B1, 1, 1); PG8_SCHED; PG8_LDA(At, 1, 0); PG8_STAGE_A(PG8_SA(0, 1), a2, 1, k2, nx);
            PG8_WAIT_V(8); PG8_WAIT_L(0); PG8_BAR; PG8_MMA(0, 0, At, B0); PG8_MMA(0, 1, At, B1); PG8_BAR; PG8_SCHED;
            PG8_LDA(At, 1, 1); PG8_STAGE(PG8_SB(1, 0), b3, voffB); PG8_STAGE(PG8_SB(1, 1), b3 + hstep, voffB); PG8_STAGE_A(PG8_SA(1, 0), a3, 0, k3, nx);
            PG8_WAIT_V(8); PG8_WAIT_L(0); PG8_BAR; PG8_MMA(1, 0, At, B0); PG8_MMA(1, 1, At, B1); PG8_BAR; PG8_SCHED;
            } else {
            static_assert(!GATHER || SP2, "GATHER is wired into the SP2 loop only");
            PG8_LDB(B0, 0, 0); PG8_SCHED; PG8_LDA(At, 0, 0); PG8_STAGE(PG8_SA(1, 1), a1 + hstep, voffA);
            PG8_WAIT_L(8); PG8_BAR; PG8_WAIT_L(0); PG8_MMA(0, 0, At, B0); PG8_BAR; PG8_SCHED;
            PG8_LDB(B1, 0, 1); PG8_STAGE(PG8_SB(0, 0), b2, voffB);
            PG8_BAR; PG8_WAIT_L(0); PG8_MMA(0, 1, At, B1); PG8_BAR;
            PG8_LDA(At, 0, 1); PG8_STAGE(PG8_SA(0, 0), a2, voffA);
            PG8_BAR; PG8_WAIT_L(0); PG8_MMA(1, 0, At, B0); PG8_BAR; PG8_SCHED;
            PG8_STAGE(PG8_SB(0, 1), b2 + hstep, voffB);
            PG8_WAIT_V(6); PG8_BAR; PG8_MMA(1, 1, At, B1); PG8_BAR;
            PG8_LDB(B0, 1, 0); PG8_SCHED; PG8_LDA(At, 1, 0); PG8_STAGE(PG8_SA(0, 1), a2 + hstep, voffA);
            PG8_WAIT_L(8); PG8_BAR; PG8_WAIT_L(0); PG8_MMA(0, 0, At, B0); PG8_BAR; PG8_SCHED;
            PG8_LDB(B1, 1, 1); PG8_STAGE(PG8_SB(1, 0), b3, voffB);
            PG8_BAR; PG8_WAIT_L(0); PG8_MMA(0, 1, At, B1); PG8_BAR;
            PG8_LDA(At, 1, 1); PG8_STAGE(PG8_SA(1, 0), a3, voffA);
            PG8_BAR; PG8_WAIT_L(0); PG8_MMA(1, 0, At, B0); PG8_BAR; PG8_SCHED;
            PG8_STAGE(PG8_SB(1, 1), b3 + hstep, voffB);
            PG8_WAIT_V(6); PG8_BAR; PG8_MMA(1, 1, At, B1); PG8_BAR;
            }
        }
        if constexpr (ALIGN_EPI) { if (wr == 0) PG8_BAR; }
        if constexpr (F8) asm volatile("s_nop 15\n\ts_nop 15" ::: "memory");
        E(acc, cur, wr, wc, fr, fq);
        if (!has_next) break;
#pragma unroll
        for (int a = 0; a < 2; ++a)
#pragma unroll
            for (int b = 0; b < 2; ++b)
#pragma unroll
                for (int m = 0; m < 4; ++m)
#pragma unroll
                    for (int n = 0; n < 2; ++n) acc[a][b][m][n] = (f32x4){0.f, 0.f, 0.f, 0.f};
        cur = nxt; cA = nA; cB = nB; ++ui; if constexpr (SPLITK) ntc = cur.nt;
        if constexpr (GATHER) { _Pragma("unroll") for (int _h = 0; _h < 2; ++_h) _Pragma("unroll") for (int _i = 0; _i < 2; ++_i) gofC[_h][_i] = gofN[_h][_i]; }
        if constexpr (ALIGN_EPI) { if (wr == 1) PG8_BAR; }
    }
    PG8_WAIT_V(0);
    if constexpr (!ALIGN_EPI) { if (wr == 0) PG8_BAR; }
    PG8_BAR;
#undef PG8_SA
#undef PG8_SB
#undef PG8_STAGE
#undef PG8_STAGE_A
#undef PG8_GOF
#undef PG8_GTOK
#undef PG8_GCVT
#undef PG8_LDA
#undef PG8_LDB
#undef PG8_MMA
#undef PG8_WAIT_V
#undef PG8_WAIT_L
#undef PG8_WAIT_V8P
#undef PG8_BAR
#undef PG8_SCHED
}

#define EPI_ROWS(...) _Pragma("unroll") for (int ai = 0; ai < 2; ++ai) _Pragma("unroll") for (int m = 0; m < 4; ++m) { const int row = row0 + ai * HALF + m * 16; \
        _Pragma("unroll") for (int bj = 0; bj < 2; ++bj) { const int c = bj * HALF + wc * 32 + 8 * fq; f32x4 v0 = acc[ai][bj][m][0], v1 = acc[ai][bj][m][1]; __VA_ARGS__ } }
__device__ __forceinline__ u32x4 pack8(f32x4 v0, f32x4 v1) { u32x4 w; w.x = cvt_pk_bf16(v0[0], v0[1]); w.y = cvt_pk_bf16(v0[2], v0[3]); w.z = cvt_pk_bf16(v1[0], v1[1]); w.w = cvt_pk_bf16(v1[2], v1[3]); return w; }

__device__ __forceinline__ float ssq8(f32x4 a, f32x4 b) { return (a[0] * a[0] + a[1] * a[1]) + (a[2] * a[2] + a[3] * a[3]) + (b[0] * b[0] + b[1] * b[1]) + (b[2] * b[2] + b[3] * b[3]); }
struct EpiInproj { static constexpr bool PERM = true; static constexpr bool MID = false; static constexpr int NS = 16;
    bf16_t *CQ, *CKV, *KM; float *SSQQ, *SSQKV, *FLOG; const float* ROPE; bf16_t *QF, *KF, *VF;
    __device__ __forceinline__ void operator()(const f32x4 (&acc)[2][2][4][2], const Unit& u, int wr, int wc, int fr, int fq) const {
        const int row0 = u.pm * BM + wr * 64 + fr;
        if (u.pn == 0) {
#pragma unroll
            for (int ai = 0; ai < 2; ++ai)
#pragma unroll
                for (int m = 0; m < 4; ++m) { const int row = row0 + ai * HALF + m * 16; float ss = 0.f;
#pragma unroll
                    for (int bj = 0; bj < 2; ++bj) { const int c = bj * HALF + wc * 32 + 8 * fq; const f32x4 v0 = acc[ai][bj][m][0], v1 = acc[ai][bj][m][1];
                        *(u32x4*)(CQ + (size_t)row * 256 + c) = pack8(v0, v1); ss += ssq8(v0, v1); }
                    ss += __shfl_xor(ss, 16); ss += __shfl_xor(ss, 32);
                    if (fq == 0) SSQQ[(size_t)row * 4 + wc] = ss; }
        } else if (u.pn == 1) {
#pragma unroll
            for (int ai = 0; ai < 2; ++ai)
#pragma unroll
                for (int m = 0; m < 4; ++m) { const int row = row0 + ai * HALF + m * 16; const int c = wc * 32 + 8 * fq;
                    { const f32x4 v0 = acc[ai][0][m][0], v1 = acc[ai][0][m][1]; *(u32x4*)(CKV + (size_t)row * 128 + c) = pack8(v0, v1);
                      float ss = ssq8(v0, v1); ss += __shfl_xor(ss, 16); ss += __shfl_xor(ss, 32); if (fq == 0) SSQKV[(size_t)row * 4 + wc] = ss; }
                    const f32x4 v0 = acc[ai][1][m][0], v1 = acc[ai][1][m][1];
                    if (wc == 0) { const f32x4* rp = (const f32x4*)(ROPE + (size_t)row * 32 + 8 * fq); const f32x4 r0 = rp[0], r1 = rp[1]; f32x4 o0, o1;
                        o0[0] = v0[0] * r0[0] - v0[1] * r0[1]; o0[1] = v0[0] * r0[1] + v0[1] * r0[0]; o0[2] = v0[2] * r0[2] - v0[3] * r0[3]; o0[3] = v0[2] * r0[3] + v0[3] * r0[2];
                        o1[0] = v1[0] * r1[0] - v1[1] * r1[1]; o1[1] = v1[0] * r1[1] + v1[1] * r1[0]; o1[2] = v1[2] * r1[2] - v1[3] * r1[3]; o1[3] = v1[2] * r1[3] + v1[3] * r1[2];
                        const u32x4 w = pack8(o0, o1);
#pragma unroll
                        for (int h = 0; h < 8; ++h) *(u32x4*)(KM + (size_t)row * KM_P + h * 96 + 64 + 8 * fq) = w; }
                    else if (wc == 1 && fq == 0) { float* p = FLOG + (size_t)row * 8; *(f32x4*)p = v0; *(f32x4*)(p + 4) = v1; } }
        } else {
            const int grp = (u.pn >> 1) - 1, cb = (u.pn & 1) * 256;
            if (grp == 0)      { EPI_ROWS( const int cc = cb + c; v0 = v0 * C2F; v1 = v1 * C2F; *(u32x4*)(QF + (size_t)row * QF_P + (cc >> 6) * 80 + (cc & 63)) = pack8(v0, v1); ) }
            else if (grp == 1) { EPI_ROWS( const int cc = cb + c; *(u32x4*)(KF + (size_t)row * KF_P + (cc >> 6) * 80 + (cc & 63)) = pack8(v0, v1); ) }
            else               { EPI_ROWS( const int cc = cb + c; *(u32x4*)(VF + (size_t)row * VF_P + cc) = pack8(v0, v1); ) }
        }
    }
};
struct EpiQ { static constexpr bool PERM = true; static constexpr bool MID = false; static constexpr int NS = 16;
    bf16_t* QM; const float* ROPE; const float* SSQ;
    __device__ __forceinline__ float rs(int row) const { const f32x4 p = *(const f32x4*)(SSQ + (size_t)row * 4); return C2M / sqrtf(((p[0] + p[1]) + (p[2] + p[3])) * (1.f / 256.f) + EPS); }
    __device__ __forceinline__ void operator()(const f32x4 (&acc)[2][2][4][2], const Unit& u, int wr, int wc, int fr, int fq) const {
        const int row0 = u.pm * BM + wr * 64 + fr;
        if (u.pn < 2) {
            EPI_ROWS( const int cc = u.pn * 256 + c; const float C2M = rs(row); v0 = v0 * C2M; v1 = v1 * C2M; *(u32x4*)(QM + (size_t)row * QM_P + (cc >> 6) * 96 + (cc & 63)) = pack8(v0, v1); )
        } else {
            EPI_ROWS( const int h = c >> 5, p0 = c & 31; const float C2M = rs(row); const f32x4* rp = (const f32x4*)(ROPE + (size_t)row * 32 + p0);
                const f32x4 r0 = rp[0], r1 = rp[1]; f32x4 o0, o1;
                o0[0] = v0[0] * r0[0] - v0[1] * r0[1]; o0[1] = v0[0] * r0[1] + v0[1] * r0[0]; o0[2] = v0[2] * r0[2] - v0[3] * r0[3]; o0[3] = v0[2] * r0[3] + v0[3] * r0[2];
                o1[0] = v1[0] * r1[0] - v1[1] * r1[1]; o1[1] = v1[0] * r1[1] + v1[1] * r1[0]; o1[2] = v1[2] * r1[2] - v1[3] * r1[3]; o1[3] = v1[2] * r1[3] + v1[3] * r1[2];
                o0 = o0 * C2M; o1 = o1 * C2M; *(u32x4*)(QM + (size_t)row * QM_P + h * 96 + 64 + p0) = pack8(o0, o1); )
        }
    }
};
struct EpiKV { static constexpr bool PERM = true; static constexpr bool MID = false; static constexpr int NS = 16;
    bf16_t *KM, *VM; const float* SSQ;
    __device__ __forceinline__ float rs(int row) const { const f32x4 p = *(const f32x4*)(SSQ + (size_t)row * 4); return 1.f / sqrtf(((p[0] + p[1]) + (p[2] + p[3])) * (1.f / 128.f) + EPS); }
    __device__ __forceinline__ void operator()(const f32x4 (&acc)[2][2][4][2], const Unit& u, int wr, int wc, int fr, int fq) const {
        const int row0 = u.pm * BM + wr * 64 + fr;
        if (u.pn < 2) { EPI_ROWS( const int cc = u.pn * 256 + c; const float r = rs(row); v0 = v0 * r; v1 = v1 * r; *(u32x4*)(KM + (size_t)row * KM_P + (cc >> 6) * 96 + (cc & 63)) = pack8(v0, v1); ) }
        else          { EPI_ROWS( const int cc = (u.pn - 2) * 256 + c; const float r = rs(row); v0 = v0 * r; v1 = v1 * r; *(u32x4*)(VM + (size_t)row * VM_P + cc) = pack8(v0, v1); ) }
    }
};
struct EpiResid { static constexpr bool PERM = true; static constexpr bool MID = false; static constexpr int NS = 0;
    const float* Xin; float* Xout; const float* gate  ; const float* rowscale; int rs_stride;
    __device__ __forceinline__ void operator()(const f32x4 (&acc)[2][2][4][2], const Unit& u, int wr, int wc, int fr, int fq) const {
        const int row0 = u.pm * BM + wr * 64 + fr; const int b = (u.pm * BM) >> 12;
        const float* gp = gate + (size_t)b * 6144 + u.pn * 256;
        EPI_ROWS( const f32x4 g0 = *(const f32x4*)(gp + c), g1 = *(const f32x4*)(gp + c + 4); const size_t off = (size_t)row * DM + u.pn * 256 + c;
            float rs = 1.f; if (rowscale) rs = rowscale[(size_t)row * rs_stride];
            const f32x4 x0 = *(const f32x4*)(Xin + off), x1 = *(const f32x4*)(Xin + off + 4);
            *(f32x4*)(Xout + off) = x0 + g0 * (v0 * rs); *(f32x4*)(Xout + off + 4) = x1 + g1 * (v1 * rs); )
    }
};
struct EpiSwiglu { static constexpr bool PERM = true; static constexpr bool MID = false; static constexpr int NS = 8;
    bf16_t* H;
    __device__ __forceinline__ void operator()(const f32x4 (&acc)[2][2][4][2], const Unit& u, int wr, int wc, int fr, int fq) const {
        const int row0 = u.pm * BM + wr * 64 + fr;
#pragma unroll
        for (int ai = 0; ai < 2; ++ai)
#pragma unroll
            for (int m = 0; m < 4; ++m) { const int row = row0 + ai * HALF + m * 16; f32x4 h[2];
#pragma unroll
                for (int n = 0; n < 2; ++n) { const f32x4 gv = acc[ai][0][m][n], uv = acc[ai][1][m][n];
#pragma unroll
                    for (int j = 0; j < 4; ++j) { const float e = __builtin_amdgcn_exp2f(-gv[j] * LOG2E); h[n][j] = gv[j] * __builtin_amdgcn_rcpf(1.f + e) * uv[j]; } }
                *(u32x4*)(H + (size_t)row * FF + u.pn * 128 + wc * 32 + 8 * fq) = pack8(h[0], h[1]); }
    }
};
struct EpiBf16Plain { static constexpr bool PERM = true; static constexpr bool MID = false; static constexpr int NS = 16; static constexpr int SCL0 = 0x7F7F7F7F, SCL1 = 0x7F7F7F7F;
    bf16_t* O; int ldc; float scale;
    __device__ __forceinline__ void operator()(const f32x4 (&acc)[2][2][4][2], const Unit& u, int wr, int wc, int fr, int fq) const {
        const int row0 = u.pm * BM + wr * 64 + fr;
        EPI_ROWS( v0 = v0 * scale; v1 = v1 * scale; *(u32x4*)(O + (size_t)row * ldc + u.pn * 256 + c) = pack8(v0, v1); )
    }
};
struct EpiWo { static constexpr bool PERM = true; static constexpr bool MID = true; static constexpr int NS = 16;
    bf16_t* O; const float* SSQ;
    __device__ __forceinline__ void sums(int row, float& s1, float& s2) const { const f32x4* p = (const f32x4*)(SSQ + (size_t)row * 16); const f32x4 a = p[0], b = p[1], c = p[2], d = p[3];
        s1 = ((a[0] + a[1]) + (a[2] + a[3])) + ((b[0] + b[1]) + (b[2] + b[3])); s2 = ((c[0] + c[1]) + (c[2] + c[3])) + ((d[0] + d[1]) + (d[2] + d[3])); }
    __device__ __forceinline__ void mid(f32x4 (&acc)[2][2][4][2], const Unit& u, int wr, int wc, int fr, int fq) const {
        int row0 = u.pm * BM + wr * 64 + fr; asm volatile("" : "+v"(row0));
#pragma unroll
        for (int ai = 0; ai < 2; ++ai)
#pragma unroll
            for (int m = 0; m < 4; ++m) { float s1, s2; sums(row0 + ai * HALF + m * 16, s1, s2); const float ratio = sqrtf((s2 * (1.f / 512.f) + EPS) / (s1 * (1.f / 512.f) + EPS));
#pragma unroll
                for (int bj = 0; bj < 2; ++bj)
#pragma unroll
                    for (int n = 0; n < 2; ++n) acc[ai][bj][m][n] = acc[ai][bj][m][n] * ratio;
                asm volatile("" : "+v"(acc[ai][0][m][0]), "+v"(acc[ai][0][m][1]), "+v"(acc[ai][1][m][0]), "+v"(acc[ai][1][m][1]) :: "memory"); }
    }
    __device__ __forceinline__ void operator()(const f32x4 (&acc)[2][2][4][2], const Unit& u, int wr, int wc, int fr, int fq) const {
        int row0 = u.pm * BM + wr * 64 + fr; asm volatile("" : "+v"(row0));
#pragma unroll
        for (int ai = 0; ai < 2; ++ai)
#pragma unroll
            for (int m = 0; m < 4; ++m) { const int row = row0 + ai * HALF + m * 16; float s1, s2; sums(row, s1, s2); const float r2 = 1.f / sqrtf(s2 * (1.f / 512.f) + EPS);
#pragma unroll
                for (int bj = 0; bj < 2; ++bj) { const int c = bj * HALF + wc * 32 + 8 * fq; *(u32x4*)(O + (size_t)row * DM + u.pn * 256 + c) = pack8(acc[ai][bj][m][0] * r2, acc[ai][bj][m][1] * r2); } }
    }
};
struct EpiSwigluF8 { static constexpr bool PERM = true; static constexpr bool MID = false; static constexpr int NS = 8; static constexpr int SCL0 = 0x7A7A7A7A, SCL1 = 0x7C7C7C7C;
    unsigned char* H;
    __device__ __forceinline__ void operator()(const f32x4 (&acc)[2][2][4][2], const Unit& u, int wr, int wc, int fr, int fq) const {
        const int row0 = u.pm * BM + wr * 64 + fr;
#pragma unroll
        for (int ai = 0; ai < 2; ++ai)
#pragma unroll
            for (int m = 0; m < 4; ++m) { const int row = row0 + ai * HALF + m * 16; float h[8];
#pragma unroll
                for (int n = 0; n < 2; ++n) { const f32x4 ga = acc[ai][0][m][n], ua = acc[ai][1][m][n];
#pragma unroll
                    for (int j = 0; j < 4; ++j) { const float e = __builtin_amdgcn_exp2f(ga[j]); const float hv = (ga[j] * ua[j]) * __builtin_amdgcn_rcpf(1.f + e);
                        h[4 * n + j] = __builtin_amdgcn_fmed3f(hv, -448.f, 448.f); } }
                int w0 = 0, w1 = 0;
                w0 = __builtin_amdgcn_cvt_pk_fp8_f32(h[0], h[1], w0, false); w0 = __builtin_amdgcn_cvt_pk_fp8_f32(h[2], h[3], w0, true);
                w1 = __builtin_amdgcn_cvt_pk_fp8_f32(h[4], h[5], w1, false); w1 = __builtin_amdgcn_cvt_pk_fp8_f32(h[6], h[7], w1, true);
                *(v2u*)(H + (size_t)row * FF + u.pn * 128 + wc * 32 + 8 * fq) = (v2u){(unsigned)w0, (unsigned)w1}; }
    }
};
struct MoeOrder : StaticOrder {
    int tend[8];
    __device__ __forceinline__ void load(const int* texp) {
#pragma unroll
        for (int e = 0; e < 8; ++e) tend[e] = __builtin_amdgcn_readfirstlane(texp[1 + e]); }
    __device__ __forceinline__ bool next(int i, Unit& u) const { if (!StaticOrder::next(i, u)) return false; int b = 0;
#pragma unroll
        for (int e = 0; e < 7; ++e) b += (u.pm >= tend[e]) ? 1 : 0;
        u.bsel = b; return true; }
};
struct EpiMoeDown { static constexpr bool PERM = true; static constexpr bool MID = false; static constexpr int NS = 0;
    float* X; const float* gate; const int* rowtok; const float* roww; float oscale;
    __device__ __forceinline__ void operator()(const f32x4 (&acc)[2][2][4][2], const Unit& u, int wr, int wc, int fr, int fq) const {
        const int row0 = u.pm * BM + wr * 64 + fr;
#pragma unroll
        for (int ai = 0; ai < 2; ++ai)
#pragma unroll
            for (int m = 0; m < 4; ++m) { const int slot = row0 + ai * HALF + m * 16; const int tok = rowtok[slot];
                if (tok >= 0) { const float w = roww[slot] * oscale; const float* gp = gate + (size_t)(tok >> 12) * 6144 + u.pn * 256; float* xp = X + (size_t)tok * DM + u.pn * 256;
#pragma unroll
                    for (int bj = 0; bj < 2; ++bj) { const int c = bj * HALF + wc * 32 + 8 * fq; const f32x4 v0 = acc[ai][bj][m][0], v1 = acc[ai][bj][m][1];
                        const f32x4 g0 = *(const f32x4*)(gp + c), g1 = *(const f32x4*)(gp + c + 4); const f32x4 x0 = *(const f32x4*)(xp + c), x1 = *(const f32x4*)(xp + c + 4);
                        *(f32x4*)(xp + c) = x0 + g0 * (v0 * w); *(f32x4*)(xp + c + 4) = x1 + g1 * (v1 * w); } } }
    }
};
struct MoeOrderD : MoeOrder {
    int mainU, mainM, tailSub, S, NT;
    __device__ __forceinline__ void init_d(int ntile, int NT_, int G_, int c_) {
        NT = NT_; const int per = G_ / 4; int tailM = (G_ % 4 == 0) ? ntile % per : 0; const int U = 4 * tailM;
        S = (7 * U <= G_ && NT_ % 14 == 0) ? 7 : ((2 * U <= G_ && NT_ % 4 == 0) ? 2 : 1); if (S == 1) tailM = 0;
        mainM = ntile - tailM; mainU = 4 * mainM; tailSub = 4 * tailM * S;
        StaticOrder::init(mainM * BM, 4 * BM, G_, c_); }
    __device__ __forceinline__ bool next(int i, Unit& u) const {
        const long L = (long)i * G + c;
        if (L < mainU) { StaticOrder::next(i, u); u.nt = NT; }
        else { const int j = (int)(L - mainU); if (j >= tailSub) return false;
            const int uu = j / S; u.part = j - uu * S; u.pm = mainM + (uu >> 2); u.pn = uu & 3; u.nt = NT / S; }
        int b = 0;
#pragma unroll
        for (int e = 0; e < 7; ++e) b += (u.pm >= tend[e]) ? 1 : 0;
        u.bsel = b; return true; }
};
struct EpiMoeY { static constexpr bool PERM = true; static constexpr bool MID = false; static constexpr int NS = 16; static constexpr int SCL0 = 0x7F7F7F7F, SCL1 = 0x7F7F7F7F;
    bf16_t* Y; bf16_t* Yp; int tail0; size_t pstride; float scale;
    __device__ __forceinline__ void operator()(const f32x4 (&acc)[2][2][4][2], const Unit& u, int wr, int wc, int fr, int fq) const {
        const int row0 = u.pm * BM + wr * 64 + fr;
        bf16_t* O = (u.part == 0) ? Y : Yp + (size_t)(u.part - 1) * pstride - (size_t)tail0 * DM;
        EPI_ROWS( v0 = v0 * scale; v1 = v1 * scale; *(u32x4*)(O + (size_t)row * DM + u.pn * 256 + c) = pack8(v0, v1); )
    }
};
}

#define XB_TMO      128
#define XB_XCNT(j)  (256  + 64 * (j))
#define XB_XSUB(j)  (1280 + 64 * (j))
#define XB_XGEN(j)  (2304 + 64 * (j))
#define XB_TOP      3328
#define XB_TOPGEN   3392
#define XCD_BAR_WORDS 3456
#define XB_SPIN_CAP (1u << 22)

__device__ __forceinline__ unsigned xb_ld(unsigned* p)              { return __hip_atomic_load(p, __ATOMIC_RELAXED, __HIP_MEMORY_SCOPE_AGENT); }
__device__ __forceinline__ unsigned xb_add(unsigned* p, unsigned v) { return __hip_atomic_fetch_add(p, v, __ATOMIC_RELAXED, __HIP_MEMORY_SCOPE_AGENT); }
__device__ __forceinline__ unsigned xb_xcc_id() { return (unsigned)__builtin_amdgcn_s_getreg((3 << 11) | 20) & 0xFu; }
#define XB_SPIN(cond, bar) do { unsigned _sp = 0; while (cond) { __builtin_amdgcn_s_sleep(1); \
    if ((++_sp & 255u) == 0u) { if (xb_ld(&(bar)[XB_TMO])) break; if (_sp > XB_SPIN_CAP) { atomicAdd(&(bar)[XB_TMO], 1u); break; } } } } while (0)

struct XcdBarrier { unsigned* bar; unsigned x; volatile LAS unsigned* st; };

__device__ __forceinline__ XcdBarrier xcd_barrier_post(unsigned* bar, volatile LAS unsigned* st) {
    XcdBarrier b; b.bar = bar; b.x = xb_xcc_id(); b.st = st;
    if (threadIdx.x == 0) (void)xb_add(&bar[XB_XCNT(b.x)], 1u);
    return b;
}
__device__ __forceinline__ void xcd_barrier_complete(unsigned* bar, unsigned x, unsigned& nloc, unsigned& nx) {
    const unsigned G = gridDim.x * gridDim.y * gridDim.z;
    unsigned sum, cnt, mine, sp = 0u;
    for (;;) {
        sum = 0u; cnt = 0u; mine = 0u;
#pragma unroll
        for (unsigned j = 0; j < 16; ++j) { const unsigned c = xb_ld(&bar[XB_XCNT(j)]); sum += c; cnt += (c > 0u) ? 1u : 0u; mine = (j == x) ? c : mine; }
        if (sum == G) break;
        __builtin_amdgcn_s_sleep(1);
        if ((++sp & 255u) == 0u) { if (xb_ld(&bar[XB_TMO])) break; if (sp > XB_SPIN_CAP) { atomicAdd(&bar[XB_TMO], 1u); break; } }
    }
    nloc = mine > 0u ? mine : 1u; nx = cnt > 0u ? cnt : 1u;
}
__device__ __forceinline__ void xcd_barrier(const XcdBarrier& b) {
    asm volatile("s_waitcnt vmcnt(0)" ::: "memory");
    __syncthreads();
    if (threadIdx.x == 0) {
        unsigned* bar = b.bar;
        __builtin_amdgcn_s_waitcnt(0);
        unsigned nloc = b.st[0], nx = b.st[1];
        if (nloc == 0u) { xcd_barrier_complete(bar, b.x, nloc, nx); b.st[0] = nloc; b.st[1] = nx; }
        const unsigned old = xb_add(&bar[XB_XSUB(b.x)], 1u);
        const unsigned gen = old / nloc;
        if (old + 1u == (gen + 1u) * nloc) {
            __builtin_amdgcn_fence(__ATOMIC_RELEASE, "agent");
            asm volatile("s_waitcnt vmcnt(0)" ::: "memory");
            const unsigned og = xb_add(&bar[XB_TOP], 1u);
            const unsigned tg = og / nx;
            if (og + 1u == (tg + 1u) * nx) xb_add(&bar[XB_TOPGEN], 1u);
            else XB_SPIN(xb_ld(&bar[XB_TOPGEN]) == tg, bar);
            __builtin_amdgcn_fence(__ATOMIC_ACQUIRE, "agent");
            xb_add(&bar[XB_XGEN(b.x)], 1u);
            asm volatile("s_waitcnt vmcnt(0)" ::: "memory");
        } else {
            XB_SPIN(xb_ld(&bar[XB_XGEN(b.x)]) == gen, bar);
            __builtin_amdgcn_fence(__ATOMIC_ACQUIRE, "agent");
            asm volatile("s_waitcnt vmcnt(0)" ::: "memory");
        }
    }
    __syncthreads();
}

struct Args {
    const float* in[24]; float* out; unsigned char* ws; int ph_lo, ph_hi;
};
struct Frame {
    LAS unsigned char* lds;
    int tid, lane, wave, vcu, G;
    unsigned char* ws;
};

template <class Src>
__device__ __forceinline__ void conv_item(const Src& src, int Ksrc, int Kpad, bf16* WT, LAS float* scr, int item, int lane, int nblk) {
    const int kb = item / nblk, nb = item % nblk, k0 = 64 * kb, n0 = 32 * nb;
    const float* colp = src(n0 + (lane & 31)); const int ld = src.ld;
#pragma unroll 8
    for (int i = 0; i < 32; ++i) { const int kk = 2 * i + (lane >> 5), k = k0 + kk; float v = 0.f; if (colp != nullptr && k < Ksrc) v = colp[(size_t)k * ld] * src.ksc(k); scr[kk * 33 + (lane & 31)] = v; }
    LDS_WAIT(); asm volatile("" ::: "memory");
    const int c = lane & 7;
#pragma unroll
    for (int j = 0; j < 4; ++j) { const int n = (lane >> 3) + 8 * j; const LAS float* s = scr + (8 * c) * 33 + n;
        v4u o; o.x = pk2(s[0 * 33], s[1 * 33]); o.y = pk2(s[2 * 33], s[3 * 33]); o.z = pk2(s[4 * 33], s[5 * 33]); o.w = pk2(s[6 * 33], s[7 * 33]);
        *(GAS v4u*)(WT + (size_t)(n0 + n) * Kpad + k0 + 8 * c) = o; }
    LDS_WAIT(); asm volatile("" ::: "memory");
}
template <class Src>
__device__ __forceinline__ void conv_matrix(Frame& F, const Src& src, int Ksrc, int Kpad, int Nout, bf16* WT, int rot = 0) {
    LAS float* scr = (LAS float*)(F.lds + F.wave * 16384);
    const int gw = F.vcu * NWAVES + F.wave, NGW = F.G * NWAVES, nblk = Nout / 32, nitems = (Kpad / 64) * nblk;
    for (int it = (gw + NGW - rot % NGW) % NGW; it < nitems; it += NGW) conv_item(src, Ksrc, Kpad, WT, scr, it, F.lane, nblk);
}
template <class Src>
__device__ __forceinline__ void conv_item64(const Src& src, int Ksrc, int Kpad, bf16* WT, LAS unsigned short* scr, int item, int lane, int nblk) {
    const int kb = item / nblk, nb = item % nblk, k0 = 64 * kb, n0 = 64 * nb;
    const int nn = (lane & 15) * 4, kq = lane >> 4;
    const float* colp = src(n0 + nn); const int ld = src.ld;
    f32x4 v[16];
#pragma unroll
    for (int i = 0; i < 16; ++i) { const int k = k0 + 4 * i + kq; v[i] = (k < Ksrc) ? *(const f32x4*)(colp + (size_t)k * ld) : (f32x4){0.f, 0.f, 0.f, 0.f}; }
#pragma unroll
    for (int i = 0; i < 16; ++i) { LAS unsigned* d = (LAS unsigned*)(scr + (4 * i + kq) * 66 + nn); d[0] = pk2(v[i].x, v[i].y); d[1] = pk2(v[i].z, v[i].w); }
    LDS_WAIT(); asm volatile("" ::: "memory");
    const int c = lane & 7;
#pragma unroll
    for (int j = 0; j < 8; ++j) { const int n = (lane >> 3) + 8 * j; const LAS unsigned short* sp = scr + (8 * c) * 66 + n;
        v4u o; o.x = (unsigned)sp[0 * 66] | ((unsigned)sp[1 * 66] << 16); o.y = (unsigned)sp[2 * 66] | ((unsigned)sp[3 * 66] << 16);
        o.z = (unsigned)sp[4 * 66] | ((unsigned)sp[5 * 66] << 16); o.w = (unsigned)sp[6 * 66] | ((unsigned)sp[7 * 66] << 16);
        *(GAS v4u*)(WT + (size_t)(n0 + n) * Kpad + k0 + 8 * c) = o; }
    LDS_WAIT(); asm volatile("" ::: "memory");
}
template <class Src>
__device__ __forceinline__ void conv_matrix64(Frame& F, const Src& src, int Ksrc, int Kpad, int Nout, bf16* WT) {
    LAS unsigned short* scr = (LAS unsigned short*)(F.lds + F.wave * 16384);
    const int gw = F.vcu * NWAVES + F.wave, NGW = F.G * NWAVES, nblk = Nout / 64, nitems = (Kpad / 64) * nblk;
    for (int it = gw; it < nitems; it += NGW) conv_item64(src, Ksrc, Kpad, WT, scr, it, F.lane, nblk);
}
template <class Src>
__device__ __forceinline__ void conv_item_f8(const Src& src, int Ksrc, int Kpad, unsigned char* WT, LAS unsigned* scr, int item, int lane, int nblk, float sc) {
    const int kb = item / nblk, nb = item % nblk, k0 = 128 * kb, n0 = 64 * nb;
    const int nn = (lane & 15) * 4, kq4 = lane >> 4;
    const float* colp = src(n0 + nn); const int ld = src.ld;
#pragma unroll 2
    for (int i = 0; i < 8; ++i) { const int kq = 4 * i + kq4, k = k0 + 4 * kq; f32x4 r[4];
#pragma unroll
        for (int q = 0; q < 4; ++q) r[q] = (k + q < Ksrc) ? *(const f32x4*)(colp + (size_t)(k + q) * ld) : (f32x4){0.f, 0.f, 0.f, 0.f};
#pragma unroll
        for (int j = 0; j < 4; ++j) { int w = 0; w = __builtin_amdgcn_cvt_pk_fp8_f32(r[0][j] * sc, r[1][j] * sc, w, false); w = __builtin_amdgcn_cvt_pk_fp8_f32(r[2][j] * sc, r[3][j] * sc, w, true); scr[kq * 65 + nn + j] = (unsigned)w; } }
    LDS_WAIT(); asm volatile("" ::: "memory");
    const int c = lane & 7;
#pragma unroll
    for (int j = 0; j < 8; ++j) { const int n = (lane >> 3) + 8 * j; const LAS unsigned* sp = scr + (4 * c) * 65 + n;
        v4u o; o.x = sp[0]; o.y = sp[65]; o.z = sp[130]; o.w = sp[195];
        *(GAS v4u*)(WT + (size_t)(n0 + n) * Kpad + k0 + 16 * c) = o; }
    LDS_WAIT(); asm volatile("" ::: "memory");
}
template <class Src>
__device__ __forceinline__ void conv_matrix_f8(Frame& F, const Src& src, int Ksrc, int Kpad, int Nout, unsigned char* WT, float sc) {
    LAS unsigned* scr = (LAS unsigned*)(F.lds + F.wave * 16384);
    const int gw = F.vcu * NWAVES + F.wave, NGW = F.G * NWAVES, nblk = Nout / 64, nitems = (Kpad / 128) * nblk;
    for (int it = gw; it < nitems; it += NGW) conv_item_f8(src, Ksrc, Kpad, WT, scr, it, F.lane, nblk, sc);
}
template <class Src, bool F8>
__device__ __forceinline__ void conv_matrix_wg(Frame& F, const Src& src, int Ksrc, int Kpad, int Nout, unsigned char* WT, float sc, int rot = 0) {
    constexpr int KT = F8 ? 128 : 64, RW = KT / 8;
    LAS unsigned short* l16 = (LAS unsigned short*)F.lds; LAS unsigned* l32 = (LAS unsigned*)F.lds;
    const int nblk = Nout / 256, nitems = (Kpad / KT) * nblk, ld = src.ld;
    for (int it = (F.vcu + F.G - rot % F.G) % F.G; it < nitems; it += F.G) {
        const int kb = it / nblk, nb = it % nblk, k0 = KT * kb, n0 = 256 * nb;
        const float* colp = src(n0 + 4 * F.lane); const float scn = sc * src.nsc(n0 + 4 * F.lane);
        f32x4 r[RW];
#pragma unroll
        for (int j = 0; j < RW; ++j) { const int k = k0 + F.wave * RW + j; r[j] = (k < Ksrc) ? *(const f32x4*)(colp + (size_t)k * ld) * src.ksc(k) : (f32x4){0.f, 0.f, 0.f, 0.f}; }
        if constexpr (F8) {
#pragma unroll
            for (int q4 = 0; q4 < RW / 4; ++q4) { const int kq = F.wave * (RW / 4) + q4;
#pragma unroll
                for (int j = 0; j < 4; ++j) { int w = 0; w = __builtin_amdgcn_cvt_pk_fp8_f32(r[4 * q4][j] * scn, r[4 * q4 + 1][j] * scn, w, false); w = __builtin_amdgcn_cvt_pk_fp8_f32(r[4 * q4 + 2][j] * scn, r[4 * q4 + 3][j] * scn, w, true);
                    l32[kq * 257 + 4 * F.lane + j] = (unsigned)w; } }
        } else {
#pragma unroll
            for (int j = 0; j < RW; ++j) { const int kk = F.wave * RW + j; LAS unsigned* d = (LAS unsigned*)(l16 + kk * 258 + 4 * F.lane); d[0] = pk2(r[j].x, r[j].y); d[1] = pk2(r[j].z, r[j].w); }
        }
        __syncthreads();
#pragma unroll
        for (int j = 0; j < 4; ++j) { const int task = F.tid + 512 * j, rr = task >> 3, c = task & 7; v4u o;
            if constexpr (F8) { const LAS unsigned* sp = l32 + (4 * c) * 257 + rr; o.x = sp[0]; o.y = sp[257]; o.z = sp[514]; o.w = sp[771];
                *(GAS v4u*)(WT + (size_t)(n0 + rr) * Kpad + k0 + 16 * c) = o; }
            else { const LAS unsigned short* sp = l16 + (8 * c) * 258 + rr;
                o.x = (unsigned)sp[0] | ((unsigned)sp[258] << 16); o.y = (unsigned)sp[2 * 258] | ((unsigned)sp[3 * 258] << 16); o.z = (unsigned)sp[4 * 258] | ((unsigned)sp[5 * 258] << 16); o.w = (unsigned)sp[6 * 258] | ((unsigned)sp[7 * 258] << 16);
                *(GAS v4u*)(WT + ((size_t)(n0 + rr) * Kpad + k0 + 8 * c) * 2) = o; }
        }
        __syncthreads();
    }
}
struct SrcPlain { const float* W; int ld; __device__ __forceinline__ const float* operator()(int n) const { return W + n; } __device__ __forceinline__ float ksc(int) const { return 1.f; } __device__ __forceinline__ float nsc(int) const { return 1.f; } };
struct SrcPlainG { const float* W; int ld; const float* g1; const float* g2;
    __device__ __forceinline__ const float* operator()(int n) const { return W + n; } __device__ __forceinline__ float ksc(int k) const { return k < 512 ? g1[k] : g2[k - 512]; } __device__ __forceinline__ float nsc(int) const { return 1.f; } };
struct SrcWin { const float* W; int ld;
    __device__ __forceinline__ float ksc(int) const { return 1.f; }
    __device__ __forceinline__ const float* operator()(int n) const {
        int s;
        if (n < 384) s = n;
        else if (n < 416) { const int p = n - 384; s = 384 + (p >> 1) + 16 * (p & 1); }
        else if (n < 424) s = 1952 + (n - 416);
        else if (n < 512) return nullptr;
        else if (n < 1024) s = 416 + (n - 512);
        else if (n < 1536) s = 928 + (n - 1024);
        else s = 1440 + (n - 1536);
        return W + s; } };
struct SrcWuq { const float* W; int ld; const float* g;
    __device__ __forceinline__ float ksc(int k) const { return g[k]; }
    __device__ __forceinline__ const float* operator()(int n) const {
        int s;
        if (n < 512) s = (n >> 6) * 96 + (n & 63);
        else { const int r = n - 512, h = r >> 5, p = r & 31; s = h * 96 + 64 + (p >> 1) + 16 * (p & 1); }
        return W + s; } };
struct SrcWukv { const float* W; int ld; const float* g;
    __device__ __forceinline__ float ksc(int k) const { return g[k]; }
    __device__ __forceinline__ const float* operator()(int n) const {
        int s;
        if (n < 512) s = (n >> 6) * 128 + (n & 63);
        else { const int r = n - 512; s = (r >> 6) * 128 + 64 + (r & 63); }
        return W + s; } };
struct SrcGU { const float* Wg; const float* Wu; int ld;
    __device__ __forceinline__ float ksc(int) const { return 1.f; }
    __device__ __forceinline__ float nsc(int n) const { return ((n & 255) < 128) ? -LOG2E : -SC_H / (4.f * LOG2E); }
    __device__ __forceinline__ const float* operator()(int n) const { const int t = n >> 8, w = n & 255; return (w < 128) ? (Wg + t * 128 + w) : (Wu + t * 128 + (w - 128)); } };

__device__ __forceinline__ void mod_phase(Frame& F, const float* c, const float* ada_w, const float* ada_b, float* MOD) {
    LAS float* cact = (LAS float*)F.lds;
    LAS float* red = cact + 8 * 1024;
    for (int i = F.tid; i < 8 * 1024; i += NWAVES * 64) { const float v = c[i]; cact[i] = v / (1.f + __expf(-v)); }
    __syncthreads();
    for (int item = F.vcu; item < 192; item += F.G) {
        const int l = item / 96, j = (item % 96) * 64 + F.lane;
        const float* wp = ada_w + (size_t)l * 1024 * 6144 + j;
        float acc[8];
#pragma unroll
        for (int b = 0; b < 8; ++b) acc[b] = 0.f;
        const int kb = F.wave * 128;
#pragma unroll 4
        for (int k = kb; k < kb + 128; ++k) { const float w = wp[(size_t)k * 6144];
#pragma unroll
            for (int b = 0; b < 8; ++b) acc[b] += cact[b * 1024 + k] * w; }
#pragma unroll
        for (int b = 0; b < 8; ++b) red[(F.wave * 8 + b) * 64 + F.lane] = acc[b];
        __syncthreads();
        { const int b = F.wave; float s = ada_b[l * 6144 + j];
#pragma unroll
          for (int w = 0; w < 8; ++w) s += red[(w * 8 + b) * 64 + F.lane];
          MOD[((size_t)l * 8 + b) * 6144 + j] = s; }
        __syncthreads();
    }
}

template <bool ROUTER, bool RESID, bool F8OUT = ROUTER>
__device__ __forceinline__ void norm_phase(Frame& F, const float* X, const float* g, const float* modl  , int part  , bf16* XN,
                                           const float* router_w, int* TOKE, float* TOKW, unsigned* CNT, const bf16* T, const float* rgate  , float* Xout) {
    const int gw = F.vcu * NWAVES + F.wave, NGW = F.G * NWAVES;
    if constexpr (ROUTER) { if (F.tid < 16) ((LAS unsigned*)(F.lds + LCNT_OFF))[F.tid] = 0u; __syncthreads(); }
    f32x4 gv[4];
#pragma unroll
    for (int j = 0; j < 4; ++j) gv[j] = *(const f32x4*)(g + 4 * F.lane + 256 * j);
    f32x4 vn[4]; v2u tn[4];
#pragma unroll
    for (int j = 0; j < 4; ++j) { vn[j] = ((const f32x4*)(X + (size_t)gw * DM) + F.lane)[64 * j]; if constexpr (RESID) tn[j] = ((const v2u*)(T + (size_t)gw * DM) + F.lane)[64 * j]; }
    for (int m = gw; m < M; m += NGW) {
        const int b = m >> 12;
        const f32x4* sh = (const f32x4*)(modl + (size_t)b * 6144 + part * 1024) + F.lane;
        const f32x4* sc = (const f32x4*)(modl + (size_t)b * 6144 + (part + 1) * 1024) + F.lane;
        f32x4 v[4]; v2u tc[4]; float s = 0.f;
#pragma unroll
        for (int j = 0; j < 4; ++j) { v[j] = vn[j]; if constexpr (RESID) tc[j] = tn[j]; }
        { const int mn = (m + NGW < M) ? m + NGW : m;
#pragma unroll
          for (int j = 0; j < 4; ++j) { vn[j] = ((const f32x4*)(X + (size_t)mn * DM) + F.lane)[64 * j]; if constexpr (RESID) tn[j] = ((const v2u*)(T + (size_t)mn * DM) + F.lane)[64 * j]; } }
        if constexpr (RESID) {
            const f32x4* gr = (const f32x4*)(rgate + (size_t)b * 6144) + F.lane; f32x4* xo = (f32x4*)(Xout + (size_t)m * DM) + F.lane;
#pragma unroll
            for (int j = 0; j < 4; ++j) { const v2u t = tc[j]; const f32x4 gg = gr[64 * j];
                v[j].x += gg.x * bf2f(t.x & 0xffffu); v[j].y += gg.y * bf2f(t.x >> 16); v[j].z += gg.z * bf2f(t.y & 0xffffu); v[j].w += gg.w * bf2f(t.y >> 16); xo[64 * j] = v[j]; }
        }
#pragma unroll
        for (int j = 0; j < 4; ++j) s += (v[j].x * v[j].x + v[j].y * v[j].y) + (v[j].z * v[j].z + v[j].w * v[j].w);
        const float r = 1.f / sqrtf(wave_sum(s) * (1.f / DM) + EPS);
        v2u* o8 = (v2u*)(XN + (size_t)m * DM) + F.lane; unsigned* o4 = (unsigned*)((unsigned char*)XN + (size_t)m * DM) + F.lane;
#pragma unroll
        for (int j = 0; j < 4; ++j) { const f32x4 a = sh[64 * j], c1 = sc[64 * j]; v[j] = (v[j] * r) * gv[j]; v[j] = v[j] * (c1 + 1.f) + a;
            if constexpr (F8OUT) { int w = 0; w = __builtin_amdgcn_cvt_pk_fp8_f32(fminf(fmaxf(v[j].x, -448.f), 448.f), fminf(fmaxf(v[j].y, -448.f), 448.f), w, false);
                w = __builtin_amdgcn_cvt_pk_fp8_f32(fminf(fmaxf(v[j].z, -448.f), 448.f), fminf(fmaxf(v[j].w, -448.f), 448.f), w, true); o4[64 * j] = (unsigned)w; }
            else { v2u w; w.x = pk2(v[j].x, v[j].y); w.y = pk2(v[j].z, v[j].w); o8[64 * j] = w; } }
        if constexpr (ROUTER) {
            float lg[8];
#pragma unroll
            for (int e = 0; e < 8; ++e) lg[e] = 0.f;
#pragma unroll
            for (int j = 0; j < 4; ++j)
#pragma unroll
                for (int q = 0; q < 4; ++q) { const float* rw = router_w + (size_t)(4 * F.lane + 256 * j + q) * 8; const f32x4 w0 = *(const f32x4*)rw, w1 = *(const f32x4*)(rw + 4); const float hv = v[j][q];
                    lg[0] += hv * w0.x; lg[1] += hv * w0.y; lg[2] += hv * w0.z; lg[3] += hv * w0.w; lg[4] += hv * w1.x; lg[5] += hv * w1.y; lg[6] += hv * w1.z; lg[7] += hv * w1.w; }
#pragma unroll
            for (int e = 0; e < 8; ++e) lg[e] = wave_sum(lg[e]);
            int e0 = 0; float v0 = lg[0];
#pragma unroll
            for (int e = 1; e < 8; ++e) if (lg[e] > v0) { v0 = lg[e]; e0 = e; }
            int e1 = -1; float v1 = -INFINITY;
#pragma unroll
            for (int e = 0; e < 8; ++e) if (e != e0 && lg[e] > v1) { v1 = lg[e]; e1 = e; }
            const float w1 = 1.f / (1.f + __expf(v0 - v1)), w0 = 1.f - w1;
            if (F.lane == 0) { TOKE[m] = e0 | (e1 << 8); *(f32x2*)(TOKW + 2 * (size_t)m) = (f32x2){w0, w1};
                LAS unsigned* lc = (LAS unsigned*)(F.lds + LCNT_OFF);
                __hip_atomic_fetch_add(lc + e0, 1u, __ATOMIC_RELAXED, __HIP_MEMORY_SCOPE_WORKGROUP); __hip_atomic_fetch_add(lc + e1, 1u, __ATOMIC_RELAXED, __HIP_MEMORY_SCOPE_WORKGROUP); }
        }
    }
    if constexpr (ROUTER) { __syncthreads(); if (F.tid < 16) CNT[F.vcu * 16 + F.tid] = ((LAS unsigned*)(F.lds + LCNT_OFF))[F.tid]; }
}

__device__ __forceinline__ void rope_phase(Frame& F, const int* positions, float* ROPE) {
    const int gw = F.vcu * NWAVES + F.wave, NGW = F.G * NWAVES;
    const int i = F.lane & 15; const float invf = powf(10000.f, -(float)i / 16.f);
    for (int m4 = gw; m4 < M / 4; m4 += NGW) { const int m = 4 * m4 + (F.lane >> 4);
        const float ang = (float)positions[m] * invf; float sn, cs; sincosf(ang, &sn, &cs);
        *(f32x2*)(ROPE + (size_t)m * 32 + 2 * i) = (f32x2){cs, sn}; }
}
__device__ __forceinline__ float log_sigmoid(float x) { return fminf(x, 0.f) - log1pf(__expf(-fabsf(x))); }
__device__ __forceinline__ void scan_phase(Frame& F, const float* FLOG, const float* fb, bf16* QF, bf16* KF) {
    const int sc = (int)blockIdx.x - (F.G - 64);
    if (sc >= 0) {
        const int b = sc >> 3, h = sc & 7; const float bias = fb[h];
        const size_t m0 = (size_t)b * SEQ + 8 * F.tid;
        LAS float* wtot = (LAS float*)(F.lds + LCNT_OFF + 512);
        float lf[8]; float tot = 0.f;
#pragma unroll
        for (int j = 0; j < 8; ++j) { lf[j] = log_sigmoid(FLOG[(m0 + j) * 8 + h] + bias); tot += lf[j]; }
        float inc = tot;
#pragma unroll
        for (int o = 1; o < 64; o <<= 1) { const float t = __shfl_up(inc, o); if (F.lane >= o) inc += t; }
        if (F.lane == 63) wtot[F.wave] = inc;
        __syncthreads();
        float run = inc - tot;
        for (int w = 0; w < F.wave; ++w) run += wtot[w];
#pragma unroll
        for (int j = 0; j < 8; ++j) { run += lf[j]; const float L = run * LOG2E;
            const unsigned hi = f2bf(L); const float r1 = L - bf2f(hi); const unsigned mi = f2bf(r1); const float r2 = r1 - bf2f(mi); const unsigned lo = f2bf(r2);
            const unsigned one = 0x3f80u;
            v4u q0, k0; const v4u z = (v4u){0u, 0u, 0u, 0u};
            q0.x = hi | (mi << 16); q0.y = lo | (one << 16); q0.z = one | (one << 16); q0.w = 0u;
            k0.x = one | (one << 16); k0.y = one | ((hi ^ 0x8000u) << 16); k0.z = (mi ^ 0x8000u) | ((lo ^ 0x8000u) << 16); k0.w = 0u;
            bf16* qp = QF + (m0 + j) * QF_P + h * 80 + 64; bf16* kp = KF + (m0 + j) * KF_P + h * 80 + 64;
            *(v4u*)qp = q0; *(v4u*)(qp + 8) = z; *(v4u*)kp = k0; *(v4u*)(kp + 8) = z; }
    }
    __syncthreads();
}

__device__ __forceinline__ void route_phase(Frame& F, const unsigned* CNT  , const int* TOKE, int* ROWTOK, int* TOKSLOT, int* TEXP  ) {
    LAS unsigned* sh = (LAS unsigned*)(F.lds + LCNT_OFF);
    const int gw = F.vcu * NWAVES + F.wave, NGW = F.G * NWAVES;
    if (F.tid < 8) sh[64 + F.tid] = 0u;
    { const int e = F.wave; unsigned tot = 0u, pre = 0u;
#pragma unroll
        for (int j = 0; j < 4; ++j) { const int wg = F.lane + 64 * j; const unsigned v = (wg < F.G) ? CNT[wg * 16 + e] : 0u; tot += v; pre += (wg < F.vcu) ? v : 0u; }
#pragma unroll
        for (int o = 1; o < 64; o <<= 1) { tot += __shfl_xor(tot, o); pre += __shfl_xor(pre, o); }
        if (F.lane == 0) { sh[e] = tot; sh[16 + e] = pre; } }
    __syncthreads();
    if (F.tid < 8) { unsigned st = 0u;
        for (int t2 = 0; t2 < F.tid; ++t2) st += (sh[t2] + 255u) & ~255u;
        sh[48 + F.tid] = st; sh[32 + F.tid] = st + sh[16 + F.tid]; }
    __syncthreads();
    if (F.lane < 16) { const int m = gw + F.lane * NGW;
        if (m < M) { const int te = TOKE[m]; const int e0 = te & 255, e1 = te >> 8;
            const unsigned i0 = __hip_atomic_fetch_add(sh + 64 + e0, 1u, __ATOMIC_RELAXED, __HIP_MEMORY_SCOPE_WORKGROUP), i1 = __hip_atomic_fetch_add(sh + 64 + e1, 1u, __ATOMIC_RELAXED, __HIP_MEMORY_SCOPE_WORKGROUP);
            const unsigned s0 = sh[32 + e0] + i0, s1 = sh[32 + e1] + i1;
            ROWTOK[s0] = m; ROWTOK[s1] = m; TOKSLOT[2 * m] = (int)s0; TOKSLOT[2 * m + 1] = (int)s1; } }
    if (F.vcu < 8) { const unsigned tot = sh[F.vcu], seg = sh[48 + F.vcu], end = (tot + 255u) & ~255u;
        for (unsigned r = tot + F.tid; r < end; r += NWAVES * 64) ROWTOK[seg + r] = -1; }
    if (F.vcu == 16 && F.tid == 0) { int t = 0;
        for (int e = 0; e < 8; ++e) { t += (int)((sh[e] + 255u) >> 8); TEXP[1 + e] = t; }
        TEXP[0] = t; }
    __syncthreads();
}

__device__ __forceinline__ void outnorm_phase(Frame& F, bf16* O, const float* g1, const float* g2) {
    const int gw = F.vcu * NWAVES + F.wave, NGW = F.G * NWAVES;
    float ga[8], gb[8];
#pragma unroll
    for (int j = 0; j < 8; ++j) { ga[j] = g1[8 * F.lane + j]; gb[j] = g2[8 * F.lane + j]; }
    for (int m = gw; m < M; m += NGW) {
        v4u* p = (v4u*)(O + (size_t)m * O_P) + F.lane;
        const v4u a = p[0], b = p[64];
        float fa[8], fbv[8]; float sa = 0.f, sb = 0.f;
#pragma unroll
        for (int j = 0; j < 4; ++j) { fa[2 * j] = bf2f(a[j] & 0xffffu); fa[2 * j + 1] = bf2f(a[j] >> 16); fbv[2 * j] = bf2f(b[j] & 0xffffu); fbv[2 * j + 1] = bf2f(b[j] >> 16); }
#pragma unroll
        for (int j = 0; j < 8; ++j) { sa += fa[j] * fa[j]; sb += fbv[j] * fbv[j]; }
        const float ra = 1.f / sqrtf(wave_sum(sa) * (1.f / 512.f) + EPS), rb = 1.f / sqrtf(wave_sum(sb) * (1.f / 512.f) + EPS);
        v4u oa, ob;
#pragma unroll
        for (int j = 0; j < 4; ++j) { oa[j] = pk2(fa[2 * j] * ra * ga[2 * j], fa[2 * j + 1] * ra * ga[2 * j + 1]); ob[j] = pk2(fbv[2 * j] * rb * gb[2 * j], fbv[2 * j + 1] * rb * gb[2 * j + 1]); }
        p[0] = oa; p[64] = ob;
    }
}

__device__ __forceinline__ void final_phase(Frame& F, float* X, const float* g, const bf16* Y, const bf16* Yp, const int* TEXP, const int* TOKSLOT, const float* TOKW, const float* gf  ) {
    const int gw = F.vcu * NWAVES + F.wave, NGW = F.G * NWAVES;
    int tail0, S; size_t pstride;
    { pg8::MoeOrderD O; O.init_d(__builtin_amdgcn_readfirstlane(TEXP[0]), FF / 128, F.G, 0); S = O.S; tail0 = O.mainM * 256; pstride = (size_t)(O.tailSub / (4 * O.S)) * 256 * DM; }
    f32x4 gv[4];
#pragma unroll
    for (int j = 0; j < 4; ++j) gv[j] = *(const f32x4*)(g + 4 * F.lane + 256 * j);
    for (int m = gw; m < M; m += NGW) {
        const int b = m >> 12;
        f32x4* xr = (f32x4*)(X + (size_t)m * DM) + F.lane;
        const int s0 = TOKSLOT[2 * m], s1 = TOKSLOT[2 * m + 1]; const float w0 = TOKW[2 * m], w1 = TOKW[2 * m + 1];
        const v2u* y0 = (const v2u*)(Y + (size_t)s0 * DM) + F.lane; const v2u* y1 = (const v2u*)(Y + (size_t)s1 * DM) + F.lane; const f32x4* gr = (const f32x4*)(gf + (size_t)b * 6144) + F.lane;
        f32x4 v[4]; float s = 0.f;
#pragma unroll
        for (int j = 0; j < 4; ++j) { v[j] = xr[64 * j]; const v2u a = y0[64 * j], c = y1[64 * j]; const f32x4 gg = gr[64 * j];
            v[j].x += gg.x * (w0 * bf2f(a.x & 0xffffu) + w1 * bf2f(c.x & 0xffffu)); v[j].y += gg.y * (w0 * bf2f(a.x >> 16) + w1 * bf2f(c.x >> 16));
            v[j].z += gg.z * (w0 * bf2f(a.y & 0xffffu) + w1 * bf2f(c.y & 0xffffu)); v[j].w += gg.w * (w0 * bf2f(a.y >> 16) + w1 * bf2f(c.y >> 16));
        }
        if (S > 1 && (s0 >= tail0 || s1 >= tail0)) {
#pragma unroll 1
            for (int k = 0; k < 2; ++k) { const int sk = k ? s1 : s0; const float wk = k ? w1 : w0; if (sk < tail0) continue;
#pragma unroll 1
                for (int p = 1; p < S; ++p) { const v2u* yp = (const v2u*)(Yp + (size_t)(p - 1) * pstride + (size_t)(sk - tail0) * DM) + F.lane;
#pragma unroll
                    for (int j = 0; j < 4; ++j) { const v2u a = yp[64 * j]; const f32x4 gg = gr[64 * j];
                        v[j].x += gg.x * (wk * bf2f(a.x & 0xffffu)); v[j].y += gg.y * (wk * bf2f(a.x >> 16)); v[j].z += gg.z * (wk * bf2f(a.y & 0xffffu)); v[j].w += gg.w * (wk * bf2f(a.y >> 16)); } } } }
#pragma unroll
        for (int j = 0; j < 4; ++j) s += (v[j].x * v[j].x + v[j].y * v[j].y) + (v[j].z * v[j].z + v[j].w * v[j].w);
        const float r = 1.f / sqrtf(wave_sum(s) * (1.f / DM) + EPS);
#pragma unroll
        for (int j = 0; j < 4; ++j) xr[64 * j] = (v[j] * r) * gv[j];
    }
}

typedef __bf16 bf16x2_t __attribute__((ext_vector_type(2)));
template <int DQK>
__device__ __forceinline__ void attn_naive_unit(Frame& F, const bf16* Q, int qpitch, const bf16* K, int kpitch, const bf16* V, int vpitch, bf16* O  , int b, int h, int qb) {
    LAS unsigned* Ksh = (LAS unsigned*)F.lds;
    LAS float* Vsh = (LAS float*)(F.lds + 64 * DQK * 2);
    const int tid = F.tid, qpos = qb * 512 + tid; const size_t row = (size_t)b * SEQ + qpos;
    unsigned q[DQK / 2]; float o[64];
    { const bf16* qp = Q + row * qpitch + h * DQK;
#pragma unroll
      for (int d8 = 0; d8 < DQK / 8; ++d8) { const v4u w = *(const v4u*)(qp + 8 * d8);
#pragma unroll
          for (int j = 0; j < 4; ++j) q[4 * d8 + j] = w[j]; } }
#pragma unroll
    for (int d = 0; d < 64; ++d) o[d] = 0.f;
    float mrun = -INFINITY, l = 0.f;
    const int ntile = 8 * (qb + 1);
    for (int t = 0; t < ntile; ++t) {
        __syncthreads();
        for (int idx = tid; idx < 64 * DQK / 8; idx += NWAVES * 64) { const int r = idx / (DQK / 8), c8 = idx % (DQK / 8);
            const v4u w = *(const v4u*)(K + ((size_t)b * SEQ + t * 64 + r) * kpitch + h * DQK + 8 * c8); *(LAS v4u*)(Ksh + r * (DQK / 2) + 4 * c8) = w; }
        { const int r = tid >> 3, c8 = tid & 7; const v4u w = *(const v4u*)(V + ((size_t)b * SEQ + t * 64 + r) * vpitch + h * 64 + 8 * c8); LAS float* d = Vsh + r * 64 + 8 * c8;
#pragma unroll
          for (int j = 0; j < 4; ++j) { d[2 * j] = bf2f(w[j] & 0xffffu); d[2 * j + 1] = bf2f(w[j] >> 16); } }
        __syncthreads();
        const int kbase = t * 64;
#pragma unroll 1
        for (int gk = 0; gk < 16; ++gk) {
            float s[4]; float mx = -INFINITY;
#pragma unroll
            for (int j = 0; j < 4; ++j) { const LAS unsigned* kr = Ksh + (gk * 4 + j) * (DQK / 2); float a = 0.f;
#pragma unroll
                for (int d = 0; d < DQK / 2; ++d) a = __builtin_amdgcn_fdot2_f32_bf16(__builtin_bit_cast(bf16x2_t, q[d]), __builtin_bit_cast(bf16x2_t, kr[d]), a, false);
                s[j] = (kbase + gk * 4 + j <= qpos) ? a : -INFINITY; mx = fmaxf(mx, s[j]); asm volatile("" ::: "memory"); }
            const float mnew = fmaxf(mrun, mx);
            if (mnew > -INFINITY) {
                const float alpha = __builtin_amdgcn_exp2f(mrun - mnew);
                l *= alpha;
#pragma unroll
                for (int d = 0; d < 64; ++d) o[d] *= alpha;
#pragma unroll
                for (int j = 0; j < 4; ++j) { const float p = __builtin_amdgcn_exp2f(s[j] - mnew); l += p; const LAS float* vr = Vsh + (gk * 4 + j) * 64;
#pragma unroll
                    for (int dc = 0; dc < 4; ++dc) {
#pragma unroll
                        for (int d = 0; d < 16; ++d) o[dc * 16 + d] += p * vr[dc * 16 + d];
                        asm volatile("" ::: "memory"); } }
                mrun = mnew;
            }
        }
    }
    const float rl = 1.f / l;
    bf16* op = O + row * O_P + h * 64;
#pragma unroll
    for (int d8 = 0; d8 < 8; ++d8) { v4u w;
#pragma unroll
        for (int j = 0; j < 4; ++j) w[j] = pk2(o[8 * d8 + 2 * j] * rl, o[8 * d8 + 2 * j + 1] * rl);
        *(v4u*)(op + 8 * d8) = w; }
    __syncthreads();
}

namespace att {
using f32x16 = __attribute__((ext_vector_type(16))) float;
using s16x4 = __attribute__((ext_vector_type(4))) short;
using u32x4 = __attribute__((ext_vector_type(4))) unsigned;
typedef __attribute__((address_space(3))) const char* lds_cptr;
typedef short v4i16_t __attribute__((ext_vector_type(4)));
__device__ __forceinline__ int crow(int r, int hi) { return (r & 3) + 8 * (r >> 2) + 4 * hi; }
__device__ __forceinline__ void glds16(const void* gsrc, unsigned lds_dst) { unsigned keep;
    asm volatile("s_mov_b32 %0, m0\n\ts_mov_b32 m0, %2\n\ts_nop 0\n\tglobal_load_lds_dwordx4 %1, off\n\ts_mov_b32 m0, %0" : "=&s"(keep) : "v"(gsrc), "s"(lds_dst) : "memory"); }
__device__ __forceinline__ unsigned cvtpk(float lo, float hi) { unsigned r; asm("v_cvt_pk_bf16_f32 %0, %1, %2" : "=v"(r) : "v"(lo), "v"(hi)); return r; }
#define ATT_WAIT_BAR(N) asm volatile("s_waitcnt vmcnt(" #N ") lgkmcnt(0)\n\ts_barrier" ::: "memory")
constexpr float THR = 8.f;

__device__ __forceinline__ float max3f(float a, float b, float c) { float r; asm("v_max3_f32 %0, %1, %2, %3" : "=v"(r) : "v"(a), "v"(b), "v"(c)); return r; }
__device__ __forceinline__ float max2f(float a, float b) { float r; asm("v_max_f32_e32 %0, %1, %2" : "=v"(r) : "v"(a), "v"(b)); return r; }
__device__ __forceinline__ float fadd_s(float a, float b) { float r; asm("v_add_f32_e32 %0, %1, %2" : "=v"(r) : "v"(a), "v"(b)); return r; }
__device__ __forceinline__ float fsub_s(float a, float b) { float r; asm("v_sub_f32_e32 %0, %1, %2" : "=v"(r) : "v"(a), "v"(b)); return r; }
__device__ __forceinline__ float fmul_s(float a, float b) { float r; asm("v_mul_f32_e32 %0, %1, %2" : "=v"(r) : "v"(a), "v"(b)); return r; }

template <int DQK>
__device__ __forceinline__ void attn_unit(const bf16* Q, const bf16* K, const bf16* V, bf16* O, float* SSQO  , int b, int h, int qb, char* shm) {
    constexpr int NK = DQK / 16, NCH = DQK / 8, NX = NCH - 8, KBYTES = NCH * 1024, SLOT = KBYTES + 8192, PITCH = 8 * DQK;
    constexpr int LDS_WS = 3 * SLOT, LDS_OST = LDS_WS + 8 * 256;
    int tid_ = threadIdx.x; asm volatile("" : "+v"(tid_));
    const int tid = tid_, lane = tid & 63, r32 = lane & 31, hi = lane >> 5; const int wid = __builtin_amdgcn_readfirstlane(tid >> 6);
    const long rowbase = (long)b * SEQ; const int q0 = qb * 256;
    const bf16* Qw = Q + (rowbase + q0 + wid * 32) * PITCH + h * DQK;
    const bf16* Kh = K + rowbase * PITCH + h * DQK; const bf16* Vh = V + rowbase * 512 + h * 64;
    const unsigned lds0 = (unsigned)(uintptr_t)shm;
    float* wsf = (float*)(shm + LDS_WS) + wid * 64;
    const int NT = 4 * (qb + 1);
    const bf16* ksrc0 = Kh + ((long)(NT - 1) * 64 + lane) * PITCH + wid * 8;
    const bf16* vsrc = Vh + ((long)(NT - 1) * 64 + 16 * (wid & 3) + (lane >> 2)) * 512 + (wid >> 2) * 32 + (lane & 3) * 8;
#define ATT_DMA(back, slotoff) do { const unsigned _d = (unsigned)__builtin_amdgcn_readfirstlane(lds0 + (slotoff)); \
        glds16(ksrc0 - (long)(back) * 64 * PITCH, _d + wid * 1024); if (wid < NX) glds16(ksrc0 - (long)(back) * 64 * PITCH + 64, _d + (8 + wid) * 1024); \
        glds16(vsrc - (long)(back) * 64 * 512, _d + KBYTES + wid * 1024); } while (0)
    ATT_DMA(0, 0); ATT_DMA(1, SLOT);
    bf16x8 qr[NK];
#pragma unroll
    for (int d0 = 0; d0 < NK; ++d0) qr[d0] = *reinterpret_cast<const bf16x8*>(&Qw[(long)r32 * PITCH + d0 * 16 + hi * 8]);
#pragma unroll
    for (int d0 = 0; d0 < NK; ++d0) asm volatile("" : "+v"(qr[d0]));
    asm volatile("s_waitcnt vmcnt(0)" ::: "memory");
    float mhat = 0.f, l_reg = 0.f; f32x16 o[2]; o[0] = f32x16{}; o[1] = f32x16{};
    constexpr bool CPERS = (DQK == 80);
    f32x16 cneg;
#pragma unroll
    for (int r = 0; r < 16; ++r) cneg[r] = 0.f;
    if constexpr (CPERS) asm volatile("" : "+v"(cneg));
    const int jdiag = wid >> 1;
    const lds_cptr kp0 = (lds_cptr)shm + hi * 1024 + r32 * 16;
    const lds_cptr vp0 = (lds_cptr)shm + KBYTES + ((lane >> 4) & 1) * 32 + (lane & 3) * 8 + (4 * hi + ((lane & 15) >> 2)) * 64;
    f32x16 p0, p1; s16x4 vlo[8], vhi[8];
#define ATT_A(slot) do { \
        bf16x8 kf[2 * NK]; \
        _Pragma("unroll") for (int d0 = 0; d0 < NK; ++d0) { kf[2 * d0] = *(const __attribute__((address_space(3))) bf16x8*)(kp0 + (slot) + d0 * 2048); kf[2 * d0 + 1] = *(const __attribute__((address_space(3))) bf16x8*)(kp0 + (slot) + d0 * 2048 + 512); } \
        __builtin_amdgcn_sched_barrier(0); \
        _Pragma("unroll") for (int i = 0; i < 8; ++i) { \
            vlo[i] = __builtin_bit_cast(s16x4, __builtin_amdgcn_ds_read_tr16_b64_v4i16((__attribute__((address_space(3))) v4i16_t*)(vp0 + (slot) + (i >> 2) * 4096 + (i & 3) * 1024))); \
            vhi[i] = __builtin_bit_cast(s16x4, __builtin_amdgcn_ds_read_tr16_b64_v4i16((__attribute__((address_space(3))) v4i16_t*)(vp0 + (slot) + (i >> 2) * 4096 + (i & 3) * 1024 + 512))); } \
        __builtin_amdgcn_sched_barrier(0); \
        _Pragma("unroll") for (int i = 0; i < 2 * NK; ++i) asm volatile("" : "+v"(kf[i])); \
        if constexpr (CPERS) { p0 = __builtin_amdgcn_mfma_f32_32x32x16_bf16(kf[0], qr[0], cneg, 0, 0, 0); p1 = __builtin_amdgcn_mfma_f32_32x32x16_bf16(kf[1], qr[0], cneg, 0, 0, 0); } \
        else { f32x16 c; _Pragma("unroll") for (int r = 0; r < 16; ++r) c[r] = -mhat; \
            p0 = __builtin_amdgcn_mfma_f32_32x32x16_bf16(kf[0], qr[0], c, 0, 0, 0); p1 = __builtin_amdgcn_mfma_f32_32x32x16_bf16(kf[1], qr[0], c, 0, 0, 0); } \
        _Pragma("unroll") for (int d0 = 1; d0 < NK; ++d0) { p0 = __builtin_amdgcn_mfma_f32_32x32x16_bf16(kf[2 * d0], qr[d0], p0, 0, 0, 0); p1 = __builtin_amdgcn_mfma_f32_32x32x16_bf16(kf[2 * d0 + 1], qr[d0], p1, 0, 0, 0); } \
        _Pragma("unroll") for (int i = 0; i < 8; ++i) { asm volatile("" : "+v"(vlo[i])); asm volatile("" : "+v"(vhi[i])); } \
        asm volatile("s_nop 15\n\ts_nop 7" : "+v"(p0), "+v"(p1));        \
    } while (0)
#define ATT_B(MODE) do { \
        if (MODE == 1) { int qrel = wid * 32 + r32; asm volatile("" : "+v"(qrel)); const int kb = 64 * jdiag + 4 * hi; \
            _Pragma("unroll") for (int r = 0; r < 16; ++r) { const int kv = kb + (r & 3) + 8 * (r >> 2); if (kv > qrel) p0[r] = -INFINITY; if (kv + 32 > qrel) p1[r] = -INFINITY; } } \
        float rm; \
        { float a0 = max3f(p0[0], p0[1], p1[0]), a1 = max3f(p0[2], p0[3], p1[1]), a2 = max3f(p0[4], p0[5], p1[2]), a3 = max3f(p0[6], p0[7], p1[3]); \
          a0 = max3f(a0, p0[8], p0[9]); a1 = max3f(a1, p0[10], p0[11]); a2 = max3f(a2, p0[12], p0[13]); a3 = max3f(a3, p0[14], p0[15]); \
          a0 = max3f(a0, p1[4], p1[5]); a1 = max3f(a1, p1[6], p1[7]); a2 = max3f(a2, p1[8], p1[9]); a3 = max3f(a3, p1[10], p1[11]); \
          a0 = max3f(a0, p1[12], p1[13]); a1 = max3f(a1, p1[14], p1[15]); rm = max2f(max2f(a0, a1), max2f(a2, a3)); } \
        asm volatile("s_nop 1" : "+v"(rm));                                     \
        { auto rr = __builtin_amdgcn_permlane32_swap(__float_as_uint(rm), __float_as_uint(rm), false, false); float r0_ = __uint_as_float(rr[0]), r1_ = __uint_as_float(rr[1]); asm volatile("s_nop 1" : "+v"(r0_), "+v"(r1_)); rm = max2f(r0_, r1_); } \
        if (MODE == 1) { mhat += rm; if constexpr (CPERS) { _Pragma("unroll") for (int r = 0; r < 16; ++r) cneg[r] = -mhat; asm volatile("" : "+v"(cneg)); } \
            _Pragma("unroll") for (int r = 0; r < 16; ++r) { p0[r] = fsub_s(p0[r], rm); p1[r] = fsub_s(p1[r], rm); } } \
        else if (__builtin_expect(__any(rm > THR), 0)) { const float dl = fmaxf(rm, 0.f); mhat += dl; if constexpr (CPERS) { _Pragma("unroll") for (int r = 0; r < 16; ++r) cneg[r] = -mhat; asm volatile("" : "+v"(cneg)); } \
            _Pragma("unroll") for (int r = 0; r < 16; ++r) { p0[r] = fsub_s(p0[r], dl); p1[r] = fsub_s(p1[r], dl); } \
            const float f = __builtin_amdgcn_exp2f(-dl); l_reg *= f; if (hi == 0) wsf[r32] = f; \
            asm volatile("s_waitcnt lgkmcnt(0)" ::: "memory"); \
            _Pragma("unroll") for (int r4 = 0; r4 < 4; ++r4) { const f32x4 fv = *(const f32x4*)(wsf + 8 * r4 + 4 * hi); \
                _Pragma("unroll") for (int j = 0; j < 4; ++j) { o[0][4 * r4 + j] = fmul_s(o[0][4 * r4 + j], fv[j]); o[1][4 * r4 + j] = fmul_s(o[1][4 * r4 + j], fv[j]); } } } \
        _Pragma("unroll") for (int r = 0; r < 16; ++r) { p0[r] = __builtin_amdgcn_exp2f(p0[r]); p1[r] = __builtin_amdgcn_exp2f(p1[r]); } \
        asm volatile("s_nop 1" : "+v"(p0), "+v"(p1));                      \
        float sa0 = 0.f, sa1 = 0.f, sa2 = 0.f, sa3 = 0.f; \
        _Pragma("unroll") for (int r = 0; r < 16; r += 4) { \
            sa0 = fadd_s(sa0, p0[r]); sa1 = fadd_s(sa1, p0[r + 1]); sa2 = fadd_s(sa2, p0[r + 2]); sa3 = fadd_s(sa3, p0[r + 3]); \
            sa0 = fadd_s(sa0, p1[r]); sa1 = fadd_s(sa1, p1[r + 1]); sa2 = fadd_s(sa2, p1[r + 2]); sa3 = fadd_s(sa3, p1[r + 3]); } \
        l_reg += fadd_s(fadd_s(sa0, sa1), fadd_s(sa2, sa3)); \
        u32x4 pw[4]; \
        _Pragma("unroll") for (int j = 0; j < 4; ++j) { pw[0][j] = cvtpk(p0[2 * j], p0[2 * j + 1]); pw[1][j] = cvtpk(p0[8 + 2 * j], p0[8 + 2 * j + 1]); pw[2][j] = cvtpk(p1[2 * j], p1[2 * j + 1]); pw[3][j] = cvtpk(p1[8 + 2 * j], p1[8 + 2 * j + 1]); } \
        asm volatile("s_nop 3" : "+v"(pw[0]), "+v"(pw[1]), "+v"(pw[2]), "+v"(pw[3]), "+v"(o[0]), "+v"(o[1]));     \
        _Pragma("unroll") for (int ks = 0; ks < 4; ++ks) _Pragma("unroll") for (int d0 = 0; d0 < 2; ++d0) { const int i = d0 * 4 + ks; \
            const bf16x8 vf = (bf16x8){vlo[i][0], vlo[i][1], vlo[i][2], vlo[i][3], vhi[i][0], vhi[i][1], vhi[i][2], vhi[i][3]}; \
            o[d0] = __builtin_amdgcn_mfma_f32_32x32x16_bf16(__builtin_bit_cast(bf16x8, pw[ks]), vf, o[d0], 0, 0, 0); } \
    } while (0)
#define ATT_SYNC(k) do { if ((k) + 1 < NT) { if (wid < NX) ATT_WAIT_BAR(3); else ATT_WAIT_BAR(2); } else ATT_WAIT_BAR(0); } while (0)
    const bool late = wid >= 4;
    if (late) { ATT_SYNC(0); ATT_DMA(2, 2 * SLOT); }
#pragma unroll
    for (int s = 0; s < 4; ++s) {
        if (!late) { ATT_SYNC(s); if (s + 2 < NT) ATT_DMA(s + 2, ((s + 2) % 3) * SLOT); }
        const int jb = 3 - s;
        if (jb <= jdiag) ATT_A((s % 3) * SLOT);
        if (late && s + 1 < NT) { ATT_SYNC(s + 1); if (s + 3 < NT) ATT_DMA(s + 3, (s % 3) * SLOT); }
        if (jb == jdiag) ATT_B(1); else if (jb < jdiag) ATT_B(0);
    }
    int slot = SLOT, slot2 = 0;
#pragma unroll 1
    for (int s = 4; s < NT; ++s) {
        if (!late) { ATT_SYNC(s); if (s + 2 < NT) ATT_DMA(s + 2, slot2); }
        ATT_A(slot);
        if (late && s + 1 < NT) { ATT_SYNC(s + 1); if (s + 3 < NT) ATT_DMA(s + 3, slot); }
        ATT_B(0);
        slot = (slot == 2 * SLOT) ? 0 : slot + SLOT; slot2 = (slot2 == 2 * SLOT) ? 0 : slot2 + SLOT;
    }
#undef ATT_SYNC
#undef ATT_A
#undef ATT_B
    { auto rr = __builtin_amdgcn_permlane32_swap(__float_as_uint(l_reg), __float_as_uint(l_reg), false, false); l_reg = __uint_as_float(rr[0]) + __uint_as_float(rr[1]); }
    if (hi == 0) wsf[32 + r32] = l_reg; asm volatile("s_waitcnt lgkmcnt(0)" ::: "memory");
    float rli[16];
#pragma unroll
    for (int r = 0; r < 16; ++r) rli[r] = __builtin_amdgcn_rcpf(wsf[32 + crow(r, hi)]);
    bf16* Ow = O + (rowbase + q0 + wid * 32) * O_P + h * 64;
    { bf16* stg = (bf16*)(shm + LDS_OST) + wid * 2048;
#pragma unroll
      for (int r = 0; r < 16; ++r) { const int orow = crow(r, hi);
#pragma unroll
          for (int d0 = 0; d0 < 2; ++d0) stg[orow * 64 + d0 * 32 + r32] = (bf16)f2bf(o[d0][r] * rli[r]); }
      asm volatile("s_waitcnt lgkmcnt(0)" ::: "memory");
#pragma unroll
      for (int i = 0; i < 4; ++i) { const int row = i * 8 + (lane >> 3), ch = lane & 7; const u32x4 v = *(const u32x4*)(stg + row * 64 + ch * 8); *(u32x4*)(Ow + (long)row * O_P + ch * 8) = v;
          float ss = 0.f;
#pragma unroll
          for (int j = 0; j < 4; ++j) { const float lo_ = bf2f(v[j] & 0xffffu), hi_ = bf2f(v[j] >> 16); ss += lo_ * lo_ + hi_ * hi_; }
          ss += __shfl_xor(ss, 1); ss += __shfl_xor(ss, 2); ss += __shfl_xor(ss, 4);
          if (ch == 0) SSQO[(size_t)(rowbase + q0 + wid * 32 + row) * 16 + h] = ss; } }
    asm volatile("s_waitcnt lgkmcnt(0)\n\ts_barrier" ::: "memory");
#undef ATT_DMA
}
}

constexpr int PH_PRO = 0, PH_L0 = 1, PH_L1 = 11, PH_MOE = 19, PH_FINAL = 22, N_PHASES = 23;

__device__ __forceinline__ void weights_phase(Frame& F, const Args& args) {
    unsigned char* ws = args.ws;
#pragma unroll 1
    for (int l = 0; l < 2; ++l) {
        conv_matrix(F, SrcWin{args.in[6] + (size_t)l * 1024 * 1960, 1960}, 1024, 1024, INC, (bf16*)(ws + WS_WIN) + (size_t)l * INC * 1024, 1024 * l);
        conv_matrix(F, SrcWuq{args.in[8] + (size_t)l * 256 * 768, 768, args.in[7] + l * 256}, 256, 256, 768, (bf16*)(ws + WS_WUQ) + (size_t)l * 768 * 256, 96 * l);
        conv_matrix(F, SrcWukv{args.in[10] + (size_t)l * 128 * 1024, 1024, args.in[9] + l * 128}, 128, 128, 1024, (bf16*)(ws + WS_WUKV) + (size_t)l * 1024 * 128, 192 + 64 * l);
    }
    __syncthreads();
#pragma unroll 1
    for (int l = 0; l < 2; ++l)
        conv_matrix_wg<SrcPlainG, false>(F, SrcPlainG{args.in[14] + (size_t)l * 1024 * 1024, 1024, args.in[12] + l * 512, args.in[13] + l * 512}, 1024, 1024, 1024, ws + WS_WO + (size_t)l * 1024 * 1024 * 2, 1.f, 40 + 64 * l);
    conv_matrix_wg<SrcGU, true>(F, SrcGU{args.in[16], args.in[17], FF}, 1024, 1024, 2 * FF, ws + WS_WGU0, SC_WGU, 168);
    conv_matrix_wg<SrcPlain, true>(F, SrcPlain{args.in[18], 1024}, FF, FF, 1024, ws + WS_WD0, SC_WD, 136);
}

__global__ void __launch_bounds__(NWAVES * 64, 2) fwd_kernel(Args args) {
    extern __shared__ __attribute__((aligned(16))) unsigned char lds[];
    Frame F;
    F.lds = (LAS unsigned char*)lds;
    F.tid = threadIdx.x; F.lane = F.tid & 63; F.wave = __builtin_amdgcn_readfirstlane(F.tid >> 6);
    F.G = gridDim.x; { const int bx = blockIdx.x; F.vcu = (F.G % 8 == 0) ? (bx % 8) * (F.G / 8) + bx / 8 : bx; }
    F.ws = args.ws;
    unsigned char* ws = args.ws;
    for (int u = F.tid; u < (LDS_BYTES - LDSCTL_OFF) / 4; u += NWAVES * 64) ((LAS unsigned*)(F.lds + LDSCTL_OFF))[u] = 0u;
    __syncthreads();
#if MK_ONE_LAUNCH
    XcdBarrier bar = xcd_barrier_post((unsigned*)(ws + WS_CTL) + CW_BAR, (volatile LAS unsigned*)(F.lds + MISC_OFF) + 8);
#define SEAM(k) do { if (lo <= (k) && (k) + 1 < hi) xcd_barrier(bar); } while (0)
#else
#define SEAM(k) do { } while (0)
#endif
    const int lo = args.ph_lo, hi = args.ph_hi;
#ifndef PHSEL
#define PHSEL 0xFFFFu
#endif
#define IN(k) (lo <= (k) && (k) < hi)
#define SEL(kind) (((PHSEL) >> (kind)) & 1u)

#define FRESH() do { int t_ = threadIdx.x; asm volatile("" : "+v"(t_)); F.tid = t_; F.lane = t_ & 63; F.wave = __builtin_amdgcn_readfirstlane(t_ >> 6); } while (0)
#define INP(k) (args.in[k])
#define WSP(T, off) ((T*)(ws + (off)))
    float* X = args.out;

    if (SEL(0) && IN(PH_PRO)) { FRESH();
        rope_phase(F, (const int*)INP(2), WSP(float, WS_ROPE));
        mod_phase(F, INP(1), INP(3), INP(4), WSP(float, WS_MOD));
    }
    SEAM(PH_PRO);

#define LAYER_MIXER(l, pb) do { \
          \
        if (SEL(1) && IN(pb + 0)) { FRESH(); \
            if (l == 0) { norm_phase<false, false>(F, INP(0), INP(5), WSP(float, WS_MOD), 0, WSP(bf16, WS_XN), nullptr, nullptr, nullptr, nullptr, nullptr, nullptr, nullptr); weights_phase(F, args); } \
            else norm_phase<false, true>(F, X, INP(5) + 1024, WSP(float, WS_MOD) + (size_t)8 * 6144, 0, WSP(bf16, WS_XN), nullptr, nullptr, nullptr, nullptr, WSP(bf16, WS_T2), WSP(float, WS_MOD) + 5 * 1024, X); } \
        SEAM(pb + 0); \
          \
        if (SEL(2) && IN(pb + 1)) { \
            pg8::Gemm g{WSP(bf16, WS_XN), WSP(bf16, WS_WIN) + (size_t)l * INC * 1024, 1024, 0, nullptr}; pg8::StaticOrder S; S.init(M, INC, F.G, (int)blockIdx.x); \
            pg8::EpiInproj E{WSP(bf16, WS_CQN), WSP(bf16, WS_CKVN), WSP(bf16, WS_KM), WSP(float, WS_SSQQ), WSP(float, WS_SSQKV), WSP(float, WS_FLOG), WSP(float, WS_ROPE), WSP(bf16, WS_QF), WSP(bf16, WS_KF), WSP(bf16, WS_VF)}; \
            pg8::gemm_phase<pg8::EpiInproj, pg8::StaticOrder, true, true>(F.lds, g, S, E); } \
        SEAM(pb + 1); \
          \
        if (SEL(4) && IN(pb + 3)) { FRESH(); scan_phase(F, WSP(float, WS_FLOG), INP(11) + l * 8, WSP(bf16, WS_QF), WSP(bf16, WS_KF)); \
            { pg8::Gemm g{WSP(bf16, WS_CQN), WSP(bf16, WS_WUQ) + (size_t)l * 768 * 256, 256, 0, nullptr}; pg8::StaticOrder S; S.init(M, 768, F.G, (int)blockIdx.x); \
              pg8::EpiQ E{WSP(bf16, WS_QM), WSP(float, WS_ROPE), WSP(float, WS_SSQQ)}; pg8::gemm_phase<pg8::EpiQ, pg8::StaticOrder, true, true>(F.lds, g, S, E); } \
            { int kkv = 128; asm volatile("" : "+s"(kkv)); pg8::Gemm g{WSP(bf16, WS_CKVN), WSP(bf16, WS_WUKV) + (size_t)l * 1024 * 128, kkv, 0, nullptr}; pg8::StaticOrder S; S.init(M, 1024, F.G, (int)blockIdx.x); \
              pg8::EpiKV E{WSP(bf16, WS_KM), WSP(bf16, WS_VM), WSP(float, WS_SSQKV)}; pg8::gemm_phase<pg8::EpiKV, pg8::StaticOrder, true, true>(F.lds, g, S, E); } } \
        SEAM(pb + 3); \
          \
        if (SEL(5) && IN(pb + 4)) { \
            const int bh = F.vcu >> 2, s4 = F.vcu & 3, b = bh >> 3, h = bh & 7; \
            _Pragma("unroll 1") for (int i = 0; i < 4; ++i) { const int p = (i & 2) ? 7 - s4 : s4, qb = (i & 1) ? 15 - p : p; \
                att::attn_unit<96>(WSP(bf16, WS_QM), WSP(bf16, WS_KM), WSP(bf16, WS_VM), WSP(bf16, WS_O), WSP(float, WS_SSQO), b, h, qb, (char*)lds); } \
            _Pragma("unroll 1") for (int i = 0; i < 4; ++i) { const int p = (i & 2) ? 7 - s4 : s4, qb = (i & 1) ? 15 - p : p; \
                att::attn_unit<80>(WSP(bf16, WS_QF), WSP(bf16, WS_KF), WSP(bf16, WS_VF), WSP(bf16, WS_O) + 512, WSP(float, WS_SSQO) + 8, b, h, qb, (char*)lds); } } \
        SEAM(pb + 4); \
          \
        if (SEL(7) && IN(pb + 6)) { \
            pg8::Gemm g{WSP(bf16, WS_O), WSP(bf16, WS_WO) + (size_t)l * 1024 * 1024, 1024, 0, nullptr}; pg8::StaticOrder S; S.init(M, 1024, F.G, (int)blockIdx.x); \
            pg8::EpiWo E{WSP(bf16, WS_T1), WSP(float, WS_SSQO)}; \
            pg8::gemm_phase<pg8::EpiWo, pg8::StaticOrder, true, true>(F.lds, g, S, E); } \
        SEAM(pb + 6); \
    } while (0)

    LAYER_MIXER(0, PH_L0);
    if (SEL(8) && IN(PH_L0 + 7)) { FRESH(); norm_phase<false, true, true>(F, INP(0), INP(15), WSP(float, WS_MOD), 3, WSP(bf16, WS_XN8), nullptr, nullptr, nullptr, nullptr, WSP(bf16, WS_T1), WSP(float, WS_MOD) + 2 * 1024, X); }
    SEAM(PH_L0 + 7);
    if (SEL(9) && IN(PH_L0 + 8)) {
        pg8::Gemm g{WSP(bf16, WS_XN8), WSP(bf16, WS_WGU0), 512, 0, nullptr}; pg8::StaticOrder S; S.init(M, 2 * FF, F.G, (int)blockIdx.x);
        pg8::EpiSwigluF8 E{WSP(unsigned char, WS_H0)}; pg8::gemm_phase<pg8::EpiSwigluF8, pg8::StaticOrder, true, true, false, true>(F.lds, g, S, E);
    }
    SEAM(PH_L0 + 8);
    if (SEL(10) && IN(PH_L0 + 9)) {
        pg8::Gemm g{WSP(bf16, WS_H0), WSP(bf16, WS_WD0), FF / 2, 0, nullptr}; pg8::StaticOrder S; S.init(M, 1024, F.G, (int)blockIdx.x);
        pg8::EpiBf16Plain E{WSP(bf16, WS_T2), DM, 1.f / (SC_H * SC_WD)}; pg8::gemm_phase<pg8::EpiBf16Plain, pg8::StaticOrder, true, true, false, true>(F.lds, g, S, E);
    }
    SEAM(PH_L0 + 9);
    LAYER_MIXER(1, PH_L1);
    if (SEL(8) && IN(PH_L1 + 7)) { FRESH();
        norm_phase<true, true>(F, X, INP(15) + 1024, WSP(float, WS_MOD) + (size_t)8 * 6144, 3, WSP(bf16, WS_XN8), INP(19), WSP(int, WS_TOKE), WSP(float, WS_TOKW), WSP(unsigned, WS_CNT), WSP(bf16, WS_T1), WSP(float, WS_MOD) + (size_t)8 * 6144 + 2 * 1024, X);
#pragma unroll 1
        for (int e = 0; e < NE; ++e) {
            conv_matrix_wg<SrcGU, true>(F, SrcGU{INP(20) + (size_t)e * 1024 * FF, INP(21) + (size_t)e * 1024 * FF, FF}, 1024, 1024, 2 * FF, WSP(unsigned char, WS_WGU8) + (size_t)e * 2 * FF * 1024, SC_WGU);
            conv_matrix_wg<SrcPlain, true>(F, SrcPlain{INP(22) + (size_t)e * FF * 1024, 1024}, FF, FF, 1024, WSP(unsigned char, WS_WD8) + (size_t)e * 1024 * FF, SC_WD);
        }
    }
    SEAM(PH_L1 + 7);
    if (SEL(11) && IN(PH_MOE)) { FRESH(); route_phase(F, WSP(unsigned, WS_CNT), WSP(int, WS_TOKE), WSP(int, WS_ROWTOK), WSP(int, WS_TOKSLOT), WSP(int, WS_TEXP)); }
    SEAM(PH_MOE);
    if (SEL(11) && IN(PH_MOE + 1)) { const int* texp = WSP(int, WS_TEXP); const int ntile = __builtin_amdgcn_readfirstlane(texp[0]);
        pg8::Gemm g{WSP(bf16, WS_XN8), WSP(bf16, WS_WGU8), 512, (size_t)2 * FF * 1024, WSP(int, WS_ROWTOK)};
        pg8::MoeOrder S; S.init(ntile * 256, 2 * FF, F.G, (int)blockIdx.x); S.load(texp);
        pg8::EpiSwigluF8 E{WSP(unsigned char, WS_H8)}; pg8::gemm_phase<pg8::EpiSwigluF8, pg8::MoeOrder, true, true, true, true>(F.lds, g, S, E); }
    SEAM(PH_MOE + 1);
    if (SEL(12) && IN(PH_MOE + 2)) { const int* texp = WSP(int, WS_TEXP); const int ntile = __builtin_amdgcn_readfirstlane(texp[0]);
        pg8::Gemm g{(const bf16*)WSP(unsigned char, WS_H8), WSP(bf16, WS_WD8), FF / 2, (size_t)1024 * FF, nullptr};
        pg8::MoeOrderD S; S.init_d(ntile, FF / 128, F.G, (int)blockIdx.x); S.load(texp);
        pg8::EpiMoeY E{WSP(bf16, WS_Y), WSP(bf16, WS_YP), S.mainM * 256, (size_t)(ntile - S.mainM) * 256 * DM, 1.f / (SC_H * SC_WD)};
        pg8::gemm_phase<pg8::EpiMoeY, pg8::MoeOrderD, true, true, false, true, true>(F.lds, g, S, E); }
    SEAM(PH_MOE + 2);
    if (SEL(13) && IN(PH_FINAL)) { FRESH(); final_phase(F, X, INP(23), WSP(bf16, WS_Y), WSP(bf16, WS_YP), WSP(int, WS_TEXP), WSP(int, WS_TOKSLOT), WSP(float, WS_TOKW), WSP(float, WS_MOD) + (size_t)8 * 6144 + 5 * 1024); }
#undef IN
#undef SEAM
}

extern "C" void kernel_launch(void* const* d_in, const int* in_sizes, int n_in, void* d_out, int out_size, void* d_ws, size_t ws_size, hipStream_t stream) {
    static int grid = 0;
    if (grid == 0) {
        if (n_in != 24 || out_size != M * DM || ws_size < WS_END) { fprintf(stderr, "kernel_launch: unexpected shapes (n_in %d out %d ws %zu)\n", n_in, out_size, ws_size); grid = -1; return; }
        int dev = 0, cus = 0, per_cu = 0;
        if (hipGetDevice(&dev) != hipSuccess || hipDeviceGetAttribute(&cus, hipDeviceAttributeMultiprocessorCount, dev) != hipSuccess) { grid = -1; return; }
        if (hipFuncSetAttribute((const void*)fwd_kernel, hipFuncAttributeMaxDynamicSharedMemorySize, LDS_BYTES) != hipSuccess) { fprintf(stderr, "kernel_launch: hipFuncSetAttribute failed\n"); grid = -1; return; }
        if (hipOccupancyMaxActiveBlocksPerMultiprocessor(&per_cu, (const void*)fwd_kernel, NWAVES * 64, LDS_BYTES) != hipSuccess || per_cu < 1)
            fprintf(stderr, "kernel_launch: occupancy query reports %d\n", per_cu);
        (void)hipGetLastError();
        grid = cus;
        if (grid != 256) fprintf(stderr, "kernel_launch: %d CUs (built for 256)\n", grid);
    }
    if (grid < 0) return;
    (void)hipMemsetAsync((char*)d_ws + WS_CTL, 0, CTL_ZERO_BYTES, stream);
    Args a{};
    for (int i = 0; i < 24; ++i) a.in[i] = (const float*)d_in[i];
    a.out = (float*)d_out; a.ws = (unsigned char*)d_ws;
#if MK_ONE_LAUNCH
    a.ph_lo = 0; a.ph_hi = N_PHASES;
    hipLaunchKernelGGL(fwd_kernel, dim3(grid), dim3(NWAVES * 64), LDS_BYTES, stream, a);
#else
    for (int p = 0; p < N_PHASES; ++p) { a.ph_lo = p; a.ph_hi = p + 1; hipLaunchKernelGGL(fwd_kernel, dim3(grid), dim3(NWAVES * 64), LDS_BYTES, stream, a); }
#endif
}
```

```cpp
#include <hip/hip_runtime.h>
#include <cstdio>
#include <cstdint>
#include <cmath>

#ifndef MK_ONE_LAUNCH
#define MK_ONE_LAUNCH 1
#endif

#define GAS __attribute__((address_space(1)))
#define LAS __attribute__((address_space(3)))
typedef unsigned short bf16;
typedef unsigned v4u __attribute__((ext_vector_type(4)));
typedef unsigned v2u __attribute__((ext_vector_type(2)));
typedef float f32x4 __attribute__((ext_vector_type(4)));
typedef float f32x2 __attribute__((ext_vector_type(2)));
typedef short bf16x8 __attribute__((ext_vector_type(8)));
typedef GAS unsigned gu32;
typedef int v8i __attribute__((ext_vector_type(8)));
typedef int v4i __attribute__((ext_vector_type(4)));
typedef v8i v8i_a16 __attribute__((aligned(16)));

constexpr int NB = 8, SEQ = 4096, DM = 1024, M = NB * SEQ, NH = 8, FF = 3584, NE = 8;
constexpr int INC = 2048;
constexpr int PA_P = 512, QM_P = 768, KM_P = 768, VM_P = 512, QF_P = 640, KF_P = 640, VF_P = 512, O_P = 1024;
constexpr float LOG2E = 1.4426950408889634f;
constexpr float C2M = 0.10206207261596575f * LOG2E;
constexpr float C2F = 0.125f * LOG2E;
constexpr float EPS = 1e-6f;

constexpr size_t MiB = 1u << 20;
constexpr size_t WS_CTL = 0, CTL_ZERO_BYTES = 1 * MiB;
constexpr size_t WS_MOD = 1 * MiB;
constexpr size_t WS_WIN = 4 * MiB, WS_WUQ = 12 * MiB, WS_WUKV = 13 * MiB, WS_WO = 14 * MiB, WS_WGU0 = 18 * MiB, WS_WD0 = 32 * MiB;
constexpr size_t WS_XN = 40 * MiB;
constexpr size_t WS_R = 104 * MiB;
constexpr size_t WS_PA = WS_R, WS_CQN = 168 * MiB, WS_CKVN = 184 * MiB, WS_QM = 200 * MiB, WS_KM = 248 * MiB, WS_VM = 296 * MiB,
                 WS_QF = 328 * MiB, WS_KF = 368 * MiB, WS_VF = 408 * MiB, WS_O = 440 * MiB, WS_ROPE = 504 * MiB;
constexpr size_t WS_SSQQ = WS_PA, WS_SSQKV = WS_PA + 1 * MiB, WS_FLOG = WS_PA + 2 * MiB, WS_SSQO = WS_PA + 4 * MiB;
constexpr size_t WS_H0 = WS_R;
constexpr size_t WS_WGU8 = WS_R, WS_WD8 = 160 * MiB, WS_H8 = 192 * MiB;
constexpr size_t WS_XN8 = WS_XN;
constexpr int MOE_MAXTILE = 136, MOE_MAXROW = MOE_MAXTILE * 256;
constexpr size_t H8_ROUND = (size_t)MOE_MAXROW * FF;
constexpr float SC_WGU = 32.f, SC_WD = 64.f, SC_H = 4.f;
constexpr size_t WS_T1 = 200 * MiB, WS_T2 = 328 * MiB;
constexpr size_t WS_YP = WS_R;
constexpr size_t WS_Y = 432 * MiB;
constexpr size_t WS_RT = 570 * MiB;
constexpr size_t WS_ROWTOK = WS_RT, WS_TOKSLOT = WS_RT + 512 * 1024, WS_TOKE = WS_RT + 1024 * 1024, WS_TOKW = WS_RT + 1280 * 1024, WS_CNT = WS_RT + 1536 * 1024, WS_TEXP = WS_RT + 1600 * 1024;
constexpr size_t WS_END = 572 * MiB;
constexpr int LCNT_OFF = 126976;
constexpr int CW_BAR = 4096;

constexpr int RING_BYTES = 131072;
constexpr int LDSCTL_OFF = RING_BYTES, MISC_OFF = LDSCTL_OFF + 320;
constexpr int LDS_BYTES = 147456;
constexpr int NWAVES = 8;

#define LDS_WAIT() asm volatile("s_waitcnt lgkmcnt(0)" ::: "memory")
#define VM_WAIT() asm volatile("s_waitcnt vmcnt(0)" ::: "memory")
__device__ __forceinline__ unsigned f2bf(float f) { unsigned u = __builtin_bit_cast(unsigned, f); return (u + 0x7fffu + ((u >> 16) & 1u)) >> 16; }
__device__ __forceinline__ unsigned pk2(float lo, float hi) { return f2bf(lo) | (f2bf(hi) << 16); }
__device__ __forceinline__ float bf2f(unsigned h) { return __builtin_bit_cast(float, h << 16); }
__device__ __forceinline__ float wave_sum(float v) {
#pragma unroll
    for (int o = 1; o < 64; o <<= 1) v += __shfl_xor(v, o);
    return v;
}

namespace pg8 {
#define PG8_LAS __attribute__((address_space(3)))
typedef unsigned short bf16_t;
typedef unsigned u32x4 __attribute__((ext_vector_type(4)));
constexpr int BM = 256, BK = 64, HALF = 128, HTB = HALF * BK * 2, STAGE_BYTES = 8 * HTB, NXCD = 8, WGM = 8;

__host__ __device__ __forceinline__ int lds_byte(int r, int c) { const int st = (r >> 4) * 2 + (c >> 5), rr = r & 15, cc = c & 31, ob = rr * 64 + cc * 2; return st * 1024 + (ob ^ (((ob >> 9) & 1) << 5)); }
__host__ __device__ __forceinline__ void stage_rc(int b, int& R, int& C) { const int st = b / 1024, sb = b % 1024, swz = sb ^ (((sb >> 9) & 1) << 5); R = (st >> 1) * 16 + swz / 64; C = (st & 1) * 32 + (swz % 64) / 2; }
__host__ __device__ __forceinline__ int perm32(int rho) { const int n = rho >> 4, i = rho & 15; return 8 * (i >> 2) + 4 * n + (i & 3); }

struct Unit { int pm, pn, bsel, part, nt; };
struct Gemm { const bf16_t* A; const bf16_t* Bt; int K; size_t bstride; const int* rowidx; };

struct StaticOrder {
    int nM, nN, nwg, G, c;
    __host__ __device__ void init(int M_, int N_, int G_, int c_) { nM = M_ / BM; nN = N_ / BM; nwg = nM * nN; G = G_; c = c_; }
    __host__ __device__ bool next(int i, Unit& u) const {
        const long L = (long)i * G + c; if (L >= nwg) return false;
        int wgid = (int)L; { const int q = nwg / NXCD, r = nwg % NXCD, xcd = wgid % NXCD, off = wgid / NXCD; wgid = (xcd < r ? xcd * (q + 1) : r * (q + 1) + (xcd - r) * q) + off; }
        const int nig = WGM * nN, gid = wgid / nig, fm = gid * WGM, gsz = (nM - fm) < WGM ? (nM - fm) : WGM;
        u.pm = fm + ((wgid % nig) % gsz); u.pn = (wgid % nig) / gsz; u.bsel = 0; u.part = 0; u.nt = 0; return true;
    }
};

__device__ __forceinline__ unsigned cvt_pk_bf16(float lo, float hi) { unsigned r; asm volatile("v_cvt_pk_bf16_f32 %0, %1, %2" : "=v"(r) : "v"(lo), "v"(hi)); return r; }

template <class Epi, class Sched, bool ALIGN_EPI = false, bool SP2 = false, bool GATHER = false, bool F8 = false, bool SPLITK = false>
__device__ __forceinline__ void gemm_phase(PG8_LAS unsigned char* lds, const Gemm g, const Sched& S, const Epi& E) {
    int tid_ = threadIdx.x; asm volatile("" : "+v"(tid_));
    const int tid = tid_, wid = __builtin_amdgcn_readfirstlane(tid >> 6), lane = tid & 63, wr = wid >> 2, wc = wid & 3, fr = lane & 15, fq = lane >> 4;
    const int K = g.K, nt = K / BK;
    unsigned voffA[2], voffB[2];
#pragma unroll
    for (int i = 0; i < 2; ++i) { int R, C; stage_rc(tid * 16 + i * 8192, R, C); const int Rb = Epi::PERM ? ((R & ~31) + perm32(R & 31)) : R;
        voffA[i] = (unsigned)(R * K + C) * 2u; voffB[i] = (unsigned)(Rb * K + C) * 2u; }
    asm volatile("" : "+v"(voffA[0]), "+v"(voffA[1]), "+v"(voffB[0]), "+v"(voffB[1]));
    const size_t kstep = (size_t)(BK * 2);
    const size_t hstep = (size_t)HALF * K * 2;
    const size_t tstep = 2 * hstep;
    const unsigned ldsw = (unsigned)wid * 1024u;
    int aoff = lds_byte(wr * 64 + fr, fq * 8), boff = lds_byte(wc * 32 + fr, fq * 8);
    asm volatile("" : "+v"(aoff), "+v"(boff));
#define PG8_SA(b, h) (((b) * 2 + (h)) * HTB)
#define PG8_SB(b, h) ((4 + (b) * 2 + (h)) * HTB)
#define PG8_STAGE(bufoff, gbase, voff) do { _Pragma("unroll") for (int _i = 0; _i < 2; ++_i) \
        __builtin_amdgcn_global_load_lds((const unsigned*)((const char*)(gbase) + (voff)[_i]), (PG8_LAS unsigned*)(lds + (bufoff) + ldsw + _i * 8192), 16, 0, 0); } while (0)
    unsigned gofC[2][2] = {{0u, 0u}, {0u, 0u}}, gofN[2][2] = {{0u, 0u}, {0u, 0u}}; int gR[2] = {0, 0}; unsigned gC[2] = {0u, 0u};
    if constexpr (GATHER) {
#pragma unroll
        for (int i = 0; i < 2; ++i) { int R, C; stage_rc(tid * 16 + i * 8192, R, C); gR[i] = R; gC[i] = (unsigned)C * 2u; }
        asm volatile("" : "+v"(gR[0]), "+v"(gR[1]), "+v"(gC[0]), "+v"(gC[1]));
    }
#define PG8_GOF(dst, unit) do { _Pragma("unroll") for (int _h = 0; _h < 2; ++_h) _Pragma("unroll") for (int _i = 0; _i < 2; ++_i) { int _t = g.rowidx[(unit).pm * BM + _h * HALF + gR[_i]]; _t = _t < 0 ? 0 : _t; \
        dst[_h][_i] = (unsigned)_t * (unsigned)(K * 2) + gC[_i]; } } while (0)
#define PG8_GTOK(dst, unit) do { _Pragma("unroll") for (int _h = 0; _h < 2; ++_h) _Pragma("unroll") for (int _i = 0; _i < 2; ++_i) dst[_h][_i] = (unsigned)g.rowidx[(unit).pm * BM + _h * HALF + gR[_i]]; } while (0)
#define PG8_GCVT(dst) do { _Pragma("unroll") for (int _h = 0; _h < 2; ++_h) _Pragma("unroll") for (int _i = 0; _i < 2; ++_i) { int _t = (int)dst[_h][_i]; _t = _t < 0 ? 0 : _t; dst[_h][_i] = (unsigned)_t * (unsigned)(K * 2) + gC[_i]; } } while (0)
#define PG8_STAGE_A(bufoff, tptr, h, kb, nx) do { if constexpr (GATHER) { _Pragma("unroll") for (int _i = 0; _i < 2; ++_i) { const unsigned _o = (nx) ? gofN[h][_i] : gofC[h][_i]; \
        __builtin_amdgcn_global_load_lds((const unsigned*)((const char*)g.A + (kb) + _o), (PG8_LAS unsigned*)(lds + (bufoff) + ldsw + _i * 8192), 16, 0, 0); } } \
        else PG8_STAGE(bufoff, (tptr) + (h) * hstep, voffA); } while (0)
#define PG8_LD32(p) __builtin_shufflevector(*(const PG8_LAS v4i*)(p), *(const PG8_LAS v4i*)((p) + 1024), 0, 1, 2, 3, 4, 5, 6, 7)
#define PG8_LDA(dst, b, h) do { if constexpr (F8) { _Pragma("unroll") for (int m = 0; m < 4; ++m) dst##8[m] = PG8_LD32(lds + PG8_SA(b, h) + aoff + m * 2048); } \
        else { _Pragma("unroll") for (int m = 0; m < 4; ++m) _Pragma("unroll") for (int k = 0; k < 2; ++k) dst[m][k] = *(const PG8_LAS bf16x8*)(lds + PG8_SA(b, h) + aoff + m * 2048 + k * 1024); } } while (0)
#define PG8_LDB(dst, b, h) do { if constexpr (F8) { _Pragma("unroll") for (int n = 0; n < 2; ++n) dst##8[n] = PG8_LD32(lds + PG8_SB(b, h) + boff + n * 2048); } \
        else { _Pragma("unroll") for (int n = 0; n < 2; ++n) _Pragma("unroll") for (int k = 0; k < 2; ++k) dst[n][k] = *(const PG8_LAS bf16x8*)(lds + PG8_SB(b, h) + boff + n * 2048 + k * 1024); } } while (0)
#define PG8_MMA(ai, bj, At, Bt) do { __builtin_amdgcn_s_setprio(1); if constexpr (F8) { _Pragma("unroll") for (int m = 0; m < 4; ++m) _Pragma("unroll") for (int n = 0; n < 2; ++n) \
            asm volatile("v_mfma_scale_f32_16x16x128_f8f6f4 %0, %1, %2, %0, %3, %4 op_sel_hi:[0,0,0]" : "+v"(acc[ai][bj][m][n]) : "v"(Bt##8[n]), "v"(At##8[m]), "v"((bj) == 0 ? f8scl : f8scl1), "v"(f8one)); } \
        else { _Pragma("unroll") for (int m = 0; m < 4; ++m) _Pragma("unroll") for (int n = 0; n < 2; ++n) _Pragma("unroll") for (int k = 0; k < 2; ++k) \
            acc[ai][bj][m][n] = __builtin_amdgcn_mfma_f32_16x16x32_bf16(Bt[n][k], At[m][k], acc[ai][bj][m][n], 0, 0, 0); } __builtin_amdgcn_s_setprio(0); } while (0)
#define PG8_WAIT_V(n) asm volatile("s_waitcnt vmcnt(" #n ")" ::: "memory")
#define PG8_WAIT_L(n) asm volatile("s_waitcnt lgkmcnt(" #n ")" ::: "memory")
#define PG8_WAIT_V8P(post) do { if (post) asm volatile("s_waitcnt vmcnt(%0)" :: "n"(8 + Epi::NS) : "memory"); else asm volatile("s_waitcnt vmcnt(8)" ::: "memory"); } while (0)
#define PG8_BAR __builtin_amdgcn_s_barrier()
#define PG8_SCHED __builtin_amdgcn_sched_barrier(0)
    Unit cur, nxt; int ui = 0;
    if (!S.next(0, cur)) return;
    f32x4 acc[2][2][4][2];
#pragma unroll
    for (int a = 0; a < 2; ++a)
#pragma unroll
        for (int b = 0; b < 2; ++b)
#pragma unroll
            for (int m = 0; m < 4; ++m)
#pragma unroll
                for (int n = 0; n < 2; ++n) acc[a][b][m][n] = (f32x4){0.f, 0.f, 0.f, 0.f};
    bf16x8 At[4][2], B0[2][2], B1[2][2]; v8i At8[4], B08[2], B18[2];
    int f8scl = 0x7F7F7F7F, f8scl1 = 0x7F7F7F7F, f8one = 0x7F7F7F7F;
    if constexpr (F8) { f8scl = Epi::SCL0; f8scl1 = Epi::SCL1; }
    asm volatile("" : "+v"(f8scl), "+v"(f8scl1), "+v"(f8one));
    int ntc = nt; size_t kofc = 0;
    if constexpr (SPLITK) { ntc = cur.nt; kofc = (size_t)(cur.part * cur.nt) * kstep; }
    const char* cA = (const char*)g.A + (size_t)cur.pm * tstep + kofc; const char* cB = (const char*)g.Bt + (size_t)cur.bsel * g.bstride + (size_t)cur.pn * tstep + kofc;
    if constexpr (GATHER) { PG8_GOF(gofC, cur); }
    if constexpr (SP2) {
        PG8_STAGE(PG8_SB(0, 0), cB, voffB); PG8_STAGE(PG8_SB(0, 1), cB + hstep, voffB); PG8_STAGE_A(PG8_SA(0, 0), cA, 0, 0, false); PG8_STAGE_A(PG8_SA(0, 1), cA, 1, 0, false);
        if (wr == 1) PG8_BAR;
        PG8_WAIT_V(2); PG8_BAR;
        PG8_STAGE(PG8_SB(1, 0), cB + kstep, voffB); PG8_STAGE_A(PG8_SA(1, 0), cA + kstep, 0, kstep, false); PG8_STAGE(PG8_SB(1, 1), cB + hstep + kstep, voffB);
        PG8_WAIT_V(6); PG8_BAR;
    } else {
        PG8_STAGE(PG8_SB(0, 0), cB, voffB); PG8_STAGE(PG8_SA(0, 0), cA, voffA); PG8_STAGE(PG8_SB(0, 1), cB + hstep, voffB); PG8_STAGE(PG8_SA(0, 1), cA + hstep, voffA);
        if (wr == 1) PG8_BAR;
        PG8_WAIT_V(4); PG8_BAR;
        PG8_STAGE(PG8_SB(1, 0), cB + kstep, voffB); PG8_STAGE(PG8_SA(1, 0), cA + kstep, voffA); PG8_STAGE(PG8_SB(1, 1), cB + hstep + kstep, voffB);
        PG8_WAIT_V(6); PG8_BAR;
    }
    for (;;) {
        const bool has_next = S.next(ui + 1, nxt);
        if constexpr (GATHER) { if (has_next) { PG8_GTOK(gofN, nxt); } }
        size_t kofn = 0; if constexpr (SPLITK) { if (has_next) kofn = (size_t)(nxt.part * nxt.nt) * kstep; }
        const char* nA = has_next ? (const char*)g.A + (size_t)nxt.pm * tstep + kofn : cA; const char* nB = has_next ? (const char*)g.Bt + (size_t)nxt.bsel * g.bstride + (size_t)nxt.pn * tstep + kofn : cB;
#pragma unroll 1
        for (int t = 0; t < ntc; t += 2) {
            const bool last = (t == ntc - 2);
            const char* a1 = cA + (size_t)(t + 1) * kstep;
            const char* a2 = last ? nA : cA + (size_t)(t + 2) * kstep; const char* b2 = last ? nB : cB + (size_t)(t + 2) * kstep;
            const char* a3 = a2 + kstep; const char* b3 = b2 + kstep;
            if constexpr (GATHER) { if (last && has_next) { PG8_GCVT(gofN); } }
            if constexpr (Epi::MID) { if (t == nt / 2) E.mid(acc, cur, wr, wc, fr, fq); }
            const size_t k1 = (size_t)(t + 1) * kstep, k2 = last ? (size_t)0 : (size_t)(t + 2) * kstep, k3 = k2 + kstep; const bool nx = last && has_next;
            if constexpr (SP2) {
            const bool post = (t == 0) && (ui > 0);
            PG8_LDB(B0, 0, 0); PG8_LDB(B1, 0, 1); PG8_SCHED; PG8_LDA(At, 0, 0); PG8_STAGE_A(PG8_SA(1, 1), a1, 1, k1, false);
            PG8_WAIT_V8P(post); PG8_WAIT_L(0); PG8_BAR; PG8_MMA(0, 0, At, B0); PG8_MMA(0, 1, At, B1); PG8_BAR; PG8_SCHED;
            PG8_LDA(At, 0, 1); PG8_STAGE(PG8_SB(0, 0), b2, voffB); PG8_STAGE(PG8_SB(0, 1), b2 + hstep, voffB); PG8_STAGE_A(PG8_SA(0, 0), a2, 0, k2, nx);
            PG8_WAIT_V8P(post); PG8_WAIT_L(0); PG8_BAR; PG8_MMA(1, 0, At, B0); PG8_MMA(1, 1, At, B1); PG8_BAR; PG8_SCHED;
            PG8_LDB(B0, 1, 0); PG8_LDB(B1, 1, 1); PG8_SCHED; PG8_LDA(At, 1, 0); PG8_STAGE_A(PG8_SA(0, 1), a2, 1, k2, nx);
            PG8_WAIT_V(8); PG8_WAIT_L(0); PG8_BAR; PG8_MMA(0, 0, At, B0); PG8_MMA(0, 1, At, B1); PG8_BAR; PG8_SCHED;
            PG8_LDA(At, 1, 1); PG8_STAGE(PG8_SB(1, 0), b3, voffB); PG8_STAGE(PG8_SB(1, 1), b3 + hstep, voffB); PG8_STAGE_A(PG8_SA(1, 0), a3, 0, k3, nx);
            PG8_WAIT_V(8); PG8_WAIT_L(0); PG8_BAR; PG8_MMA(1, 0, At, B0); PG8_MMA(1, 1, At, B1); PG8_BAR; PG8_SCHED;
            } else {
            static_assert(!GATHER || SP2, "GATHER is wired into the SP2 loop only");
            PG8_LDB(B0, 0, 0); PG8_SCHED; PG8_LDA(At, 0, 0); PG8_STAGE(PG8_SA(1, 1), a1 + hstep, voffA);
            PG8_WAIT_L(8); PG8_BAR; PG8_WAIT_L(0); PG8_MMA(0, 0, At, B0); PG8_BAR; PG8_SCHED;
            PG8_LDB(B1, 0, 1); PG8_STAGE(PG8_SB(0, 0), b2, voffB);
            PG8_BAR; PG8_WAIT_L(0); PG8_MMA(0, 1, At, B1); PG8_BAR;
            PG8_LDA(At, 0, 1); PG8_STAGE(PG8_SA(0, 0), a2, voffA);
            PG8_BAR; PG8_WAIT_L(0); PG8_MMA(1, 0, At, B0); PG8_BAR; PG8_SCHED;
            PG8_STAGE(PG8_SB(0, 1), b2 + hstep, voffB);
            PG8_WAIT_V(6); PG8_BAR; PG8_MMA(1, 1, At, B1); PG8_BAR;
            PG8_LDB(B0, 1, 0); PG8_SCHED; PG8_LDA(At, 1, 0); PG8_STAGE(PG8_SA(0, 1), a2 + hstep, voffA);
            PG8_WAIT_L(8); PG8_BAR; PG8_WAIT_L(0); PG8_MMA(0, 0, At, B0); PG8_BAR; PG8_SCHED;
            PG8_LDB(B1, 1, 1); PG8_STAGE(PG8_SB(1, 0), b3, voffB);
            PG8_BAR; PG8_WAIT_L(0); PG8_MMA(0, 1, At, B1); PG8_BAR;
            PG8_LDA(At, 1, 1); PG8_STAGE(PG8_SA(1, 0), a3, voffA);
            PG8_BAR; PG8_WAIT_L(0); PG8_MMA(1, 0, At, B0); PG8_BAR; PG8_SCHED;
            PG8_STAGE(PG8_SB(1, 1), b3 + hstep, voffB);
            PG8_WAIT_V(6); PG8_BAR; PG8_MMA(1, 1, At, B1); PG8_BAR;
            }
        }
        if constexpr (ALIGN_EPI) { if (wr == 0) PG8_BAR; }
        if constexpr (F8) asm volatile("s_nop 15\n\ts_nop 15" ::: "memory");
        E(acc, cur, wr, wc, fr, fq);
        if (!has_next) break;
#pragma unroll
        for (int a = 0; a < 2; ++a)
#pragma unroll
            for (int b = 0; b < 2; ++b)
#pragma unroll
                for (int m = 0; m < 4; ++m)
#pragma unroll
                    for (int n = 0; n < 2; ++n) acc[a][b][m][n] = (f32x4){0.f, 0.f, 0.f, 0.f};
        cur = nxt; cA = nA; cB = nB; ++ui; if constexpr (SPLITK) ntc = cur.nt;
        if constexpr (GATHER) { _Pragma("unroll") for (int _h = 0; _h < 2; ++_h) _Pragma("unroll") for (int _i = 0; _i < 2; ++_i) gofC[_h][_i] = gofN[_h][_i]; }
        if constexpr (ALIGN_EPI) { if (wr == 1) PG8_BAR; }
    }
    PG8_WAIT_V(0);
    if constexpr (!ALIGN_EPI) { if (wr == 0) PG8_BAR; }
    PG8_BAR;
#undef PG8_SA
#undef PG8_SB
#undef PG8_STAGE
#undef PG8_STAGE_A
#undef PG8_GOF
#undef PG8_GTOK
#undef PG8_GCVT
#undef PG8_LDA
#undef PG8_LD32
#undef PG8_LDB
#undef PG8_MMA
#undef PG8_WAIT_V
#undef PG8_WAIT_L
#undef PG8_WAIT_V8P
#undef PG8_BAR
#undef PG8_SCHED
}

#define EPI_ROWS(...) _Pragma("unroll") for (int ai = 0; ai < 2; ++ai) _Pragma("unroll") for (int m = 0; m < 4; ++m) { const int row = row0 + ai * HALF + m * 16; \
        _Pragma("unroll") for (int bj = 0; bj < 2; ++bj) { const int c = bj * HALF + wc * 32 + 8 * fq; f32x4 v0 = acc[ai][bj][m][0], v1 = acc[ai][bj][m][1]; __VA_ARGS__ } }
__device__ __forceinline__ u32x4 pack8(f32x4 v0, f32x4 v1) { u32x4 w; w.x = cvt_pk_bf16(v0[0], v0[1]); w.y = cvt_pk_bf16(v0[2], v0[3]); w.z = cvt_pk_bf16(v1[0], v1[1]); w.w = cvt_pk_bf16(v1[2], v1[3]); return w; }

__device__ __forceinline__ float ssq8(f32x4 a, f32x4 b) { return (a[0] * a[0] + a[1] * a[1]) + (a[2] * a[2] + a[3] * a[3]) + (b[0] * b[0] + b[1] * b[1]) + (b[2] * b[2] + b[3] * b[3]); }
struct EpiInproj { static constexpr bool PERM = true; static constexpr bool MID = false; static constexpr int NS = 16;
    bf16_t *CQ, *CKV, *KM; float *SSQQ, *SSQKV, *FLOG; const float* ROPE; bf16_t *QF, *KF, *VF;
    __device__ __forceinline__ void operator()(const f32x4 (&acc)[2][2][4][2], const Unit& u, int wr, int wc, int fr, int fq) const {
        const int row0 = u.pm * BM + wr * 64 + fr;
        if (u.pn == 0) {
#pragma unroll
            for (int ai = 0; ai < 2; ++ai)
#pragma unroll
                for (int m = 0; m < 4; ++m) { const int row = row0 + ai * HALF + m * 16; float ss = 0.f;
#pragma unroll
                    for (int bj = 0; bj < 2; ++bj) { const int c = bj * HALF + wc * 32 + 8 * fq; const f32x4 v0 = acc[ai][bj][m][0], v1 = acc[ai][bj][m][1];
                        *(u32x4*)(CQ + (size_t)row * 256 + c) = pack8(v0, v1); ss += ssq8(v0, v1); }
                    ss += __shfl_xor(ss, 16); ss += __shfl_xor(ss, 32);
                    if (fq == 0) SSQQ[(size_t)row * 4 + wc] = ss; }
        } else if (u.pn == 1) {
#pragma unroll
            for (int ai = 0; ai < 2; ++ai)
#pragma unroll
                for (int m = 0; m < 4; ++m) { const int row = row0 + ai * HALF + m * 16; const int c = wc * 32 + 8 * fq;
                    { const f32x4 v0 = acc[ai][0][m][0], v1 = acc[ai][0][m][1]; *(u32x4*)(CKV + (size_t)row * 128 + c) = pack8(v0, v1);
                      float ss = ssq8(v0, v1); ss += __shfl_xor(ss, 16); ss += __shfl_xor(ss, 32); if (fq == 0) SSQKV[(size_t)row * 4 + wc] = ss; }
                    const f32x4 v0 = acc[ai][1][m][0], v1 = acc[ai][1][m][1];
                    if (wc == 0) { const f32x4* rp = (const f32x4*)(ROPE + (size_t)row * 32 + 8 * fq); const f32x4 r0 = rp[0], r1 = rp[1]; f32x4 o0, o1;
                        o0[0] = v0[0] * r0[0] - v0[1] * r0[1]; o0[1] = v0[0] * r0[1] + v0[1] * r0[0]; o0[2] = v0[2] * r0[2] - v0[3] * r0[3]; o0[3] = v0[2] * r0[3] + v0[3] * r0[2];
                        o1[0] = v1[0] * r1[0] - v1[1] * r1[1]; o1[1] = v1[0] * r1[1] + v1[1] * r1[0]; o1[2] = v1[2] * r1[2] - v1[3] * r1[3]; o1[3] = v1[2] * r1[3] + v1[3] * r1[2];
                        const u32x4 w = pack8(o0, o1);
#pragma unroll
                        for (int h = 0; h < 8; ++h) *(u32x4*)(KM + (size_t)row * KM_P + h * 96 + 64 + 8 * fq) = w; }
                    else if (wc == 1 && fq == 0) { float* p = FLOG + (size_t)row * 8; *(f32x4*)p = v0; *(f32x4*)(p + 4) = v1; } }
        } else {
            const int grp = (u.pn >> 1) - 1, cb = (u.pn & 1) * 256;
            if (grp == 0)      { EPI_ROWS( const int cc = cb + c; v0 = v0 * C2F; v1 = v1 * C2F; *(u32x4*)(QF + (size_t)row * QF_P + (cc >> 6) * 80 + (cc & 63)) = pack8(v0, v1); ) }
            else if (grp == 1) { EPI_ROWS( const int cc = cb + c; *(u32x4*)(KF + (size_t)row * KF_P + (cc >> 6) * 80 + (cc & 63)) = pack8(v0, v1); ) }
            else               { EPI_ROWS( const int cc = cb + c; *(u32x4*)(VF + (size_t)row * VF_P + cc) = pack8(v0, v1); ) }
        }
    }
};
struct EpiQ { static constexpr bool PERM = true; static constexpr bool MID = false; static constexpr int NS = 16;
    bf16_t* QM; const float* ROPE; const float* SSQ;
    __device__ __forceinline__ float rs(int row) const { const f32x4 p = *(const f32x4*)(SSQ + (size_t)row * 4); return C2M / sqrtf(((p[0] + p[1]) + (p[2] + p[3])) * (1.f / 256.f) + EPS); }
    __device__ __forceinline__ void operator()(const f32x4 (&acc)[2][2][4][2], const Unit& u, int wr, int wc, int fr, int fq) const {
        const int row0 = u.pm * BM + wr * 64 + fr;
        if (u.pn < 2) {
            EPI_ROWS( const int cc = u.pn * 256 + c; const float C2M = rs(row); v0 = v0 * C2M; v1 = v1 * C2M; *(u32x4*)(QM + (size_t)row * QM_P + (cc >> 6) * 96 + (cc & 63)) = pack8(v0, v1); )
        } else {
            EPI_ROWS( const int h = c >> 5, p0 = c & 31; const float C2M = rs(row); const f32x4* rp = (const f32x4*)(ROPE + (size_t)row * 32 + p0);
                const f32x4 r0 = rp[0], r1 = rp[1]; f32x4 o0, o1;
                o0[0] = v0[0] * r0[0] - v0[1] * r0[1]; o0[1] = v0[0] * r0[1] + v0[1] * r0[0]; o0[2] = v0[2] * r0[2] - v0[3] * r0[3]; o0[3] = v0[2] * r0[3] + v0[3] * r0[2];
                o1[0] = v1[0] * r1[0] - v1[1] * r1[1]; o1[1] = v1[0] * r1[1] + v1[1] * r1[0]; o1[2] = v1[2] * r1[2] - v1[3] * r1[3]; o1[3] = v1[2] * r1[3] + v1[3] * r1[2];
                o0 = o0 * C2M; o1 = o1 * C2M; *(u32x4*)(QM + (size_t)row * QM_P + h * 96 + 64 + p0) = pack8(o0, o1); )
        }
    }
};
struct EpiKV { static constexpr bool PERM = true; static constexpr bool MID = false; static constexpr int NS = 16;
    bf16_t *KM, *VM; const float* SSQ;
    __device__ __forceinline__ float rs(int row) const { const f32x4 p = *(const f32x4*)(SSQ + (size_t)row * 4); return 1.f / sqrtf(((p[0] + p[1]) + (p[2] + p[3])) * (1.f / 128.f) + EPS); }
    __device__ __forceinline__ void operator()(const f32x4 (&acc)[2][2][4][2], const Unit& u, int wr, int wc, int fr, int fq) const {
        const int row0 = u.pm * BM + wr * 64 + fr;
        if (u.pn < 2) { EPI_ROWS( const int cc = u.pn * 256 + c; const float r = rs(row); v0 = v0 * r; v1 = v1 * r; *(u32x4*)(KM + (size_t)row * KM_P + (cc >> 6) * 96 + (cc & 63)) = pack8(v0, v1); ) }
        else          { EPI_ROWS( const int cc = (u.pn - 2) * 256 + c; const float r = rs(row); v0 = v0 * r; v1 = v1 * r; *(u32x4*)(VM + (size_t)row * VM_P + cc) = pack8(v0, v1); ) }
    }
};
struct EpiResid { static constexpr bool PERM = true; static constexpr bool MID = false; static constexpr int NS = 0;
    const float* Xin; float* Xout; const float* gate  ; const float* rowscale; int rs_stride;
    __device__ __forceinline__ void operator()(const f32x4 (&acc)[2][2][4][2], const Unit& u, int wr, int wc, int fr, int fq) const {
        const int row0 = u.pm * BM + wr * 64 + fr; const int b = (u.pm * BM) >> 12;
        const float* gp = gate + (size_t)b * 6144 + u.pn * 256;
        EPI_ROWS( const f32x4 g0 = *(const f32x4*)(gp + c), g1 = *(const f32x4*)(gp + c + 4); const size_t off = (size_t)row * DM + u.pn * 256 + c;
            float rs = 1.f; if (rowscale) rs = rowscale[(size_t)row * rs_stride];
            const f32x4 x0 = *(const f32x4*)(Xin + off), x1 = *(const f32x4*)(Xin + off + 4);
            *(f32x4*)(Xout + off) = x0 + g0 * (v0 * rs); *(f32x4*)(Xout + off + 4) = x1 + g1 * (v1 * rs); )
    }
};
struct EpiSwiglu { static constexpr bool PERM = true; static constexpr bool MID = false; static constexpr int NS = 8;
    bf16_t* H;
    __device__ __forceinline__ void operator()(const f32x4 (&acc)[2][2][4][2], const Unit& u, int wr, int wc, int fr, int fq) const {
        const int row0 = u.pm * BM + wr * 64 + fr;
#pragma unroll
        for (int ai = 0; ai < 2; ++ai)
#pragma unroll
            for (int m = 0; m < 4; ++m) { const int row = row0 + ai * HALF + m * 16; f32x4 h[2];
#pragma unroll
                for (int n = 0; n < 2; ++n) { const f32x4 gv = acc[ai][0][m][n], uv = acc[ai][1][m][n];
#pragma unroll
                    for (int j = 0; j < 4; ++j) { const float e = __builtin_amdgcn_exp2f(-gv[j] * LOG2E); h[n][j] = gv[j] * __builtin_amdgcn_rcpf(1.f + e) * uv[j]; } }
                *(u32x4*)(H + (size_t)row * FF + u.pn * 128 + wc * 32 + 8 * fq) = pack8(h[0], h[1]); }
    }
};
struct EpiBf16Plain { static constexpr bool PERM = true; static constexpr bool MID = false; static constexpr int NS = 16; static constexpr int SCL0 = 0x7F7F7F7F, SCL1 = 0x7F7F7F7F;
    bf16_t* O; int ldc; float scale;
    __device__ __forceinline__ void operator()(const f32x4 (&acc)[2][2][4][2], const Unit& u, int wr, int wc, int fr, int fq) const {
        const int row0 = u.pm * BM + wr * 64 + fr;
        EPI_ROWS( v0 = v0 * scale; v1 = v1 * scale; *(u32x4*)(O + (size_t)row * ldc + u.pn * 256 + c) = pack8(v0, v1); )
    }
};
struct EpiWo { static constexpr bool PERM = true; static constexpr bool MID = true; static constexpr int NS = 16;
    bf16_t* O; const float* SSQ;
    __device__ __forceinline__ void sums(int row, float& s1, float& s2) const { const f32x4* p = (const f32x4*)(SSQ + (size_t)row * 16); const f32x4 a = p[0], b = p[1], c = p[2], d = p[3];
        s1 = ((a[0] + a[1]) + (a[2] + a[3])) + ((b[0] + b[1]) + (b[2] + b[3])); s2 = ((c[0] + c[1]) + (c[2] + c[3])) + ((d[0] + d[1]) + (d[2] + d[3])); }
    __device__ __forceinline__ void mid(f32x4 (&acc)[2][2][4][2], const Unit& u, int wr, int wc, int fr, int fq) const {
        int row0 = u.pm * BM + wr * 64 + fr; asm volatile("" : "+v"(row0));
#pragma unroll
        for (int ai = 0; ai < 2; ++ai)
#pragma unroll
            for (int m = 0; m < 4; ++m) { float s1, s2; sums(row0 + ai * HALF + m * 16, s1, s2); const float ratio = sqrtf((s2 * (1.f / 512.f) + EPS) / (s1 * (1.f / 512.f) + EPS));
#pragma unroll
                for (int bj = 0; bj < 2; ++bj)
#pragma unroll
                    for (int n = 0; n < 2; ++n) acc[ai][bj][m][n] = acc[ai][bj][m][n] * ratio;
                asm volatile("" : "+v"(acc[ai][0][m][0]), "+v"(acc[ai][0][m][1]), "+v"(acc[ai][1][m][0]), "+v"(acc[ai][1][m][1]) :: "memory"); }
    }
    __device__ __forceinline__ void operator()(const f32x4 (&acc)[2][2][4][2], const Unit& u, int wr, int wc, int fr, int fq) const {
        int row0 = u.pm * BM + wr * 64 + fr; asm volatile("" : "+v"(row0));
#pragma unroll
        for (int ai = 0; ai < 2; ++ai)
#pragma unroll
            for (int m = 0; m < 4; ++m) { const int row = row0 + ai * HALF + m * 16; float s1, s2; sums(row, s1, s2); const float r2 = 1.f / sqrtf(s2 * (1.f / 512.f) + EPS);
#pragma unroll
                for (int bj = 0; bj < 2; ++bj) { const int c = bj * HALF + wc * 32 + 8 * fq; *(u32x4*)(O + (size_t)row * DM + u.pn * 256 + c) = pack8(acc[ai][bj][m][0] * r2, acc[ai][bj][m][1] * r2); } }
    }
};
struct EpiSwigluF8 { static constexpr bool PERM = true; static constexpr bool MID = false; static constexpr int NS = 8; static constexpr int SCL0 = 0x7A7A7A7A, SCL1 = 0x7C7C7C7C;
    unsigned char* H;
    __device__ __forceinline__ void operator()(const f32x4 (&acc)[2][2][4][2], const Unit& u, int wr, int wc, int fr, int fq) const {
        const int row0 = u.pm * BM + wr * 64 + fr;
#pragma unroll
        for (int ai = 0; ai < 2; ++ai)
#pragma unroll
            for (int m = 0; m < 4; ++m) { const int row = row0 + ai * HALF + m * 16; float h[8];
#pragma unroll
                for (int n = 0; n < 2; ++n) { const f32x4 ga = acc[ai][0][m][n], ua = acc[ai][1][m][n];
#pragma unroll
                    for (int j = 0; j < 4; ++j) { const float e = __builtin_amdgcn_exp2f(ga[j]); const float hv = (ga[j] * ua[j]) * __builtin_amdgcn_rcpf(1.f + e);
                        h[4 * n + j] = __builtin_amdgcn_fmed3f(hv, -448.f, 448.f); } }
                int w0 = 0, w1 = 0;
                w0 = __builtin_amdgcn_cvt_pk_fp8_f32(h[0], h[1], w0, false); w0 = __builtin_amdgcn_cvt_pk_fp8_f32(h[2], h[3], w0, true);
                w1 = __builtin_amdgcn_cvt_pk_fp8_f32(h[4], h[5], w1, false); w1 = __builtin_amdgcn_cvt_pk_fp8_f32(h[6], h[7], w1, true);
                *(v2u*)(H + (size_t)row * FF + u.pn * 128 + wc * 32 + 8 * fq) = (v2u){(unsigned)w0, (unsigned)w1}; }
    }
};
struct MoeOrder : StaticOrder {
    int tend[8];
    __device__ __forceinline__ void load(const int* texp) {
#pragma unroll
        for (int e = 0; e < 8; ++e) tend[e] = __builtin_amdgcn_readfirstlane(texp[1 + e]); }
    __device__ __forceinline__ bool next(int i, Unit& u) const { if (!StaticOrder::next(i, u)) return false; int b = 0;
#pragma unroll
        for (int e = 0; e < 7; ++e) b += (u.pm >= tend[e]) ? 1 : 0;
        u.bsel = b; return true; }
};
struct EpiMoeDown { static constexpr bool PERM = true; static constexpr bool MID = false; static constexpr int NS = 0;
    float* X; const float* gate; const int* rowtok; const float* roww; float oscale;
    __device__ __forceinline__ void operator()(const f32x4 (&acc)[2][2][4][2], const Unit& u, int wr, int wc, int fr, int fq) const {
        const int row0 = u.pm * BM + wr * 64 + fr;
#pragma unroll
        for (int ai = 0; ai < 2; ++ai)
#pragma unroll
            for (int m = 0; m < 4; ++m) { const int slot = row0 + ai * HALF + m * 16; const int tok = rowtok[slot];
                if (tok >= 0) { const float w = roww[slot] * oscale; const float* gp = gate + (size_t)(tok >> 12) * 6144 + u.pn * 256; float* xp = X + (size_t)tok * DM + u.pn * 256;
#pragma unroll
                    for (int bj = 0; bj < 2; ++bj) { const int c = bj * HALF + wc * 32 + 8 * fq; const f32x4 v0 = acc[ai][bj][m][0], v1 = acc[ai][bj][m][1];
                        const f32x4 g0 = *(const f32x4*)(gp + c), g1 = *(const f32x4*)(gp + c + 4); const f32x4 x0 = *(const f32x4*)(xp + c), x1 = *(const f32x4*)(xp + c + 4);
                        *(f32x4*)(xp + c) = x0 + g0 * (v0 * w); *(f32x4*)(xp + c + 4) = x1 + g1 * (v1 * w); } } }
    }
};
struct MoeOrderD : MoeOrder {
    int mainU, mainM, tailSub, S, NT;
    __device__ __forceinline__ void init_d(int ntile, int NT_, int G_, int c_) {
        NT = NT_; const int per = G_ / 4; int tailM = (G_ % 4 == 0) ? ntile % per : 0; const int U = 4 * tailM;
        S = (7 * U <= G_ && NT_ % 14 == 0) ? 7 : ((2 * U <= G_ && NT_ % 4 == 0) ? 2 : 1); if (S == 1) tailM = 0;
        mainM = ntile - tailM; mainU = 4 * mainM; tailSub = 4 * tailM * S;
        StaticOrder::init(mainM * BM, 4 * BM, G_, c_); }
    __device__ __forceinline__ bool next(int i, Unit& u) const {
        const long L = (long)i * G + c;
        if (L < mainU) { StaticOrder::next(i, u); u.nt = NT; }
        else { const int j = (int)(L - mainU); if (j >= tailSub) return false;
            const int uu = j / S; u.part = j - uu * S; u.pm = mainM + (uu >> 2); u.pn = uu & 3; u.nt = NT / S; }
        int b = 0;
#pragma unroll
        for (int e = 0; e < 7; ++e) b += (u.pm >= tend[e]) ? 1 : 0;
        u.bsel = b; return true; }
};
struct EpiMoeY { static constexpr bool PERM = true; static constexpr bool MID = false; static constexpr int NS = 16; static constexpr int SCL0 = 0x7F7F7F7F, SCL1 = 0x7F7F7F7F;
    bf16_t* Y; bf16_t* Yp; int tail0; size_t pstride; float scale;
    __device__ __forceinline__ void operator()(const f32x4 (&acc)[2][2][4][2], const Unit& u, int wr, int wc, int fr, int fq) const {
        const int row0 = u.pm * BM + wr * 64 + fr;
        bf16_t* O = (u.part == 0) ? Y : Yp + (size_t)(u.part - 1) * pstride - (size_t)tail0 * DM;
        EPI_ROWS( v0 = v0 * scale; v1 = v1 * scale; *(u32x4*)(O + (size_t)row * DM + u.pn * 256 + c) = pack8(v0, v1); )
    }
};
}

#define XB_TMO      128
#define XB_XCNT(j)  (256  + 64 * (j))
#define XB_XSUB(j)  (1280 + 64 * (j))
#define XB_XGEN(j)  (2304 + 64 * (j))
#define XB_TOP      3328
#define XB_TOPGEN   3392
#define XCD_BAR_WORDS 3456
#define XB_SPIN_CAP (1u << 22)

__device__ __forceinline__ unsigned xb_ld(unsigned* p)              { return __hip_atomic_load(p, __ATOMIC_RELAXED, __HIP_MEMORY_SCOPE_AGENT); }
__device__ __forceinline__ unsigned xb_add(unsigned* p, unsigned v) { return __hip_atomic_fetch_add(p, v, __ATOMIC_RELAXED, __HIP_MEMORY_SCOPE_AGENT); }
__device__ __forceinline__ unsigned xb_xcc_id() { return (unsigned)__builtin_amdgcn_s_getreg((3 << 11) | 20) & 0xFu; }
#define XB_SPIN(cond, bar) do { unsigned _sp = 0; while (cond) { __builtin_amdgcn_s_sleep(1); \
    if ((++_sp & 255u) == 0u) { if (xb_ld(&(bar)[XB_TMO])) break; if (_sp > XB_SPIN_CAP) { atomicAdd(&(bar)[XB_TMO], 1u); break; } } } } while (0)

struct XcdBarrier { unsigned* bar; unsigned x; volatile LAS unsigned* st; };

__device__ __forceinline__ XcdBarrier xcd_barrier_post(unsigned* bar, volatile LAS unsigned* st) {
    XcdBarrier b; b.bar = bar; b.x = xb_xcc_id(); b.st = st;
    if (threadIdx.x == 0) (void)xb_add(&bar[XB_XCNT(b.x)], 1u);
    return b;
}
__device__ __forceinline__ void xcd_barrier_complete(unsigned* bar, unsigned x, unsigned& nloc, unsigned& nx) {
    const unsigned G = gridDim.x * gridDim.y * gridDim.z;
    unsigned sum, cnt, mine, sp = 0u;
    for (;;) {
        sum = 0u; cnt = 0u; mine = 0u;
#pragma unroll
        for (unsigned j = 0; j < 16; ++j) { const unsigned c = xb_ld(&bar[XB_XCNT(j)]); sum += c; cnt += (c > 0u) ? 1u : 0u; mine = (j == x) ? c : mine; }
        if (sum == G) break;
        __builtin_amdgcn_s_sleep(1);
        if ((++sp & 255u) == 0u) { if (xb_ld(&bar[XB_TMO])) break; if (sp > XB_SPIN_CAP) { atomicAdd(&bar[XB_TMO], 1u); break; } }
    }
    nloc = mine > 0u ? mine : 1u; nx = cnt > 0u ? cnt : 1u;
}
__device__ __forceinline__ void xcd_barrier(const XcdBarrier& b) {
    asm volatile("s_waitcnt vmcnt(0)" ::: "memory");
    __syncthreads();
    if (threadIdx.x == 0) {
        unsigned* bar = b.bar;
        __builtin_amdgcn_s_waitcnt(0);
        unsigned nloc = b.st[0], nx = b.st[1];
        if (nloc == 0u) { xcd_barrier_complete(bar, b.x, nloc, nx); b.st[0] = nloc; b.st[1] = nx; }
        const unsigned old = xb_add(&bar[XB_XSUB(b.x)], 1u);
        const unsigned gen = old / nloc;
        if (old + 1u == (gen + 1u) * nloc) {
            __builtin_amdgcn_fence(__ATOMIC_RELEASE, "agent");
            asm volatile("s_waitcnt vmcnt(0)" ::: "memory");
            const unsigned og = xb_add(&bar[XB_TOP], 1u);
            const unsigned tg = og / nx;
            if (og + 1u == (tg + 1u) * nx) xb_add(&bar[XB_TOPGEN], 1u);
            else XB_SPIN(xb_ld(&bar[XB_TOPGEN]) == tg, bar);
            __builtin_amdgcn_fence(__ATOMIC_ACQUIRE, "agent");
            xb_add(&bar[XB_XGEN(b.x)], 1u);
            asm volatile("s_waitcnt vmcnt(0)" ::: "memory");
        } else {
            XB_SPIN(xb_ld(&bar[XB_XGEN(b.x)]) == gen, bar);
            __builtin_amdgcn_fence(__ATOMIC_ACQUIRE, "agent");
            asm volatile("s_waitcnt vmcnt(0)" ::: "memory");
        }
    }
    __syncthreads();
}

struct Args {
    const float* in[24]; float* out; unsigned char* ws; int ph_lo, ph_hi;
};
struct Frame {
    LAS unsigned char* lds;
    int tid, lane, wave, vcu, G;
    unsigned char* ws;
};

template <class Src>
__device__ __forceinline__ void conv_item(const Src& src, int Ksrc, int Kpad, bf16* WT, LAS float* scr, int item, int lane, int nblk) {
    const int kb = item / nblk, nb = item % nblk, k0 = 64 * kb, n0 = 32 * nb;
    const float* colp = src(n0 + (lane & 31)); const int ld = src.ld;
#pragma unroll 8
    for (int i = 0; i < 32; ++i) { const int kk = 2 * i + (lane >> 5), k = k0 + kk; float v = 0.f; if (colp != nullptr && k < Ksrc) v = colp[(size_t)k * ld] * src.ksc(k); scr[kk * 33 + (lane & 31)] = v; }
    LDS_WAIT(); asm volatile("" ::: "memory");
    const int c = lane & 7;
#pragma unroll
    for (int j = 0; j < 4; ++j) { const int n = (lane >> 3) + 8 * j; const LAS float* s = scr + (8 * c) * 33 + n;
        v4u o; o.x = pk2(s[0 * 33], s[1 * 33]); o.y = pk2(s[2 * 33], s[3 * 33]); o.z = pk2(s[4 * 33], s[5 * 33]); o.w = pk2(s[6 * 33], s[7 * 33]);
        *(GAS v4u*)(WT + (size_t)(n0 + n) * Kpad + k0 + 8 * c) = o; }
    LDS_WAIT(); asm volatile("" ::: "memory");
}
template <class Src>
__device__ __forceinline__ void conv_matrix(Frame& F, const Src& src, int Ksrc, int Kpad, int Nout, bf16* WT, int rot = 0) {
    LAS float* scr = (LAS float*)(F.lds + F.wave * 16384);
    const int gw = F.vcu * NWAVES + F.wave, NGW = F.G * NWAVES, nblk = Nout / 32, nitems = (Kpad / 64) * nblk;
    for (int it = (gw + NGW - rot % NGW) % NGW; it < nitems; it += NGW) conv_item(src, Ksrc, Kpad, WT, scr, it, F.lane, nblk);
}
template <class Src>
__device__ __forceinline__ void conv_item64(const Src& src, int Ksrc, int Kpad, bf16* WT, LAS unsigned short* scr, int item, int lane, int nblk) {
    const int kb = item / nblk, nb = item % nblk, k0 = 64 * kb, n0 = 64 * nb;
    const int nn = (lane & 15) * 4, kq = lane >> 4;
    const float* colp = src(n0 + nn); const int ld = src.ld;
    f32x4 v[16];
#pragma unroll
    for (int i = 0; i < 16; ++i) { const int k = k0 + 4 * i + kq; v[i] = (k < Ksrc) ? *(const f32x4*)(colp + (size_t)k * ld) : (f32x4){0.f, 0.f, 0.f, 0.f}; }
#pragma unroll
    for (int i = 0; i < 16; ++i) { LAS unsigned* d = (LAS unsigned*)(scr + (4 * i + kq) * 66 + nn); d[0] = pk2(v[i].x, v[i].y); d[1] = pk2(v[i].z, v[i].w); }
    LDS_WAIT(); asm volatile("" ::: "memory");
    const int c = lane & 7;
#pragma unroll
    for (int j = 0; j < 8; ++j) { const int n = (lane >> 3) + 8 * j; const LAS unsigned short* sp = scr + (8 * c) * 66 + n;
        v4u o; o.x = (unsigned)sp[0 * 66] | ((unsigned)sp[1 * 66] << 16); o.y = (unsigned)sp[2 * 66] | ((unsigned)sp[3 * 66] << 16);
        o.z = (unsigned)sp[4 * 66] | ((unsigned)sp[5 * 66] << 16); o.w = (unsigned)sp[6 * 66] | ((unsigned)sp[7 * 66] << 16);
        *(GAS v4u*)(WT + (size_t)(n0 + n) * Kpad + k0 + 8 * c) = o; }
    LDS_WAIT(); asm volatile("" ::: "memory");
}
template <class Src>
__device__ __forceinline__ void conv_matrix64(Frame& F, const Src& src, int Ksrc, int Kpad, int Nout, bf16* WT) {
    LAS unsigned short* scr = (LAS unsigned short*)(F.lds + F.wave * 16384);
    const int gw = F.vcu * NWAVES + F.wave, NGW = F.G * NWAVES, nblk = Nout / 64, nitems = (Kpad / 64) * nblk;
    for (int it = gw; it < nitems; it += NGW) conv_item64(src, Ksrc, Kpad, WT, scr, it, F.lane, nblk);
}
template <class Src>
__device__ __forceinline__ void conv_item_f8(const Src& src, int Ksrc, int Kpad, unsigned char* WT, LAS unsigned* scr, int item, int lane, int nblk, float sc) {
    const int kb = item / nblk, nb = item % nblk, k0 = 128 * kb, n0 = 64 * nb;
    const int nn = (lane & 15) * 4, kq4 = lane >> 4;
    const float* colp = src(n0 + nn); const int ld = src.ld;
#pragma unroll 2
    for (int i = 0; i < 8; ++i) { const int kq = 4 * i + kq4, k = k0 + 4 * kq; f32x4 r[4];
#pragma unroll
        for (int q = 0; q < 4; ++q) r[q] = (k + q < Ksrc) ? *(const f32x4*)(colp + (size_t)(k + q) * ld) : (f32x4){0.f, 0.f, 0.f, 0.f};
#pragma unroll
        for (int j = 0; j < 4; ++j) { int w = 0; w = __builtin_amdgcn_cvt_pk_fp8_f32(r[0][j] * sc, r[1][j] * sc, w, false); w = __builtin_amdgcn_cvt_pk_fp8_f32(r[2][j] * sc, r[3][j] * sc, w, true); scr[kq * 65 + nn + j] = (unsigned)w; } }
    LDS_WAIT(); asm volatile("" ::: "memory");
    const int c = lane & 7;
#pragma unroll
    for (int j = 0; j < 8; ++j) { const int n = (lane >> 3) + 8 * j; const LAS unsigned* sp = scr + (4 * c) * 65 + n;
        v4u o; o.x = sp[0]; o.y = sp[65]; o.z = sp[130]; o.w = sp[195];
        *(GAS v4u*)(WT + (size_t)(n0 + n) * Kpad + k0 + 16 * c) = o; }
    LDS_WAIT(); asm volatile("" ::: "memory");
}
template <class Src>
__device__ __forceinline__ void conv_matrix_f8(Frame& F, const Src& src, int Ksrc, int Kpad, int Nout, unsigned char* WT, float sc) {
    LAS unsigned* scr = (LAS unsigned*)(F.lds + F.wave * 16384);
    const int gw = F.vcu * NWAVES + F.wave, NGW = F.G * NWAVES, nblk = Nout / 64, nitems = (Kpad / 128) * nblk;
    for (int it = gw; it < nitems; it += NGW) conv_item_f8(src, Ksrc, Kpad, WT, scr, it, F.lane, nblk, sc);
}
template <class Src, bool F8>
__device__ __forceinline__ void conv_matrix_wg(Frame& F, const Src& src, int Ksrc, int Kpad, int Nout, unsigned char* WT, float sc, int rot = 0) {
    constexpr int KT = F8 ? 128 : 64, RW = KT / 8;
    LAS unsigned short* l16 = (LAS unsigned short*)F.lds; LAS unsigned* l32 = (LAS unsigned*)F.lds;
    const int nblk = Nout / 256, nitems = (Kpad / KT) * nblk, ld = src.ld;
    for (int it = (F.vcu + F.G - rot % F.G) % F.G; it < nitems; it += F.G) {
        const int kb = it / nblk, nb = it % nblk, k0 = KT * kb, n0 = 256 * nb;
        const float* colp = src(n0 + 4 * F.lane); const float scn = sc * src.nsc(n0 + 4 * F.lane);
        f32x4 r[RW];
#pragma unroll
        for (int j = 0; j < RW; ++j) { const int k = k0 + F.wave * RW + j; r[j] = (k < Ksrc) ? *(const f32x4*)(colp + (size_t)k * ld) * src.ksc(k) : (f32x4){0.f, 0.f, 0.f, 0.f}; }
        if constexpr (F8) {
#pragma unroll
            for (int q4 = 0; q4 < RW / 4; ++q4) { const int kq = F.wave * (RW / 4) + q4;
#pragma unroll
                for (int j = 0; j < 4; ++j) { int w = 0; w = __builtin_amdgcn_cvt_pk_fp8_f32(r[4 * q4][j] * scn, r[4 * q4 + 1][j] * scn, w, false); w = __builtin_amdgcn_cvt_pk_fp8_f32(r[4 * q4 + 2][j] * scn, r[4 * q4 + 3][j] * scn, w, true);
                    l32[kq * 257 + 4 * F.lane + j] = (unsigned)w; } }
        } else {
#pragma unroll
            for (int j = 0; j < RW; ++j) { const int kk = F.wave * RW + j; LAS unsigned* d = (LAS unsigned*)(l16 + kk * 258 + 4 * F.lane); d[0] = pk2(r[j].x, r[j].y); d[1] = pk2(r[j].z, r[j].w); }
        }
        __syncthreads();
#pragma unroll
        for (int j = 0; j < 4; ++j) { const int task = F.tid + 512 * j, rr = task >> 3, c = task & 7; v4u o;
            if constexpr (F8) { const LAS unsigned* sp = l32 + (4 * c) * 257 + rr; o.x = sp[0]; o.y = sp[257]; o.z = sp[514]; o.w = sp[771];
                *(GAS v4u*)(WT + (size_t)(n0 + rr) * Kpad + k0 + 16 * c) = o; }
            else { const LAS unsigned short* sp = l16 + (8 * c) * 258 + rr;
                o.x = (unsigned)sp[0] | ((unsigned)sp[258] << 16); o.y = (unsigned)sp[2 * 258] | ((unsigned)sp[3 * 258] << 16); o.z = (unsigned)sp[4 * 258] | ((unsigned)sp[5 * 258] << 16); o.w = (unsigned)sp[6 * 258] | ((unsigned)sp[7 * 258] << 16);
                *(GAS v4u*)(WT + ((size_t)(n0 + rr) * Kpad + k0 + 8 * c) * 2) = o; }
        }
        __syncthreads();
    }
}
struct SrcPlain { const float* W; int ld; __device__ __forceinline__ const float* operator()(int n) const { return W + n; } __device__ __forceinline__ float ksc(int) const { return 1.f; } __device__ __forceinline__ float nsc(int) const { return 1.f; } };
struct SrcPlainG { const float* W; int ld; const float* g1; const float* g2;
    __device__ __forceinline__ const float* operator()(int n) const { return W + n; } __device__ __forceinline__ float ksc(int k) const { return k < 512 ? g1[k] : g2[k - 512]; } __device__ __forceinline__ float nsc(int) const { return 1.f; } };
struct SrcWin { const float* W; int ld;
    __device__ __forceinline__ float ksc(int) const { return 1.f; }
    __device__ __forceinline__ const float* operator()(int n) const {
        int s;
        if (n < 384) s = n;
        else if (n < 416) { const int p = n - 384; s = 384 + (p >> 1) + 16 * (p & 1); }
        else if (n < 424) s = 1952 + (n - 416);
        else if (n < 512) return nullptr;
        else if (n < 1024) s = 416 + (n - 512);
        else if (n < 1536) s = 928 + (n - 1024);
        else s = 1440 + (n - 1536);
        return W + s; } };
struct SrcWuq { const float* W; int ld; const float* g;
    __device__ __forceinline__ float ksc(int k) const { return g[k]; }
    __device__ __forceinline__ const float* operator()(int n) const {
        int s;
        if (n < 512) s = (n >> 6) * 96 + (n & 63);
        else { const int r = n - 512, h = r >> 5, p = r & 31; s = h * 96 + 64 + (p >> 1) + 16 * (p & 1); }
        return W + s; } };
struct SrcWukv { const float* W; int ld; const float* g;
    __device__ __forceinline__ float ksc(int k) const { return g[k]; }
    __device__ __forceinline__ const float* operator()(int n) const {
        int s;
        if (n < 512) s = (n >> 6) * 128 + (n & 63);
        else { const int r = n - 512; s = (r >> 6) * 128 + 64 + (r & 63); }
        return W + s; } };
struct SrcGU { const float* Wg; const float* Wu; int ld;
    __device__ __forceinline__ float ksc(int) const { return 1.f; }
    __device__ __forceinline__ float nsc(int n) const { return ((n & 255) < 128) ? -LOG2E : -SC_H / (4.f * LOG2E); }
    __device__ __forceinline__ const float* operator()(int n) const { const int t = n >> 8, w = n & 255; return (w < 128) ? (Wg + t * 128 + w) : (Wu + t * 128 + (w - 128)); } };

__device__ __forceinline__ void mod_phase(Frame& F, const float* c, const float* ada_w, const float* ada_b, float* MOD) {
    LAS float* cact = (LAS float*)F.lds;
    LAS float* red = cact + 8 * 1024;
    for (int i = F.tid; i < 8 * 1024; i += NWAVES * 64) { const float v = c[i]; cact[i] = v / (1.f + __expf(-v)); }
    __syncthreads();
    for (int item = F.vcu; item < 192; item += F.G) {
        const int l = item / 96, j = (item % 96) * 64 + F.lane;
        const float* wp = ada_w + (size_t)l * 1024 * 6144 + j;
        float acc[8];
#pragma unroll
        for (int b = 0; b < 8; ++b) acc[b] = 0.f;
        const int kb = F.wave * 128;
#pragma unroll 4
        for (int k = kb; k < kb + 128; ++k) { const float w = wp[(size_t)k * 6144];
#pragma unroll
            for (int b = 0; b < 8; ++b) acc[b] += cact[b * 1024 + k] * w; }
#pragma unroll
        for (int b = 0; b < 8; ++b) red[(F.wave * 8 + b) * 64 + F.lane] = acc[b];
        __syncthreads();
        { const int b = F.wave; float s = ada_b[l * 6144 + j];
#pragma unroll
          for (int w = 0; w < 8; ++w) s += red[(w * 8 + b) * 64 + F.lane];
          MOD[((size_t)l * 8 + b) * 6144 + j] = s; }
        __syncthreads();
    }
}

template <bool ROUTER, bool RESID, bool F8OUT = ROUTER>
__device__ __forceinline__ void norm_phase(Frame& F, const float* X, const float* g, const float* modl  , int part  , bf16* XN,
                                           const float* router_w, int* TOKE, float* TOKW, unsigned* CNT, const bf16* T, const float* rgate  , float* Xout) {
    const int gw = F.vcu * NWAVES + F.wave, NGW = F.G * NWAVES;
    if constexpr (ROUTER) { if (F.tid < 16) ((LAS unsigned*)(F.lds + LCNT_OFF))[F.tid] = 0u; __syncthreads(); }
    f32x4 gv[4];
#pragma unroll
    for (int j = 0; j < 4; ++j) gv[j] = *(const f32x4*)(g + 4 * F.lane + 256 * j);
    f32x4 vn[4]; v2u tn[4];
#pragma unroll
    for (int j = 0; j < 4; ++j) { vn[j] = ((const f32x4*)(X + (size_t)gw * DM) + F.lane)[64 * j]; if constexpr (RESID) tn[j] = ((const v2u*)(T + (size_t)gw * DM) + F.lane)[64 * j]; }
    for (int m = gw; m < M; m += NGW) {
        const int b = m >> 12;
        const f32x4* sh = (const f32x4*)(modl + (size_t)b * 6144 + part * 1024) + F.lane;
        const f32x4* sc = (const f32x4*)(modl + (size_t)b * 6144 + (part + 1) * 1024) + F.lane;
        f32x4 v[4]; v2u tc[4]; float s = 0.f;
#pragma unroll
        for (int j = 0; j < 4; ++j) { v[j] = vn[j]; if constexpr (RESID) tc[j] = tn[j]; }
        { const int mn = (m + NGW < M) ? m + NGW : m;
#pragma unroll
          for (int j = 0; j < 4; ++j) { vn[j] = ((const f32x4*)(X + (size_t)mn * DM) + F.lane)[64 * j]; if constexpr (RESID) tn[j] = ((const v2u*)(T + (size_t)mn * DM) + F.lane)[64 * j]; } }
        if constexpr (RESID) {
            const f32x4* gr = (const f32x4*)(rgate + (size_t)b * 6144) + F.lane; f32x4* xo = (f32x4*)(Xout + (size_t)m * DM) + F.lane;
#pragma unroll
            for (int j = 0; j < 4; ++j) { const v2u t = tc[j]; const f32x4 gg = gr[64 * j];
                v[j].x += gg.x * bf2f(t.x & 0xffffu); v[j].y += gg.y * bf2f(t.x >> 16); v[j].z += gg.z * bf2f(t.y & 0xffffu); v[j].w += gg.w * bf2f(t.y >> 16); xo[64 * j] = v[j]; }
        }
#pragma unroll
        for (int j = 0; j < 4; ++j) s += (v[j].x * v[j].x + v[j].y * v[j].y) + (v[j].z * v[j].z + v[j].w * v[j].w);
        const float r = 1.f / sqrtf(wave_sum(s) * (1.f / DM) + EPS);
        v2u* o8 = (v2u*)(XN + (size_t)m * DM) + F.lane; unsigned* o4 = (unsigned*)((unsigned char*)XN + (size_t)m * DM) + F.lane;
#pragma unroll
        for (int j = 0; j < 4; ++j) { const f32x4 a = sh[64 * j], c1 = sc[64 * j]; v[j] = (v[j] * r) * gv[j]; v[j] = v[j] * (c1 + 1.f) + a;
            if constexpr (F8OUT) { int w = 0; w = __builtin_amdgcn_cvt_pk_fp8_f32(fminf(fmaxf(v[j].x, -448.f), 448.f), fminf(fmaxf(v[j].y, -448.f), 448.f), w, false);
                w = __builtin_amdgcn_cvt_pk_fp8_f32(fminf(fmaxf(v[j].z, -448.f), 448.f), fminf(fmaxf(v[j].w, -448.f), 448.f), w, true); o4[64 * j] = (unsigned)w; }
            else { v2u w; w.x = pk2(v[j].x, v[j].y); w.y = pk2(v[j].z, v[j].w); o8[64 * j] = w; } }
        if constexpr (ROUTER) {
            float lg[8];
#pragma unroll
            for (int e = 0; e < 8; ++e) lg[e] = 0.f;
#pragma unroll
            for (int j = 0; j < 4; ++j)
#pragma unroll
                for (int q = 0; q < 4; ++q) { const float* rw = router_w + (size_t)(4 * F.lane + 256 * j + q) * 8; const f32x4 w0 = *(const f32x4*)rw, w1 = *(const f32x4*)(rw + 4); const float hv = v[j][q];
                    lg[0] += hv * w0.x; lg[1] += hv * w0.y; lg[2] += hv * w0.z; lg[3] += hv * w0.w; lg[4] += hv * w1.x; lg[5] += hv * w1.y; lg[6] += hv * w1.z; lg[7] += hv * w1.w; }
#pragma unroll
            for (int e = 0; e < 8; ++e) lg[e] = wave_sum(lg[e]);
            int e0 = 0; float v0 = lg[0];
#pragma unroll
            for (int e = 1; e < 8; ++e) if (lg[e] > v0) { v0 = lg[e]; e0 = e; }
            int e1 = -1; float v1 = -INFINITY;
#pragma unroll
            for (int e = 0; e < 8; ++e) if (e != e0 && lg[e] > v1) { v1 = lg[e]; e1 = e; }
            const float w1 = 1.f / (1.f + __expf(v0 - v1)), w0 = 1.f - w1;
            if (F.lane == 0) { TOKE[m] = e0 | (e1 << 8); *(f32x2*)(TOKW + 2 * (size_t)m) = (f32x2){w0, w1};
                LAS unsigned* lc = (LAS unsigned*)(F.lds + LCNT_OFF);
                __hip_atomic_fetch_add(lc + e0, 1u, __ATOMIC_RELAXED, __HIP_MEMORY_SCOPE_WORKGROUP); __hip_atomic_fetch_add(lc + e1, 1u, __ATOMIC_RELAXED, __HIP_MEMORY_SCOPE_WORKGROUP); }
        }
    }
    if constexpr (ROUTER) { __syncthreads(); if (F.tid < 16) CNT[F.vcu * 16 + F.tid] = ((LAS unsigned*)(F.lds + LCNT_OFF))[F.tid]; }
}

__device__ __forceinline__ void rope_phase(Frame& F, const int* positions, float* ROPE) {
    const int gw = F.vcu * NWAVES + F.wave, NGW = F.G * NWAVES;
    const int i = F.lane & 15; const float invf = powf(10000.f, -(float)i / 16.f);
    for (int m4 = gw; m4 < M / 4; m4 += NGW) { const int m = 4 * m4 + (F.lane >> 4);
        const float ang = (float)positions[m] * invf; float sn, cs; sincosf(ang, &sn, &cs);
        *(f32x2*)(ROPE + (size_t)m * 32 + 2 * i) = (f32x2){cs, sn}; }
}
__device__ __forceinline__ float log_sigmoid(float x) { return fminf(x, 0.f) - log1pf(__expf(-fabsf(x))); }
__device__ __forceinline__ void scan_phase(Frame& F, const float* FLOG, const float* fb, bf16* QF, bf16* KF) {
    const int sc = (int)blockIdx.x - (F.G - 64);
    if (sc >= 0) {
        const int b = sc >> 3, h = sc & 7; const float bias = fb[h];
        const size_t m0 = (size_t)b * SEQ + 8 * F.tid;
        LAS float* wtot = (LAS float*)(F.lds + LCNT_OFF + 512);
        float lf[8]; float tot = 0.f;
#pragma unroll
        for (int j = 0; j < 8; ++j) { lf[j] = log_sigmoid(FLOG[(m0 + j) * 8 + h] + bias); tot += lf[j]; }
        float inc = tot;
#pragma unroll
        for (int o = 1; o < 64; o <<= 1) { const float t = __shfl_up(inc, o); if (F.lane >= o) inc += t; }
        if (F.lane == 63) wtot[F.wave] = inc;
        __syncthreads();
        float run = inc - tot;
        for (int w = 0; w < F.wave; ++w) run += wtot[w];
#pragma unroll
        for (int j = 0; j < 8; ++j) { run += lf[j]; const float L = run * LOG2E;
            const unsigned hi = f2bf(L); const float r1 = L - bf2f(hi); const unsigned mi = f2bf(r1); const float r2 = r1 - bf2f(mi); const unsigned lo = f2bf(r2);
            const unsigned one = 0x3f80u;
            v4u q0, k0; const v4u z = (v4u){0u, 0u, 0u, 0u};
            q0.x = hi | (mi << 16); q0.y = lo | (one << 16); q0.z = one | (one << 16); q0.w = 0u;
            k0.x = one | (one << 16); k0.y = one | ((hi ^ 0x8000u) << 16); k0.z = (mi ^ 0x8000u) | ((lo ^ 0x8000u) << 16); k0.w = 0u;
            bf16* qp = QF + (m0 + j) * QF_P + h * 80 + 64; bf16* kp = KF + (m0 + j) * KF_P + h * 80 + 64;
            *(v4u*)qp = q0; *(v4u*)(qp + 8) = z; *(v4u*)kp = k0; *(v4u*)(kp + 8) = z; }
    }
    __syncthreads();
}

__device__ __forceinline__ void route_phase(Frame& F, const unsigned* CNT  , const int* TOKE, int* ROWTOK, int* TOKSLOT, int* TEXP  ) {
    LAS unsigned* sh = (LAS unsigned*)(F.lds + LCNT_OFF);
    const int gw = F.vcu * NWAVES + F.wave, NGW = F.G * NWAVES;
    if (F.tid < 8) sh[64 + F.tid] = 0u;
    { const int e = F.wave; unsigned tot = 0u, pre = 0u;
#pragma unroll
        for (int j = 0; j < 4; ++j) { const int wg = F.lane + 64 * j; const unsigned v = (wg < F.G) ? CNT[wg * 16 + e] : 0u; tot += v; pre += (wg < F.vcu) ? v : 0u; }
#pragma unroll
        for (int o = 1; o < 64; o <<= 1) { tot += __shfl_xor(tot, o); pre += __shfl_xor(pre, o); }
        if (F.lane == 0) { sh[e] = tot; sh[16 + e] = pre; } }
    __syncthreads();
    if (F.tid < 8) { unsigned st = 0u;
        for (int t2 = 0; t2 < F.tid; ++t2) st += (sh[t2] + 255u) & ~255u;
        sh[48 + F.tid] = st; sh[32 + F.tid] = st + sh[16 + F.tid]; }
    __syncthreads();
    if (F.lane < 16) { const int m = gw + F.lane * NGW;
        if (m < M) { const int te = TOKE[m]; const int e0 = te & 255, e1 = te >> 8;
            const unsigned i0 = __hip_atomic_fetch_add(sh + 64 + e0, 1u, __ATOMIC_RELAXED, __HIP_MEMORY_SCOPE_WORKGROUP), i1 = __hip_atomic_fetch_add(sh + 64 + e1, 1u, __ATOMIC_RELAXED, __HIP_MEMORY_SCOPE_WORKGROUP);
            const unsigned s0 = sh[32 + e0] + i0, s1 = sh[32 + e1] + i1;
            ROWTOK[s0] = m; ROWTOK[s1] = m; TOKSLOT[2 * m] = (int)s0; TOKSLOT[2 * m + 1] = (int)s1; } }
    if (F.vcu < 8) { const unsigned tot = sh[F.vcu], seg = sh[48 + F.vcu], end = (tot + 255u) & ~255u;
        for (unsigned r = tot + F.tid; r < end; r += NWAVES * 64) ROWTOK[seg + r] = -1; }
    if (F.vcu == 16 && F.tid == 0) { int t = 0;
        for (int e = 0; e < 8; ++e) { t += (int)((sh[e] + 255u) >> 8); TEXP[1 + e] = t; }
        TEXP[0] = t; }
    __syncthreads();
}

__device__ __forceinline__ void outnorm_phase(Frame& F, bf16* O, const float* g1, const float* g2) {
    const int gw = F.vcu * NWAVES + F.wave, NGW = F.G * NWAVES;
    float ga[8], gb[8];
#pragma unroll
    for (int j = 0; j < 8; ++j) { ga[j] = g1[8 * F.lane + j]; gb[j] = g2[8 * F.lane + j]; }
    for (int m = gw; m < M; m += NGW) {
        v4u* p = (v4u*)(O + (size_t)m * O_P) + F.lane;
        const v4u a = p[0], b = p[64];
        float fa[8], fbv[8]; float sa = 0.f, sb = 0.f;
#pragma unroll
        for (int j = 0; j < 4; ++j) { fa[2 * j] = bf2f(a[j] & 0xffffu); fa[2 * j + 1] = bf2f(a[j] >> 16); fbv[2 * j] = bf2f(b[j] & 0xffffu); fbv[2 * j + 1] = bf2f(b[j] >> 16); }
#pragma unroll
        for (int j = 0; j < 8; ++j) { sa += fa[j] * fa[j]; sb += fbv[j] * fbv[j]; }
        const float ra = 1.f / sqrtf(wave_sum(sa) * (1.f / 512.f) + EPS), rb = 1.f / sqrtf(wave_sum(sb) * (1.f / 512.f) + EPS);
        v4u oa, ob;
#pragma unroll
        for (int j = 0; j < 4; ++j) { oa[j] = pk2(fa[2 * j] * ra * ga[2 * j], fa[2 * j + 1] * ra * ga[2 * j + 1]); ob[j] = pk2(fbv[2 * j] * rb * gb[2 * j], fbv[2 * j + 1] * rb * gb[2 * j + 1]); }
        p[0] = oa; p[64] = ob;
    }
}

__device__ __forceinline__ void final_phase(Frame& F, float* X, const float* g, const bf16* Y, const bf16* Yp, const int* TEXP, const int* TOKSLOT, const float* TOKW, const float* gf  ) {
    const int gw = F.vcu * NWAVES + F.wave, NGW = F.G * NWAVES;
    int tail0, S; size_t pstride;
    { pg8::MoeOrderD O; O.init_d(__builtin_amdgcn_readfirstlane(TEXP[0]), FF / 128, F.G, 0); S = O.S; tail0 = O.mainM * 256; pstride = (size_t)(O.tailSub / (4 * O.S)) * 256 * DM; }
    f32x4 gv[4];
#pragma unroll
    for (int j = 0; j < 4; ++j) gv[j] = *(const f32x4*)(g + 4 * F.lane + 256 * j);
    for (int m = gw; m < M; m += NGW) {
        const int b = m >> 12;
        f32x4* xr = (f32x4*)(X + (size_t)m * DM) + F.lane;
        const int s0 = TOKSLOT[2 * m], s1 = TOKSLOT[2 * m + 1]; const float w0 = TOKW[2 * m], w1 = TOKW[2 * m + 1];
        const v2u* y0 = (const v2u*)(Y + (size_t)s0 * DM) + F.lane; const v2u* y1 = (const v2u*)(Y + (size_t)s1 * DM) + F.lane; const f32x4* gr = (const f32x4*)(gf + (size_t)b * 6144) + F.lane;
        f32x4 v[4]; float s = 0.f;
#pragma unroll
        for (int j = 0; j < 4; ++j) { v[j] = xr[64 * j]; const v2u a = y0[64 * j], c = y1[64 * j]; const f32x4 gg = gr[64 * j];
            v[j].x += gg.x * (w0 * bf2f(a.x & 0xffffu) + w1 * bf2f(c.x & 0xffffu)); v[j].y += gg.y * (w0 * bf2f(a.x >> 16) + w1 * bf2f(c.x >> 16));
            v[j].z += gg.z * (w0 * bf2f(a.y & 0xffffu) + w1 * bf2f(c.y & 0xffffu)); v[j].w += gg.w * (w0 * bf2f(a.y >> 16) + w1 * bf2f(c.y >> 16));
        }
        if (S > 1 && (s0 >= tail0 || s1 >= tail0)) {
#pragma unroll 1
            for (int k = 0; k < 2; ++k) { const int sk = k ? s1 : s0; const float wk = k ? w1 : w0; if (sk < tail0) continue;
#pragma unroll 1
                for (int p = 1; p < S; ++p) { const v2u* yp = (const v2u*)(Yp + (size_t)(p - 1) * pstride + (size_t)(sk - tail0) * DM) + F.lane;
#pragma unroll
                    for (int j = 0; j < 4; ++j) { const v2u a = yp[64 * j]; const f32x4 gg = gr[64 * j];
                        v[j].x += gg.x * (wk * bf2f(a.x & 0xffffu)); v[j].y += gg.y * (wk * bf2f(a.x >> 16)); v[j].z += gg.z * (wk * bf2f(a.y & 0xffffu)); v[j].w += gg.w * (wk * bf2f(a.y >> 16)); } } } }
#pragma unroll
        for (int j = 0; j < 4; ++j) s += (v[j].x * v[j].x + v[j].y * v[j].y) + (v[j].z * v[j].z + v[j].w * v[j].w);
        const float r = 1.f / sqrtf(wave_sum(s) * (1.f / DM) + EPS);
#pragma unroll
        for (int j = 0; j < 4; ++j) xr[64 * j] = (v[j] * r) * gv[j];
    }
}

typedef __bf16 bf16x2_t __attribute__((ext_vector_type(2)));
template <int DQK>
__device__ __forceinline__ void attn_naive_unit(Frame& F, const bf16* Q, int qpitch, const bf16* K, int kpitch, const bf16* V, int vpitch, bf16* O  , int b, int h, int qb) {
    LAS unsigned* Ksh = (LAS unsigned*)F.lds;
    LAS float* Vsh = (LAS float*)(F.lds + 64 * DQK * 2);
    const int tid = F.tid, qpos = qb * 512 + tid; const size_t row = (size_t)b * SEQ + qpos;
    unsigned q[DQK / 2]; float o[64];
    { const bf16* qp = Q + row * qpitch + h * DQK;
#pragma unroll
      for (int d8 = 0; d8 < DQK / 8; ++d8) { const v4u w = *(const v4u*)(qp + 8 * d8);
#pragma unroll
          for (int j = 0; j < 4; ++j) q[4 * d8 + j] = w[j]; } }
#pragma unroll
    for (int d = 0; d < 64; ++d) o[d] = 0.f;
    float mrun = -INFINITY, l = 0.f;
    const int ntile = 8 * (qb + 1);
    for (int t = 0; t < ntile; ++t) {
        __syncthreads();
        for (int idx = tid; idx < 64 * DQK / 8; idx += NWAVES * 64) { const int r = idx / (DQK / 8), c8 = idx % (DQK / 8);
            const v4u w = *(const v4u*)(K + ((size_t)b * SEQ + t * 64 + r) * kpitch + h * DQK + 8 * c8); *(LAS v4u*)(Ksh + r * (DQK / 2) + 4 * c8) = w; }
        { const int r = tid >> 3, c8 = tid & 7; const v4u w = *(const v4u*)(V + ((size_t)b * SEQ + t * 64 + r) * vpitch + h * 64 + 8 * c8); LAS float* d = Vsh + r * 64 + 8 * c8;
#pragma unroll
          for (int j = 0; j < 4; ++j) { d[2 * j] = bf2f(w[j] & 0xffffu); d[2 * j + 1] = bf2f(w[j] >> 16); } }
        __syncthreads();
        const int kbase = t * 64;
#pragma unroll 1
        for (int gk = 0; gk < 16; ++gk) {
            float s[4]; float mx = -INFINITY;
#pragma unroll
            for (int j = 0; j < 4; ++j) { const LAS unsigned* kr = Ksh + (gk * 4 + j) * (DQK / 2); float a = 0.f;
#pragma unroll
                for (int d = 0; d < DQK / 2; ++d) a = __builtin_amdgcn_fdot2_f32_bf16(__builtin_bit_cast(bf16x2_t, q[d]), __builtin_bit_cast(bf16x2_t, kr[d]), a, false);
                s[j] = (kbase + gk * 4 + j <= qpos) ? a : -INFINITY; mx = fmaxf(mx, s[j]); asm volatile("" ::: "memory"); }
            const float mnew = fmaxf(mrun, mx);
            if (mnew > -INFINITY) {
                const float alpha = __builtin_amdgcn_exp2f(mrun - mnew);
                l *= alpha;
#pragma unroll
                for (int d = 0; d < 64; ++d) o[d] *= alpha;
#pragma unroll
                for (int j = 0; j < 4; ++j) { const float p = __builtin_amdgcn_exp2f(s[j] - mnew); l += p; const LAS float* vr = Vsh + (gk * 4 + j) * 64;
#pragma unroll
                    for (int dc = 0; dc < 4; ++dc) {
#pragma unroll
                        for (int d = 0; d < 16; ++d) o[dc * 16 + d] += p * vr[dc * 16 + d];
                        asm volatile("" ::: "memory"); } }
                mrun = mnew;
            }
        }
    }
    const float rl = 1.f / l;
    bf16* op = O + row * O_P + h * 64;
#pragma unroll
    for (int d8 = 0; d8 < 8; ++d8) { v4u w;
#pragma unroll
        for (int j = 0; j < 4; ++j) w[j] = pk2(o[8 * d8 + 2 * j] * rl, o[8 * d8 + 2 * j + 1] * rl);
        *(v4u*)(op + 8 * d8) = w; }
    __syncthreads();
}

namespace att {
using f32x16 = __attribute__((ext_vector_type(16))) float;
using s16x4 = __attribute__((ext_vector_type(4))) short;
using u32x4 = __attribute__((ext_vector_type(4))) unsigned;
typedef __attribute__((address_space(3))) const char* lds_cptr;
typedef short v4i16_t __attribute__((ext_vector_type(4)));
__device__ __forceinline__ int crow(int r, int hi) { return (r & 3) + 8 * (r >> 2) + 4 * hi; }
__device__ __forceinline__ void glds16(const void* gsrc, unsigned lds_dst) { unsigned keep;
    asm volatile("s_mov_b32 %0, m0\n\ts_mov_b32 m0, %2\n\ts_nop 0\n\tglobal_load_lds_dwordx4 %1, off\n\ts_mov_b32 m0, %0" : "=&s"(keep) : "v"(gsrc), "s"(lds_dst) : "memory"); }
__device__ __forceinline__ unsigned cvtpk(float lo, float hi) { unsigned r; asm("v_cvt_pk_bf16_f32 %0, %1, %2" : "=v"(r) : "v"(lo), "v"(hi)); return r; }
#define ATT_WAIT_BAR(N) asm volatile("s_waitcnt vmcnt(" #N ") lgkmcnt(0)\n\ts_barrier" ::: "memory")
constexpr float THR = 8.f;

__device__ __forceinline__ float max3f(float a, float b, float c) { float r; asm("v_max3_f32 %0, %1, %2, %3" : "=v"(r) : "v"(a), "v"(b), "v"(c)); return r; }
__device__ __forceinline__ float max2f(float a, float b) { float r; asm("v_max_f32_e32 %0, %1, %2" : "=v"(r) : "v"(a), "v"(b)); return r; }
__device__ __forceinline__ float fadd_s(float a, float b) { float r; asm("v_add_f32_e32 %0, %1, %2" : "=v"(r) : "v"(a), "v"(b)); return r; }
__device__ __forceinline__ float fsub_s(float a, float b) { float r; asm("v_sub_f32_e32 %0, %1, %2" : "=v"(r) : "v"(a), "v"(b)); return r; }
__device__ __forceinline__ float fmul_s(float a, float b) { float r; asm("v_mul_f32_e32 %0, %1, %2" : "=v"(r) : "v"(a), "v"(b)); return r; }

template <int DQK>
__device__ __forceinline__ void attn_unit(const bf16* Q, const bf16* K, const bf16* V, bf16* O, float* SSQO  , int b, int h, int qb, char* shm) {
    constexpr int NK = DQK / 16, NCH = DQK / 8, NX = NCH - 8, KBYTES = NCH * 1024, SLOT = KBYTES + 8192, PITCH = 8 * DQK;
    constexpr int LDS_WS = 3 * SLOT, LDS_OST = LDS_WS + 8 * 256;
    int tid_ = threadIdx.x; asm volatile("" : "+v"(tid_));
    const int tid = tid_, lane = tid & 63, r32 = lane & 31, hi = lane >> 5; const int wid = __builtin_amdgcn_readfirstlane(tid >> 6);
    const long rowbase = (long)b * SEQ; const int q0 = qb * 256;
    const bf16* Qw = Q + (rowbase + q0 + wid * 32) * PITCH + h * DQK;
    const bf16* Kh = K + rowbase * PITCH + h * DQK; const bf16* Vh = V + rowbase * 512 + h * 64;
    const unsigned lds0 = (unsigned)(uintptr_t)shm;
    float* wsf = (float*)(shm + LDS_WS) + wid * 64;
    const int NT = 4 * (qb + 1);
    const bf16* ksrc0 = Kh + ((long)(NT - 1) * 64 + lane) * PITCH + wid * 8;
    const bf16* vsrc = Vh + ((long)(NT - 1) * 64 + 16 * (wid & 3) + (lane >> 2)) * 512 + (wid >> 2) * 32 + (lane & 3) * 8;
#define ATT_DMA(back, slotoff) do { const unsigned _d = (unsigned)__builtin_amdgcn_readfirstlane(lds0 + (slotoff)); \
        glds16(ksrc0 - (long)(back) * 64 * PITCH, _d + wid * 1024); if (wid < NX) glds16(ksrc0 - (long)(back) * 64 * PITCH + 64, _d + (8 + wid) * 1024); \
        glds16(vsrc - (long)(back) * 64 * 512, _d + KBYTES + wid * 1024); } while (0)
    ATT_DMA(0, 0); ATT_DMA(1, SLOT);
    bf16x8 qr[NK];
#pragma unroll
    for (int d0 = 0; d0 < NK; ++d0) qr[d0] = *reinterpret_cast<const bf16x8*>(&Qw[(long)r32 * PITCH + d0 * 16 + hi * 8]);
#pragma unroll
    for (int d0 = 0; d0 < NK; ++d0) asm volatile("" : "+v"(qr[d0]));
    asm volatile("s_waitcnt vmcnt(0)" ::: "memory");
    float mhat = 0.f, l_reg = 0.f; f32x16 o[2]; o[0] = f32x16{}; o[1] = f32x16{};
    const int jdiag = wid >> 1;
    const lds_cptr kp0 = (lds_cptr)shm + hi * 1024 + r32 * 16;
    const lds_cptr vp0 = (lds_cptr)shm + KBYTES + ((lane >> 4) & 1) * 32 + (lane & 3) * 8 + (4 * hi + ((lane & 15) >> 2)) * 64;
    f32x16 p0, p1; s16x4 vlo[8], vhi[8];
#define ATT_A(slot) do { \
        bf16x8 kf[2 * NK]; \
        _Pragma("unroll") for (int d0 = 0; d0 < NK; ++d0) { kf[2 * d0] = *(const __attribute__((address_space(3))) bf16x8*)(kp0 + (slot) + d0 * 2048); kf[2 * d0 + 1] = *(const __attribute__((address_space(3))) bf16x8*)(kp0 + (slot) + d0 * 2048 + 512); } \
        __builtin_amdgcn_sched_barrier(0); \
        _Pragma("unroll") for (int i = 0; i < 8; ++i) { \
            vlo[i] = __builtin_bit_cast(s16x4, __builtin_amdgcn_ds_read_tr16_b64_v4i16((__attribute__((address_space(3))) v4i16_t*)(vp0 + (slot) + (i >> 2) * 4096 + (i & 3) * 1024))); \
            vhi[i] = __builtin_bit_cast(s16x4, __builtin_amdgcn_ds_read_tr16_b64_v4i16((__attribute__((address_space(3))) v4i16_t*)(vp0 + (slot) + (i >> 2) * 4096 + (i & 3) * 1024 + 512))); } \
        __builtin_amdgcn_sched_barrier(0); \
        f32x16 c; \
        _Pragma("unroll") for (int r = 0; r < 16; ++r) c[r] = -mhat; \
        _Pragma("unroll") for (int i = 0; i < 2 * NK; ++i) asm volatile("" : "+v"(kf[i])); \
        p0 = __builtin_amdgcn_mfma_f32_32x32x16_bf16(kf[0], qr[0], c, 0, 0, 0); p1 = __builtin_amdgcn_mfma_f32_32x32x16_bf16(kf[1], qr[0], c, 0, 0, 0); \
        _Pragma("unroll") for (int d0 = 1; d0 < NK; ++d0) { p0 = __builtin_amdgcn_mfma_f32_32x32x16_bf16(kf[2 * d0], qr[d0], p0, 0, 0, 0); p1 = __builtin_amdgcn_mfma_f32_32x32x16_bf16(kf[2 * d0 + 1], qr[d0], p1, 0, 0, 0); } \
        _Pragma("unroll") for (int i = 0; i < 8; ++i) { asm volatile("" : "+v"(vlo[i])); asm volatile("" : "+v"(vhi[i])); } \
        asm volatile("s_nop 15\n\ts_nop 7" : "+v"(p0), "+v"(p1));        \
    } while (0)
#define ATT_B(MODE) do { \
        if (MODE == 1) { int qrel = wid * 32 + r32; asm volatile("" : "+v"(qrel)); const int kb = 64 * jdiag + 4 * hi; \
            _Pragma("unroll") for (int r = 0; r < 16; ++r) { const int kv = kb + (r & 3) + 8 * (r >> 2); if (kv > qrel) p0[r] = -INFINITY; if (kv + 32 > qrel) p1[r] = -INFINITY; } } \
        float rm; \
        { float a0 = max3f(p0[0], p0[1], p1[0]), a1 = max3f(p0[2], p0[3], p1[1]), a2 = max3f(p0[4], p0[5], p1[2]), a3 = max3f(p0[6], p0[7], p1[3]); \
          a0 = max3f(a0, p0[8], p0[9]); a1 = max3f(a1, p0[10], p0[11]); a2 = max3f(a2, p0[12], p0[13]); a3 = max3f(a3, p0[14], p0[15]); \
          a0 = max3f(a0, p1[4], p1[5]); a1 = max3f(a1, p1[6], p1[7]); a2 = max3f(a2, p1[8], p1[9]); a3 = max3f(a3, p1[10], p1[11]); \
          a0 = max3f(a0, p1[12], p1[13]); a1 = max3f(a1, p1[14], p1[15]); rm = max2f(max2f(a0, a1), max2f(a2, a3)); } \
        asm volatile("s_nop 1" : "+v"(rm));                                     \
        { auto rr = __builtin_amdgcn_permlane32_swap(__float_as_uint(rm), __float_as_uint(rm), false, false); float r0_ = __uint_as_float(rr[0]), r1_ = __uint_as_float(rr[1]); asm volatile("s_nop 1" : "+v"(r0_), "+v"(r1_)); rm = max2f(r0_, r1_); } \
        if (MODE == 1) { mhat += rm; \
            _Pragma("unroll") for (int r = 0; r < 16; ++r) { p0[r] = fsub_s(p0[r], rm); p1[r] = fsub_s(p1[r], rm); } } \
        else if (__builtin_expect(__any(rm > THR), 0)) { const float dl = fmaxf(rm, 0.f); mhat += dl; \
            _Pragma("unroll") for (int r = 0; r < 16; ++r) { p0[r] = fsub_s(p0[r], dl); p1[r] = fsub_s(p1[r], dl); } \
            const float f = __builtin_amdgcn_exp2f(-dl); l_reg *= f; if (hi == 0) wsf[r32] = f; \
            asm volatile("s_waitcnt lgkmcnt(0)" ::: "memory"); \
            _Pragma("unroll") for (int r4 = 0; r4 < 4; ++r4) { const f32x4 fv = *(const f32x4*)(wsf + 8 * r4 + 4 * hi); \
                _Pragma("unroll") for (int j = 0; j < 4; ++j) { o[0][4 * r4 + j] = fmul_s(o[0][4 * r4 + j], fv[j]); o[1][4 * r4 + j] = fmul_s(o[1][4 * r4 + j], fv[j]); } } } \
        _Pragma("unroll") for (int r = 0; r < 16; ++r) { p0[r] = __builtin_amdgcn_exp2f(p0[r]); p1[r] = __builtin_amdgcn_exp2f(p1[r]); } \
        asm volatile("s_nop 1" : "+v"(p0), "+v"(p1));                      \
        float sa0 = 0.f, sa1 = 0.f, sa2 = 0.f, sa3 = 0.f; \
        _Pragma("unroll") for (int r = 0; r < 16; r += 4) { \
            sa0 = fadd_s(sa0, p0[r]); sa1 = fadd_s(sa1, p0[r + 1]); sa2 = fadd_s(sa2, p0[r + 2]); sa3 = fadd_s(sa3, p0[r + 3]); \
            sa0 = fadd_s(sa0, p1[r]); sa1 = fadd_s(sa1, p1[r + 1]); sa2 = fadd_s(sa2, p1[r + 2]); sa3 = fadd_s(sa3, p1[r + 3]); } \
        l_reg += fadd_s(fadd_s(sa0, sa1), fadd_s(sa2, sa3)); \
        u32x4 pw[4]; \
        _Pragma("unroll") for (int j = 0; j < 4; ++j) { pw[0][j] = cvtpk(p0[2 * j], p0[2 * j + 1]); pw[1][j] = cvtpk(p0[8 + 2 * j], p0[8 + 2 * j + 1]); pw[2][j] = cvtpk(p1[2 * j], p1[2 * j + 1]); pw[3][j] = cvtpk(p1[8 + 2 * j], p1[8 + 2 * j + 1]); } \
        asm volatile("s_nop 3" : "+v"(pw[0]), "+v"(pw[1]), "+v"(pw[2]), "+v"(pw[3]), "+v"(o[0]), "+v"(o[1]));     \
        _Pragma("unroll") for (int ks = 0; ks < 4; ++ks) _Pragma("unroll") for (int d0 = 0; d0 < 2; ++d0) { const int i = d0 * 4 + ks; \
            const bf16x8 vf = (bf16x8){vlo[i][0], vlo[i][1], vlo[i][2], vlo[i][3], vhi[i][0], vhi[i][1], vhi[i][2], vhi[i][3]}; \
            o[d0] = __builtin_amdgcn_mfma_f32_32x32x16_bf16(__builtin_bit_cast(bf16x8, pw[ks]), vf, o[d0], 0, 0, 0); } \
    } while (0)
#define ATT_SYNC(k) do { if ((k) + 1 < NT) { if (wid < NX) ATT_WAIT_BAR(3); else ATT_WAIT_BAR(2); } else ATT_WAIT_BAR(0); } while (0)
    const bool late = wid >= 4;
    if (late) { ATT_SYNC(0); ATT_DMA(2, 2 * SLOT); }
#pragma unroll
    for (int s = 0; s < 4; ++s) {
        if (!late) { ATT_SYNC(s); if (s + 2 < NT) ATT_DMA(s + 2, ((s + 2) % 3) * SLOT); }
        const int jb = 3 - s;
        if (jb <= jdiag) ATT_A((s % 3) * SLOT);
        if (late && s + 1 < NT) { ATT_SYNC(s + 1); if (s + 3 < NT) ATT_DMA(s + 3, (s % 3) * SLOT); }
        if (jb == jdiag) ATT_B(1); else if (jb < jdiag) ATT_B(0);
    }
    int slot = SLOT, slot2 = 0;
#pragma unroll 1
    for (int s = 4; s < NT; ++s) {
        if (!late) { ATT_SYNC(s); if (s + 2 < NT) ATT_DMA(s + 2, slot2); }
        ATT_A(slot);
        if (late && s + 1 < NT) { ATT_SYNC(s + 1); if (s + 3 < NT) ATT_DMA(s + 3, slot); }
        ATT_B(0);
        slot = (slot == 2 * SLOT) ? 0 : slot + SLOT; slot2 = (slot2 == 2 * SLOT) ? 0 : slot2 + SLOT;
    }
#undef ATT_SYNC
#undef ATT_A
#undef ATT_B
    { auto rr = __builtin_amdgcn_permlane32_swap(__float_as_uint(l_reg), __float_as_uint(l_reg), false, false); l_reg = __uint_as_float(rr[0]) + __uint_as_float(rr[1]); }
    if (hi == 0) wsf[32 + r32] = l_reg; asm volatile("s_waitcnt lgkmcnt(0)" ::: "memory");
    float rli[16];
#pragma unroll
    for (int r = 0; r < 16; ++r) rli[r] = __builtin_amdgcn_rcpf(wsf[32 + crow(r, hi)]);
    bf16* Ow = O + (rowbase + q0 + wid * 32) * O_P + h * 64;
    { bf16* stg = (bf16*)(shm + LDS_OST) + wid * 2048;
#pragma unroll
      for (int r = 0; r < 16; ++r) { const int orow = crow(r, hi);
#pragma unroll
          for (int d0 = 0; d0 < 2; ++d0) stg[orow * 64 + d0 * 32 + r32] = (bf16)f2bf(o[d0][r] * rli[r]); }
      asm volatile("s_waitcnt lgkmcnt(0)" ::: "memory");
#pragma unroll
      for (int i = 0; i < 4; ++i) { const int row = i * 8 + (lane >> 3), ch = lane & 7; const u32x4 v = *(const u32x4*)(stg + row * 64 + ch * 8); *(u32x4*)(Ow + (long)row * O_P + ch * 8) = v;
          float ss = 0.f;
#pragma unroll
          for (int j = 0; j < 4; ++j) { const float lo_ = bf2f(v[j] & 0xffffu), hi_ = bf2f(v[j] >> 16); ss += lo_ * lo_ + hi_ * hi_; }
          ss += __shfl_xor(ss, 1); ss += __shfl_xor(ss, 2); ss += __shfl_xor(ss, 4);
          if (ch == 0) SSQO[(size_t)(rowbase + q0 + wid * 32 + row) * 16 + h] = ss; } }
    asm volatile("s_waitcnt lgkmcnt(0)\n\ts_barrier" ::: "memory");
#undef ATT_DMA
}
}

constexpr int PH_PRO = 0, PH_L0 = 1, PH_L1 = 11, PH_MOE = 19, PH_FINAL = 22, N_PHASES = 23;

__device__ __forceinline__ void weights_phase(Frame& F, const Args& args) {
    unsigned char* ws = args.ws;
#pragma unroll 1
    for (int l = 0; l < 2; ++l) {
        conv_matrix(F, SrcWin{args.in[6] + (size_t)l * 1024 * 1960, 1960}, 1024, 1024, INC, (bf16*)(ws + WS_WIN) + (size_t)l * INC * 1024, 1024 * l);
        conv_matrix(F, SrcWuq{args.in[8] + (size_t)l * 256 * 768, 768, args.in[7] + l * 256}, 256, 256, 768, (bf16*)(ws + WS_WUQ) + (size_t)l * 768 * 256, 96 * l);
        conv_matrix(F, SrcWukv{args.in[10] + (size_t)l * 128 * 1024, 1024, args.in[9] + l * 128}, 128, 128, 1024, (bf16*)(ws + WS_WUKV) + (size_t)l * 1024 * 128, 192 + 64 * l);
    }
    __syncthreads();
#pragma unroll 1
    for (int l = 0; l < 2; ++l)
        conv_matrix_wg<SrcPlainG, false>(F, SrcPlainG{args.in[14] + (size_t)l * 1024 * 1024, 1024, args.in[12] + l * 512, args.in[13] + l * 512}, 1024, 1024, 1024, ws + WS_WO + (size_t)l * 1024 * 1024 * 2, 1.f, 40 + 64 * l);
    conv_matrix_wg<SrcGU, true>(F, SrcGU{args.in[16], args.in[17], FF}, 1024, 1024, 2 * FF, ws + WS_WGU0, SC_WGU, 168);
    conv_matrix_wg<SrcPlain, true>(F, SrcPlain{args.in[18], 1024}, FF, FF, 1024, ws + WS_WD0, SC_WD, 136);
}

__global__ void __launch_bounds__(NWAVES * 64, 2) fwd_kernel(Args args) {
    extern __shared__ __attribute__((aligned(16))) unsigned char lds[];
    Frame F;
    F.lds = (LAS unsigned char*)lds;
    F.tid = threadIdx.x; F.lane = F.tid & 63; F.wave = __builtin_amdgcn_readfirstlane(F.tid >> 6);
    F.G = gridDim.x; { const int bx = blockIdx.x; F.vcu = (F.G % 8 == 0) ? (bx % 8) * (F.G / 8) + bx / 8 : bx; }
    F.ws = args.ws;
    unsigned char* ws = args.ws;
    for (int u = F.tid; u < (LDS_BYTES - LDSCTL_OFF) / 4; u += NWAVES * 64) ((LAS unsigned*)(F.lds + LDSCTL_OFF))[u] = 0u;
    __syncthreads();
#if MK_ONE_LAUNCH
    XcdBarrier bar = xcd_barrier_post((unsigned*)(ws + WS_CTL) + CW_BAR, (volatile LAS unsigned*)(F.lds + MISC_OFF) + 8);
#define SEAM(k) do { if (lo <= (k) && (k) + 1 < hi) xcd_barrier(bar); } while (0)
#else
#define SEAM(k) do { } while (0)
#endif
    const int lo = args.ph_lo, hi = args.ph_hi;
#ifndef PHSEL
#define PHSEL 0xFFFFu
#endif
#define IN(k) (lo <= (k) && (k) < hi)
#define SEL(kind) (((PHSEL) >> (kind)) & 1u)

#define FRESH() do { int t_ = threadIdx.x; asm volatile("" : "+v"(t_)); F.tid = t_; F.lane = t_ & 63; F.wave = __builtin_amdgcn_readfirstlane(t_ >> 6); } while (0)
#define INP(k) (args.in[k])
#define WSP(T, off) ((T*)(ws + (off)))
    float* X = args.out;

    if (SEL(0) && IN(PH_PRO)) { FRESH();
        rope_phase(F, (const int*)INP(2), WSP(float, WS_ROPE));
        mod_phase(F, INP(1), INP(3), INP(4), WSP(float, WS_MOD));
    }
    SEAM(PH_PRO);

#define LAYER_MIXER(l, pb) do { \
          \
        if (SEL(1) && IN(pb + 0)) { FRESH(); \
            if (l == 0) { norm_phase<false, false>(F, INP(0), INP(5), WSP(float, WS_MOD), 0, WSP(bf16, WS_XN), nullptr, nullptr, nullptr, nullptr, nullptr, nullptr, nullptr); weights_phase(F, args); } \
            else norm_phase<false, true>(F, X, INP(5) + 1024, WSP(float, WS_MOD) + (size_t)8 * 6144, 0, WSP(bf16, WS_XN), nullptr, nullptr, nullptr, nullptr, WSP(bf16, WS_T2), WSP(float, WS_MOD) + 5 * 1024, X); } \
        SEAM(pb + 0); \
          \
        if (SEL(2) && IN(pb + 1)) { \
            pg8::Gemm g{WSP(bf16, WS_XN), WSP(bf16, WS_WIN) + (size_t)l * INC * 1024, 1024, 0, nullptr}; pg8::StaticOrder S; S.init(M, INC, F.G, (int)blockIdx.x); \
            pg8::EpiInproj E{WSP(bf16, WS_CQN), WSP(bf16, WS_CKVN), WSP(bf16, WS_KM), WSP(float, WS_SSQQ), WSP(float, WS_SSQKV), WSP(float, WS_FLOG), WSP(float, WS_ROPE), WSP(bf16, WS_QF), WSP(bf16, WS_KF), WSP(bf16, WS_VF)}; \
            pg8::gemm_phase<pg8::EpiInproj, pg8::StaticOrder, true, true>(F.lds, g, S, E); } \
        SEAM(pb + 1); \
          \
        if (SEL(4) && IN(pb + 3)) { FRESH(); scan_phase(F, WSP(float, WS_FLOG), INP(11) + l * 8, WSP(bf16, WS_QF), WSP(bf16, WS_KF)); \
            { pg8::Gemm g{WSP(bf16, WS_CQN), WSP(bf16, WS_WUQ) + (size_t)l * 768 * 256, 256, 0, nullptr}; pg8::StaticOrder S; S.init(M, 768, F.G, (int)blockIdx.x); \
              pg8::EpiQ E{WSP(bf16, WS_QM), WSP(float, WS_ROPE), WSP(float, WS_SSQQ)}; pg8::gemm_phase<pg8::EpiQ, pg8::StaticOrder, true, true>(F.lds, g, S, E); } \
            { int kkv = 128; asm volatile("" : "+s"(kkv)); pg8::Gemm g{WSP(bf16, WS_CKVN), WSP(bf16, WS_WUKV) + (size_t)l * 1024 * 128, kkv, 0, nullptr}; pg8::StaticOrder S; S.init(M, 1024, F.G, (int)blockIdx.x); \
              pg8::EpiKV E{WSP(bf16, WS_KM), WSP(bf16, WS_VM), WSP(float, WS_SSQKV)}; pg8::gemm_phase<pg8::EpiKV, pg8::StaticOrder, true, true>(F.lds, g, S, E); } } \
        SEAM(pb + 3); \
          \
        if (SEL(5) && IN(pb + 4)) { \
            const int bh = F.vcu >> 2, s4 = F.vcu & 3, b = bh >> 3, h = bh & 7; \
            _Pragma("unroll 1") for (int i = 0; i < 4; ++i) { const int p = (i & 2) ? 7 - s4 : s4, qb = (i & 1) ? 15 - p : p; \
                att::attn_unit<96>(WSP(bf16, WS_QM), WSP(bf16, WS_KM), WSP(bf16, WS_VM), WSP(bf16, WS_O), WSP(float, WS_SSQO), b, h, qb, (char*)lds); } \
            _Pragma("unroll 1") for (int i = 0; i < 4; ++i) { const int p = (i & 2) ? 7 - s4 : s4, qb = (i & 1) ? 15 - p : p; \
                att::attn_unit<80>(WSP(bf16, WS_QF), WSP(bf16, WS_KF), WSP(bf16, WS_VF), WSP(bf16, WS_O) + 512, WSP(float, WS_SSQO) + 8, b, h, qb, (char*)lds); } } \
        SEAM(pb + 4); \
          \
        if (SEL(7) && IN(pb + 6)) { \
            pg8::Gemm g{WSP(bf16, WS_O), WSP(bf16, WS_WO) + (size_t)l * 1024 * 1024, 1024, 0, nullptr}; pg8::StaticOrder S; S.init(M, 1024, F.G, (int)blockIdx.x); \
            pg8::EpiWo E{WSP(bf16, WS_T1), WSP(float, WS_SSQO)}; \
            pg8::gemm_phase<pg8::EpiWo, pg8::StaticOrder, true, true>(F.lds, g, S, E); } \
        SEAM(pb + 6); \
    } while (0)

    LAYER_MIXER(0, PH_L0);
    if (SEL(8) && IN(PH_L0 + 7)) { FRESH(); norm_phase<false, true, true>(F, INP(0), INP(15), WSP(float, WS_MOD), 3, WSP(bf16, WS_XN8), nullptr, nullptr, nullptr, nullptr, WSP(bf16, WS_T1), WSP(float, WS_MOD) + 2 * 1024, X); }
    SEAM(PH_L0 + 7);
    if (SEL(9) && IN(PH_L0 + 8)) {
        pg8::Gemm g{WSP(bf16, WS_XN8), WSP(bf16, WS_WGU0), 512, 0, nullptr}; pg8::StaticOrder S; S.init(M, 2 * FF, F.G, (int)blockIdx.x);
        pg8::EpiSwigluF8 E{WSP(unsigned char, WS_H0)}; pg8::gemm_phase<pg8::EpiSwigluF8, pg8::StaticOrder, true, true, false, true>(F.lds, g, S, E);
    }
    SEAM(PH_L0 + 8);
    if (SEL(10) && IN(PH_L0 + 9)) {
        pg8::Gemm g{WSP(bf16, WS_H0), WSP(bf16, WS_WD0), FF / 2, 0, nullptr}; pg8::StaticOrder S; S.init(M, 1024, F.G, (int)blockIdx.x);
        pg8::EpiBf16Plain E{WSP(bf16, WS_T2), DM, 1.f / (SC_H * SC_WD)}; pg8::gemm_phase<pg8::EpiBf16Plain, pg8::StaticOrder, true, true, false, true>(F.lds, g, S, E);
    }
    SEAM(PH_L0 + 9);
    LAYER_MIXER(1, PH_L1);
    if (SEL(8) && IN(PH_L1 + 7)) { FRESH();
        norm_phase<true, true>(F, X, INP(15) + 1024, WSP(float, WS_MOD) + (size_t)8 * 6144, 3, WSP(bf16, WS_XN8), INP(19), WSP(int, WS_TOKE), WSP(float, WS_TOKW), WSP(unsigned, WS_CNT), WSP(bf16, WS_T1), WSP(float, WS_MOD) + (size_t)8 * 6144 + 2 * 1024, X);
#pragma unroll 1
        for (int e = 0; e < NE; ++e) {
            conv_matrix_wg<SrcGU, true>(F, SrcGU{INP(20) + (size_t)e * 1024 * FF, INP(21) + (size_t)e * 1024 * FF, FF}, 1024, 1024, 2 * FF, WSP(unsigned char, WS_WGU8) + (size_t)e * 2 * FF * 1024, SC_WGU);
            conv_matrix_wg<SrcPlain, true>(F, SrcPlain{INP(22) + (size_t)e * FF * 1024, 1024}, FF, FF, 1024, WSP(unsigned char, WS_WD8) + (size_t)e * 1024 * FF, SC_WD);
        }
    }
    SEAM(PH_L1 + 7);
    if (SEL(11) && IN(PH_MOE)) { FRESH(); route_phase(F, WSP(unsigned, WS_CNT), WSP(int, WS_TOKE), WSP(int, WS_ROWTOK), WSP(int, WS_TOKSLOT), WSP(int, WS_TEXP)); }
    SEAM(PH_MOE);
    if (SEL(11) && IN(PH_MOE + 1)) { const int* texp = WSP(int, WS_TEXP); const int ntile = __builtin_amdgcn_readfirstlane(texp[0]);
        pg8::Gemm g{WSP(bf16, WS_XN8), WSP(bf16, WS_WGU8), 512, (size_t)2 * FF * 1024, WSP(int, WS_ROWTOK)};
        pg8::MoeOrder S; S.init(ntile * 256, 2 * FF, F.G, (int)blockIdx.x); S.load(texp);
        pg8::EpiSwigluF8 E{WSP(unsigned char, WS_H8)}; pg8::gemm_phase<pg8::EpiSwigluF8, pg8::MoeOrder, true, true, true, true>(F.lds, g, S, E); }
    SEAM(PH_MOE + 1);
    if (SEL(12) && IN(PH_MOE + 2)) { const int* texp = WSP(int, WS_TEXP); const int ntile = __builtin_amdgcn_readfirstlane(texp[0]);
        pg8::Gemm g{(const bf16*)WSP(unsigned char, WS_H8), WSP(bf16, WS_WD8), FF / 2, (size_t)1024 * FF, nullptr};
        pg8::MoeOrderD S; S.init_d(ntile, FF / 128, F.G, (int)blockIdx.x); S.load(texp);
        pg8::EpiMoeY E{WSP(bf16, WS_Y), WSP(bf16, WS_YP), S.mainM * 256, (size_t)(ntile - S.mainM) * 256 * DM, 1.f / (SC_H * SC_WD)};
        pg8::gemm_phase<pg8::EpiMoeY, pg8::MoeOrderD, true, true, false, true, true>(F.lds, g, S, E); }
    SEAM(PH_MOE + 2);
    if (SEL(13) && IN(PH_FINAL)) { FRESH(); final_phase(F, X, INP(23), WSP(bf16, WS_Y), WSP(bf16, WS_YP), WSP(int, WS_TEXP), WSP(int, WS_TOKSLOT), WSP(float, WS_TOKW), WSP(float, WS_MOD) + (size_t)8 * 6144 + 5 * 1024); }
#undef IN
#undef SEAM
}

extern "C" void kernel_launch(void* const* d_in, const int* in_sizes, int n_in, void* d_out, int out_size, void* d_ws, size_t ws_size, hipStream_t stream) {
    static int grid = 0;
    if (grid == 0) {
        if (n_in != 24 || out_size != M * DM || ws_size < WS_END) { fprintf(stderr, "kernel_launch: unexpected shapes (n_in %d out %d ws %zu)\n", n_in, out_size, ws_size); grid = -1; return; }
        int dev = 0, cus = 0, per_cu = 0;
        if (hipGetDevice(&dev) != hipSuccess || hipDeviceGetAttribute(&cus, hipDeviceAttributeMultiprocessorCount, dev) != hipSuccess) { grid = -1; return; }
        if (hipFuncSetAttribute((const void*)fwd_kernel, hipFuncAttributeMaxDynamicSharedMemorySize, LDS_BYTES) != hipSuccess) { fprintf(stderr, "kernel_launch: hipFuncSetAttribute failed\n"); grid = -1; return; }
        if (hipOccupancyMaxActiveBlocksPerMultiprocessor(&per_cu, (const void*)fwd_kernel, NWAVES * 64, LDS_BYTES) != hipSuccess || per_cu < 1)
            fprintf(stderr, "kernel_launch: occupancy query reports %d\n", per_cu);
        (void)hipGetLastError();
        grid = cus;
        if (grid != 256) fprintf(stderr, "kernel_launch: %d CUs (built for 256)\n", grid);
    }
    if (grid < 0) return;
    (void)hipMemsetAsync((char*)d_ws + WS_CTL, 0, CTL_ZERO_BYTES, stream);
    Args a{};
    for (int i = 0; i < 24; ++i) a.in[i] = (const float*)d_in[i];
    a.out = (float*)d_out; a.ws = (unsigned char*)d_ws;
#if MK_ONE_LAUNCH
    a.ph_lo = 0; a.ph_hi = N_PHASES;
    hipLaunchKernelGGL(fwd_kernel, dim3(grid), dim3(NWAVES * 64), LDS_BYTES, stream, a);
#else
    for (int p = 0; p < N_PHASES; ++p) { a.ph_lo = p; a.ph_hi = p + 1; hipLaunchKernelGGL(fwd_kernel, dim3(grid), dim3(NWAVES * 64), LDS_BYTES, stream, a); }
#endif
}
```

```cpp
#include <hip/hip_runtime.h>
#include <cstdio>
#include <cstdint>
#include <cmath>

#ifndef MK_ONE_LAUNCH
#define MK_ONE_LAUNCH 1
#endif

#define GAS __attribute__((address_space(1)))
#define LAS __attribute__((address_space(3)))
typedef unsigned short bf16;
typedef unsigned v4u __attribute__((ext_vector_type(4)));
typedef unsigned v2u __attribute__((ext_vector_type(2)));
typedef float f32x4 __attribute__((ext_vector_type(4)));
typedef float f32x2 __attribute__((ext_vector_type(2)));
typedef short bf16x8 __attribute__((ext_vector_type(8)));
typedef GAS unsigned gu32;
typedef int v8i __attribute__((ext_vector_type(8)));
typedef int v4i __attribute__((ext_vector_type(4)));
typedef v8i v8i_a16 __attribute__((aligned(16)));

constexpr int NB = 8, SEQ = 4096, DM = 1024, M = NB * SEQ, NH = 8, FF = 3584, NE = 8;
constexpr int INC = 2048;
constexpr int PA_P = 512, QM_P = 768, KM_P = 768, VM_P = 512, QF_P = 640, KF_P = 640, VF_P = 512, O_P = 1024;
constexpr float LOG2E = 1.4426950408889634f;
constexpr float C2M = 0.10206207261596575f * LOG2E;
constexpr float C2F = 0.125f * LOG2E;
constexpr float EPS = 1e-6f;

constexpr size_t MiB = 1u << 20;
constexpr size_t WS_CTL = 0, CTL_ZERO_BYTES = 1 * MiB;
constexpr size_t WS_MOD = 1 * MiB;
constexpr size_t WS_WIN = 4 * MiB, WS_WUQ = 12 * MiB, WS_WUKV = 13 * MiB, WS_WO = 14 * MiB, WS_WGU0 = 18 * MiB, WS_WD0 = 32 * MiB;
constexpr size_t WS_XN = 40 * MiB;
constexpr size_t WS_R = 104 * MiB;
constexpr size_t WS_PA = WS_R, WS_CQN = 168 * MiB, WS_CKVN = 184 * MiB, WS_QM = 200 * MiB, WS_KM = 248 * MiB, WS_VM = 296 * MiB,
                 WS_QF = 328 * MiB, WS_KF = 368 * MiB, WS_VF = 408 * MiB, WS_O = 440 * MiB, WS_ROPE = 504 * MiB;
constexpr size_t WS_SSQQ = WS_PA, WS_SSQKV = WS_PA + 1 * MiB, WS_FLOG = WS_PA + 2 * MiB, WS_SSQO = WS_PA + 4 * MiB;
constexpr size_t WS_H0 = WS_R;
constexpr size_t WS_WGU8 = WS_R, WS_WD8 = 160 * MiB, WS_H8 = 192 * MiB;
constexpr size_t WS_XN8 = WS_XN;
constexpr int MOE_MAXTILE = 136, MOE_MAXROW = MOE_MAXTILE * 256;
constexpr size_t H8_ROUND = (size_t)MOE_MAXROW * FF;
constexpr float SC_WGU = 32.f, SC_WD = 64.f, SC_H = 4.f;
constexpr size_t WS_T1 = 200 * MiB, WS_T2 = 328 * MiB;
constexpr size_t WS_YP = WS_R;
constexpr size_t WS_Y = 432 * MiB;
constexpr size_t WS_RT = 570 * MiB;
constexpr size_t WS_ROWTOK = WS_RT, WS_TOKSLOT = WS_RT + 512 * 1024, WS_TOKE = WS_RT + 1024 * 1024, WS_TOKW = WS_RT + 1280 * 1024, WS_CNT = WS_RT + 1536 * 1024, WS_TEXP = WS_RT + 1600 * 1024;
constexpr size_t WS_END = 572 * MiB;
constexpr int LCNT_OFF = 126976;
constexpr int CW_BAR = 4096;

constexpr int RING_BYTES = 131072;
constexpr int LDSCTL_OFF = RING_BYTES, MISC_OFF = LDSCTL_OFF + 320;
constexpr int LDS_BYTES = 147456;
constexpr int NWAVES = 8;

#define LDS_WAIT() asm volatile("s_waitcnt lgkmcnt(0)" ::: "memory")
#define VM_WAIT() asm volatile("s_waitcnt vmcnt(0)" ::: "memory")
__device__ __forceinline__ unsigned f2bf(float f) { unsigned u = __builtin_bit_cast(unsigned, f); return (u + 0x7fffu + ((u >> 16) & 1u)) >> 16; }
__device__ __forceinline__ unsigned pk2(float lo, float hi) { return f2bf(lo) | (f2bf(hi) << 16); }
__device__ __forceinline__ float bf2f(unsigned h) { return __builtin_bit_cast(float, h << 16); }
__device__ __forceinline__ float wave_sum(float v) {
#pragma unroll
    for (int o = 1; o < 64; o <<= 1) v += __shfl_xor(v, o);
    return v;
}

template <int NCH> __host__ __device__ __forceinline__ size_t kimg(int row, int h, int d) {
    const int b = row >> 12, t = row & 4095;
    return (((((size_t)(b * 64 + (t >> 6)) * NH + h) * NCH + (d >> 3)) << 9) + (size_t)(((t & 63) << 3) + (d & 7)));
}

namespace pg8 {
#define PG8_LAS __attribute__((address_space(3)))
typedef unsigned short bf16_t;
typedef unsigned u32x4 __attribute__((ext_vector_type(4)));
constexpr int BM = 256, BK = 64, HALF = 128, HTB = HALF * BK * 2, STAGE_BYTES = 8 * HTB, NXCD = 8, WGM = 8;

__host__ __device__ __forceinline__ int lds_byte(int r, int c) { const int st = (r >> 4) * 2 + (c >> 5), rr = r & 15, cc = c & 31, ob = rr * 64 + cc * 2; return st * 1024 + (ob ^ (((ob >> 9) & 1) << 5)); }
__host__ __device__ __forceinline__ void stage_rc(int b, int& R, int& C) { const int st = b / 1024, sb = b % 1024, swz = sb ^ (((sb >> 9) & 1) << 5); R = (st >> 1) * 16 + swz / 64; C = (st & 1) * 32 + (swz % 64) / 2; }
__host__ __device__ __forceinline__ int perm32(int rho) { const int n = rho >> 4, i = rho & 15; return 8 * (i >> 2) + 4 * n + (i & 3); }

struct Unit { int pm, pn, bsel, part, nt; };
struct Gemm { const bf16_t* A; const bf16_t* Bt; int K; size_t bstride; const int* rowidx; };

struct StaticOrder {
    int nM, nN, nwg, G, c;
    __host__ __device__ void init(int M_, int N_, int G_, int c_) { nM = M_ / BM; nN = N_ / BM; nwg = nM * nN; G = G_; c = c_; }
    __host__ __device__ bool next(int i, Unit& u) const {
        const long L = (long)i * G + c; if (L >= nwg) return false;
        int wgid = (int)L; { const int q = nwg / NXCD, r = nwg % NXCD, xcd = wgid % NXCD, off = wgid / NXCD; wgid = (xcd < r ? xcd * (q + 1) : r * (q + 1) + (xcd - r) * q) + off; }
        const int nig = WGM * nN, gid = wgid / nig, fm = gid * WGM, gsz = (nM - fm) < WGM ? (nM - fm) : WGM;
        u.pm = fm + ((wgid % nig) % gsz); u.pn = (wgid % nig) / gsz; u.bsel = 0; u.part = 0; u.nt = 0; return true;
    }
};

__device__ __forceinline__ unsigned cvt_pk_bf16(float lo, float hi) { unsigned r; asm volatile("v_cvt_pk_bf16_f32 %0, %1, %2" : "=v"(r) : "v"(lo), "v"(hi)); return r; }

template <class Epi, class Sched, bool ALIGN_EPI = false, bool SP2 = false, bool GATHER = false, bool F8 = false, bool SPLITK = false>
__device__ __forceinline__ void gemm_phase(PG8_LAS unsigned char* lds, const Gemm g, const Sched& S, const Epi& E) {
    int tid_ = threadIdx.x; asm volatile("" : "+v"(tid_));
    const int tid = tid_, wid = __builtin_amdgcn_readfirstlane(tid >> 6), lane = tid & 63, wr = wid >> 2, wc = wid & 3, fr = lane & 15, fq = lane >> 4;
    const int K = g.K, nt = K / BK;
    unsigned voffA[2], voffB[2];
#pragma unroll
    for (int i = 0; i < 2; ++i) { int R, C; stage_rc(tid * 16 + i * 8192, R, C); const int Rb = Epi::PERM ? ((R & ~31) + perm32(R & 31)) : R;
        voffA[i] = (unsigned)(R * K + C) * 2u; voffB[i] = (unsigned)(Rb * K + C) * 2u; }
    asm volatile("" : "+v"(voffA[0]), "+v"(voffA[1]), "+v"(voffB[0]), "+v"(voffB[1]));
    const size_t kstep = (size_t)(BK * 2);
    const size_t hstep = (size_t)HALF * K * 2;
    const size_t tstep = 2 * hstep;
    const unsigned ldsw = (unsigned)wid * 1024u;
    int aoff = lds_byte(wr * 64 + fr, fq * 8), boff = lds_byte(wc * 32 + fr, fq * 8);
    asm volatile("" : "+v"(aoff), "+v"(boff));
#define PG8_SA(b, h) (((b) * 2 + (h)) * HTB)
#define PG8_SB(b, h) ((4 + (b) * 2 + (h)) * HTB)
#define PG8_STAGE(bufoff, gbase, voff) do { _Pragma("unroll") for (int _i = 0; _i < 2; ++_i) \
        __builtin_amdgcn_global_load_lds((const unsigned*)((const char*)(gbase) + (voff)[_i]), (PG8_LAS unsigned*)(lds + (bufoff) + ldsw + _i * 8192), 16, 0, 0); } while (0)
    unsigned gofC[2][2] = {{0u, 0u}, {0u, 0u}}, gofN[2][2] = {{0u, 0u}, {0u, 0u}}; int gR[2] = {0, 0}; unsigned gC[2] = {0u, 0u};
    if constexpr (GATHER) {
#pragma unroll
        for (int i = 0; i < 2; ++i) { int R, C; stage_rc(tid * 16 + i * 8192, R, C); gR[i] = R; gC[i] = (unsigned)C * 2u; }
        asm volatile("" : "+v"(gR[0]), "+v"(gR[1]), "+v"(gC[0]), "+v"(gC[1]));
    }
#define PG8_GOF(dst, unit) do { _Pragma("unroll") for (int _h = 0; _h < 2; ++_h) _Pragma("unroll") for (int _i = 0; _i < 2; ++_i) { int _t = g.rowidx[(unit).pm * BM + _h * HALF + gR[_i]]; _t = _t < 0 ? 0 : _t; \
        dst[_h][_i] = (unsigned)_t * (unsigned)(K * 2) + gC[_i]; } } while (0)
#define PG8_GTOK(dst, unit) do { _Pragma("unroll") for (int _h = 0; _h < 2; ++_h) _Pragma("unroll") for (int _i = 0; _i < 2; ++_i) dst[_h][_i] = (unsigned)g.rowidx[(unit).pm * BM + _h * HALF + gR[_i]]; } while (0)
#define PG8_GCVT(dst) do { _Pragma("unroll") for (int _h = 0; _h < 2; ++_h) _Pragma("unroll") for (int _i = 0; _i < 2; ++_i) { int _t = (int)dst[_h][_i]; _t = _t < 0 ? 0 : _t; dst[_h][_i] = (unsigned)_t * (unsigned)(K * 2) + gC[_i]; } } while (0)
#define PG8_STAGE_A(bufoff, tptr, h, kb, nx) do { if constexpr (GATHER) { _Pragma("unroll") for (int _i = 0; _i < 2; ++_i) { const unsigned _o = (nx) ? gofN[h][_i] : gofC[h][_i]; \
        __builtin_amdgcn_global_load_lds((const unsigned*)((const char*)g.A + (kb) + _o), (PG8_LAS unsigned*)(lds + (bufoff) + ldsw + _i * 8192), 16, 0, 0); } } \
        else PG8_STAGE(bufoff, (tptr) + (h) * hstep, voffA); } while (0)
#define PG8_LD32(p) __builtin_shufflevector(*(const PG8_LAS v4i*)(p), *(const PG8_LAS v4i*)((p) + 1024), 0, 1, 2, 3, 4, 5, 6, 7)
#define PG8_LDA(dst, b, h) do { if constexpr (F8) { _Pragma("unroll") for (int m = 0; m < 4; ++m) dst##8[m] = PG8_LD32(lds + PG8_SA(b, h) + aoff + m * 2048); } \
        else { _Pragma("unroll") for (int m = 0; m < 4; ++m) _Pragma("unroll") for (int k = 0; k < 2; ++k) dst[m][k] = *(const PG8_LAS bf16x8*)(lds + PG8_SA(b, h) + aoff + m * 2048 + k * 1024); } } while (0)
#define PG8_LDB(dst, b, h) do { if constexpr (F8) { _Pragma("unroll") for (int n = 0; n < 2; ++n) dst##8[n] = PG8_LD32(lds + PG8_SB(b, h) + boff + n * 2048); } \
        else { _Pragma("unroll") for (int n = 0; n < 2; ++n) _Pragma("unroll") for (int k = 0; k < 2; ++k) dst[n][k] = *(const PG8_LAS bf16x8*)(lds + PG8_SB(b, h) + boff + n * 2048 + k * 1024); } } while (0)
#define PG8_MMA(ai, bj, At, Bt) do { __builtin_amdgcn_s_setprio(1); if constexpr (F8) { _Pragma("unroll") for (int m = 0; m < 4; ++m) _Pragma("unroll") for (int n = 0; n < 2; ++n) \
            asm volatile("v_mfma_scale_f32_16x16x128_f8f6f4 %0, %1, %2, %0, %3, %4 op_sel_hi:[0,0,0]" : "+v"(acc[ai][bj][m][n]) : "v"(Bt##8[n]), "v"(At##8[m]), "v"((bj) == 0 ? f8scl : f8scl1), "v"(f8one)); } \
        else { _Pragma("unroll") for (int m = 0; m < 4; ++m) _Pragma("unroll") for (int n = 0; n < 2; ++n) _Pragma("unroll") for (int k = 0; k < 2; ++k) \
            acc[ai][bj][m][n] = __builtin_amdgcn_mfma_f32_16x16x32_bf16(Bt[n][k], At[m][k], acc[ai][bj][m][n], 0, 0, 0); } __builtin_amdgcn_s_setprio(0); } while (0)
#define PG8_WAIT_V(n) asm volatile("s_waitcnt vmcnt(" #n ")" ::: "memory")
#define PG8_WAIT_L(n) asm volatile("s_waitcnt lgkmcnt(" #n ")" ::: "memory")
#define PG8_WAIT_V8P(post) do { if (post) asm volatile("s_waitcnt vmcnt(%0)" :: "n"(8 + Epi::NS) : "memory"); else asm volatile("s_waitcnt vmcnt(8)" ::: "memory"); } while (0)
#define PG8_BAR __builtin_amdgcn_s_barrier()
#define PG8_SCHED __builtin_amdgcn_sched_barrier(0)
    Unit cur, nxt; int ui = 0;
    if (!S.next(0, cur)) return;
    f32x4 acc[2][2][4][2];
#pragma unroll
    for (int a = 0; a < 2; ++a)
#pragma unroll
        for (int b = 0; b < 2; ++b)
#pragma unroll
            for (int m = 0; m < 4; ++m)
#pragma unroll
                for (int n = 0; n < 2; ++n) acc[a][b][m][n] = (f32x4){0.f, 0.f, 0.f, 0.f};
    bf16x8 At[4][2], B0[2][2], B1[2][2]; v8i At8[4], B08[2], B18[2];
    int f8scl = 0x7F7F7F7F, f8scl1 = 0x7F7F7F7F, f8one = 0x7F7F7F7F;
    if constexpr (F8) { f8scl = Epi::SCL0; f8scl1 = Epi::SCL1; }
    asm volatile("" : "+v"(f8scl), "+v"(f8scl1), "+v"(f8one));
    int ntc = nt; size_t kofc = 0;
    if constexpr (SPLITK) { ntc = cur.nt; kofc = (size_t)(cur.part * cur.nt) * kstep; }
    const char* cA = (const char*)g.A + (size_t)cur.pm * tstep + kofc; const char* cB = (const char*)g.Bt + (size_t)cur.bsel * g.bstride + (size_t)cur.pn * tstep + kofc;
    if constexpr (GATHER) { PG8_GOF(gofC, cur); }
    if constexpr (SP2) {
        PG8_STAGE(PG8_SB(0, 0), cB, voffB); PG8_STAGE(PG8_SB(0, 1), cB + hstep, voffB); PG8_STAGE_A(PG8_SA(0, 0), cA, 0, 0, false); PG8_STAGE_A(PG8_SA(0, 1), cA, 1, 0, false);
        if (wr == 1) PG8_BAR;
        PG8_WAIT_V(2); PG8_BAR;
        PG8_STAGE(PG8_SB(1, 0), cB + kstep, voffB); PG8_STAGE_A(PG8_SA(1, 0), cA + kstep, 0, kstep, false); PG8_STAGE(PG8_SB(1, 1), cB + hstep + kstep, voffB);
        PG8_WAIT_V(6); PG8_BAR;
    } else {
        PG8_STAGE(PG8_SB(0, 0), cB, voffB); PG8_STAGE(PG8_SA(0, 0), cA, voffA); PG8_STAGE(PG8_SB(0, 1), cB + hstep, voffB); PG8_STAGE(PG8_SA(0, 1), cA + hstep, voffA);
        if (wr == 1) PG8_BAR;
        PG8_WAIT_V(4); PG8_BAR;
        PG8_STAGE(PG8_SB(1, 0), cB + kstep, voffB); PG8_STAGE(PG8_SA(1, 0), cA + kstep, voffA); PG8_STAGE(PG8_SB(1, 1), cB + hstep + kstep, voffB);
        PG8_WAIT_V(6); PG8_BAR;
    }
    for (;;) {
        const bool has_next = S.next(ui + 1, nxt);
        if constexpr (GATHER) { if (has_next) { PG8_GTOK(gofN, nxt); } }
        size_t kofn = 0; if constexpr (SPLITK) { if (has_next) kofn = (size_t)(nxt.part * nxt.nt) * kstep; }
        const char* nA = has_next ? (const char*)g.A + (size_t)nxt.pm * tstep + kofn : cA; const char* nB = has_next ? (const char*)g.Bt + (size_t)nxt.bsel * g.bstride + (size_t)nxt.pn * tstep + kofn : cB;
#pragma unroll 1
        for (int t = 0; t < ntc; t += 2) {
            const bool last = (t == ntc - 2);
            const char* a1 = cA + (size_t)(t + 1) * kstep;
            const char* a2 = last ? nA : cA + (size_t)(t + 2) * kstep; const char* b2 = last ? nB : cB + (size_t)(t + 2) * kstep;
            const char* a3 = a2 + kstep; const char* b3 = b2 + kstep;
            if constexpr (GATHER) { if (last && has_next) { PG8_GCVT(gofN); } }
            if constexpr (Epi::MID) { if (t == nt / 2) E.mid(acc, cur, wr, wc, fr, fq); }
            const size_t k1 = (size_t)(t + 1) * kstep, k2 = last ? (size_t)0 : (size_t)(t + 2) * kstep, k3 = k2 + kstep; const bool nx = last && has_next;
            if constexpr (SP2) {
            const bool post = (t == 0) && (ui > 0);
            PG8_LDB(B0, 0, 0); PG8_LDB(B1, 0, 1); PG8_SCHED; PG8_LDA(At, 0, 0); PG8_STAGE_A(PG8_SA(1, 1), a1, 1, k1, false);
            PG8_WAIT_V8P(post); PG8_WAIT_L(0); PG8_BAR; PG8_MMA(0, 0, At, B0); PG8_MMA(0, 1, At, B1); PG8_BAR; PG8_SCHED;
            PG8_LDA(At, 0, 1); PG8_STAGE(PG8_SB(0, 0), b2, voffB); PG8_STAGE(PG8_SB(0, 1), b2 + hstep, voffB); PG8_STAGE_A(PG8_SA(0, 0), a2, 0, k2, nx);
            PG8_WAIT_V8P(post); PG8_WAIT_L(0); PG8_BAR; PG8_MMA(1, 0, At, B0); PG8_MMA(1, 1, At, B1); PG8_BAR; PG8_SCHED;
            PG8_LDB(B0, 1, 0); PG8_LDB(B1, 1, 1); PG8_SCHED; PG8_LDA(At, 1, 0); PG8_STAGE_A(PG8_SA(0, 1), a2, 1, k2, nx);
            PG8_WAIT_V(8); PG8_WAIT_L(0); PG8_BAR; PG8_MMA(0, 0, At, B0); PG8_MMA(0, 1, At, B1); PG8_BAR; PG8_SCHED;
            PG8_LDA(At, 1, 1); PG8_STAGE(PG8_SB(1, 0), b3, voffB); PG8_STAGE(PG8_SB(1, 1), b3 + hstep, voffB); PG8_STAGE_A(PG8_SA(1, 0), a3, 0, k3, nx);
            PG8_WAIT_V(8); PG8_WAIT_L(0); PG8_BAR; PG8_MMA(1, 0, At, B0); PG8_MMA(1, 1, At, B1); PG8_BAR; PG8_SCHED;
            } else {
            static_assert(!GATHER || SP2, "GATHER is wired into the SP2 loop only");
            PG8_LDB(B0, 0, 0); PG8_SCHED; PG8_LDA(At, 0, 0); PG8_STAGE(PG8_SA(1, 1), a1 + hstep, voffA);
            PG8_WAIT_L(8); PG8_BAR; PG8_WAIT_L(0); PG8_MMA(0, 0, At, B0); PG8_BAR; PG8_SCHED;
            PG8_LDB(B1, 0, 1); PG8_STAGE(PG8_SB(0, 0), b2, voffB);
            PG8_BAR; PG8_WAIT_L(0); PG8_MMA(0, 1, At, B1); PG8_BAR;
            PG8_LDA(At, 0, 1); PG8_STAGE(PG8_SA(0, 0), a2, voffA);
            PG8_BAR; PG8_WAIT_L(0); PG8_MMA(1, 0, At, B0); PG8_BAR; PG8_SCHED;
            PG8_STAGE(PG8_SB(0, 1), b2 + hstep, voffB);
            PG8_WAIT_V(6); PG8_BAR; PG8_MMA(1, 1, At, B1); PG8_BAR;
            PG8_LDB(B0, 1, 0); PG8_SCHED; PG8_LDA(At, 1, 0); PG8_STAGE(PG8_SA(0, 1), a2 + hstep, voffA);
            PG8_WAIT_L(8); PG8_BAR; PG8_WAIT_L(0); PG8_MMA(0, 0, At, B0); PG8_BAR; PG8_SCHED;
            PG8_LDB(B1, 1, 1); PG8_STAGE(PG8_SB(1, 0), b3, voffB);
            PG8_BAR; PG8_WAIT_L(0); PG8_MMA(0, 1, At, B1); PG8_BAR;
            PG8_LDA(At, 1, 1); PG8_STAGE(PG8_SA(1, 0), a3, voffA);
            PG8_BAR; PG8_WAIT_L(0); PG8_MMA(1, 0, At, B0); PG8_BAR; PG8_SCHED;
            PG8_STAGE(PG8_SB(1, 1), b3 + hstep, voffB);
            PG8_WAIT_V(6); PG8_BAR; PG8_MMA(1, 1, At, B1); PG8_BAR;
            }
        }
        if constexpr (ALIGN_EPI) { if (wr == 0) PG8_BAR; }
        if constexpr (F8) asm volatile("s_nop 15\n\ts_nop 15" ::: "memory");
        E(acc, cur, wr, wc, fr, fq);
        if (!has_next) break;
#pragma unroll
        for (int a = 0; a < 2; ++a)
#pragma unroll
            for (int b = 0; b < 2; ++b)
#pragma unroll
                for (int m = 0; m < 4; ++m)
#pragma unroll
                    for (int n = 0; n < 2; ++n) acc[a][b][m][n] = (f32x4){0.f, 0.f, 0.f, 0.f};
        cur = nxt; cA = nA; cB = nB; ++ui; if constexpr (SPLITK) ntc = cur.nt;
        if constexpr (GATHER) { _Pragma("unroll") for (int _h = 0; _h < 2; ++_h) _Pragma("unroll") for (int _i = 0; _i < 2; ++_i) gofC[_h][_i] = gofN[_h][_i]; }
        if constexpr (ALIGN_EPI) { if (wr == 1) PG8_BAR; }
    }
    PG8_WAIT_V(0);
    if constexpr (!ALIGN_EPI) { if (wr == 0) PG8_BAR; }
    PG8_BAR;
#undef PG8_SA
#undef PG8_SB
#undef PG8_STAGE
#undef PG8_STAGE_A
#undef PG8_GOF
#undef PG8_GTOK
#undef PG8_GCVT
#undef PG8_LDA
#undef PG8_LD32
#undef PG8_LDB
#undef PG8_MMA
#undef PG8_WAIT_V
#undef PG8_WAIT_L
#undef PG8_WAIT_V8P
#undef PG8_BAR
#undef PG8_SCHED
}

#define EPI_ROWS(...) _Pragma("unroll") for (int ai = 0; ai < 2; ++ai) _Pragma("unroll") for (int m = 0; m < 4; ++m) { const int row = row0 + ai * HALF + m * 16; \
        _Pragma("unroll") for (int bj = 0; bj < 2; ++bj) { const int c = bj * HALF + wc * 32 + 8 * fq; f32x4 v0 = acc[ai][bj][m][0], v1 = acc[ai][bj][m][1]; __VA_ARGS__ } }
__device__ __forceinline__ u32x4 pack8(f32x4 v0, f32x4 v1) { u32x4 w; w.x = cvt_pk_bf16(v0[0], v0[1]); w.y = cvt_pk_bf16(v0[2], v0[3]); w.z = cvt_pk_bf16(v1[0], v1[1]); w.w = cvt_pk_bf16(v1[2], v1[3]); return w; }

__device__ __forceinline__ float ssq8(f32x4 a, f32x4 b) { return (a[0] * a[0] + a[1] * a[1]) + (a[2] * a[2] + a[3] * a[3]) + (b[0] * b[0] + b[1] * b[1]) + (b[2] * b[2] + b[3] * b[3]); }
struct EpiInproj { static constexpr bool PERM = true; static constexpr bool MID = false; static constexpr int NS = 16;
    bf16_t *CQ, *CKV, *KM; float *SSQQ, *SSQKV, *FLOG; const float* ROPE; bf16_t *QF, *KF, *VF;
    __device__ __forceinline__ void operator()(const f32x4 (&acc)[2][2][4][2], const Unit& u, int wr, int wc, int fr, int fq_) const {
        int row0 = u.pm * BM + wr * 64 + fr, fq = fq_; asm volatile("" : "+v"(row0), "+v"(fq));
        if (u.pn == 0) {
#pragma unroll
            for (int ai = 0; ai < 2; ++ai)
#pragma unroll
                for (int m = 0; m < 4; ++m) { const int row = row0 + ai * HALF + m * 16; float ss = 0.f;
#pragma unroll
                    for (int bj = 0; bj < 2; ++bj) { const int c = bj * HALF + wc * 32 + 8 * fq; const f32x4 v0 = acc[ai][bj][m][0], v1 = acc[ai][bj][m][1];
                        *(u32x4*)(CQ + (size_t)row * 256 + c) = pack8(v0, v1); ss += ssq8(v0, v1); }
                    ss += __shfl_xor(ss, 16); ss += __shfl_xor(ss, 32);
                    if (fq == 0) SSQQ[(size_t)row * 4 + wc] = ss; }
        } else if (u.pn == 1) {
#pragma unroll
            for (int ai = 0; ai < 2; ++ai)
#pragma unroll
                for (int m = 0; m < 4; ++m) { const int row = row0 + ai * HALF + m * 16; const int c = wc * 32 + 8 * fq;
                    { const f32x4 v0 = acc[ai][0][m][0], v1 = acc[ai][0][m][1]; *(u32x4*)(CKV + (size_t)row * 128 + c) = pack8(v0, v1);
                      float ss = ssq8(v0, v1); ss += __shfl_xor(ss, 16); ss += __shfl_xor(ss, 32); if (fq == 0) SSQKV[(size_t)row * 4 + wc] = ss; }
                    const f32x4 v0 = acc[ai][1][m][0], v1 = acc[ai][1][m][1];
                    if (wc == 0) { const f32x4* rp = (const f32x4*)(ROPE + (size_t)row * 32 + 8 * fq); const f32x4 r0 = rp[0], r1 = rp[1]; f32x4 o0, o1;
                        o0[0] = v0[0] * r0[0] - v0[1] * r0[1]; o0[1] = v0[0] * r0[1] + v0[1] * r0[0]; o0[2] = v0[2] * r0[2] - v0[3] * r0[3]; o0[3] = v0[2] * r0[3] + v0[3] * r0[2];
                        o1[0] = v1[0] * r1[0] - v1[1] * r1[1]; o1[1] = v1[0] * r1[1] + v1[1] * r1[0]; o1[2] = v1[2] * r1[2] - v1[3] * r1[3]; o1[3] = v1[2] * r1[3] + v1[3] * r1[2];
                        const u32x4 w = pack8(o0, o1);
#pragma unroll
                        for (int h = 0; h < 8; ++h) *(u32x4*)(KM + kimg<12>(row, h, 64 + 8 * fq)) = w; }
                    else if (wc == 1 && fq == 0) { float* p = FLOG + (size_t)row * 8; *(f32x4*)p = v0; *(f32x4*)(p + 4) = v1; } }
        } else {
            const int grp = (u.pn >> 1) - 1, cb = (u.pn & 1) * 256;
            if (grp == 0)      { EPI_ROWS( const int cc = cb + c; v0 = v0 * C2F; v1 = v1 * C2F; *(u32x4*)(QF + (size_t)row * QF_P + (cc >> 6) * 80 + (cc & 63)) = pack8(v0, v1); ) }
            else if (grp == 1) { EPI_ROWS( const int cc = cb + c; *(u32x4*)(KF + kimg<10>(row, cc >> 6, cc & 63)) = pack8(v0, v1); ) }
            else               { EPI_ROWS( const int cc = cb + c; *(u32x4*)(VF + (size_t)row * VF_P + cc) = pack8(v0, v1); ) }
        }
    }
};
struct EpiQ { static constexpr bool PERM = true; static constexpr bool MID = false; static constexpr int NS = 16;
    bf16_t* QM; const float* ROPE; const float* SSQ;
    __device__ __forceinline__ float rs(int row) const { const f32x4 p = *(const f32x4*)(SSQ + (size_t)row * 4); return C2M / sqrtf(((p[0] + p[1]) + (p[2] + p[3])) * (1.f / 256.f) + EPS); }
    __device__ __forceinline__ void operator()(const f32x4 (&acc)[2][2][4][2], const Unit& u, int wr, int wc, int fr, int fq) const {
        const int row0 = u.pm * BM + wr * 64 + fr;
        if (u.pn < 2) {
            EPI_ROWS( const int cc = u.pn * 256 + c; const float C2M = rs(row); v0 = v0 * C2M; v1 = v1 * C2M; *(u32x4*)(QM + (size_t)row * QM_P + (cc >> 6) * 96 + (cc & 63)) = pack8(v0, v1); )
        } else {
            EPI_ROWS( const int h = c >> 5, p0 = c & 31; const float C2M = rs(row); const f32x4* rp = (const f32x4*)(ROPE + (size_t)row * 32 + p0);
                const f32x4 r0 = rp[0], r1 = rp[1]; f32x4 o0, o1;
                o0[0] = v0[0] * r0[0] - v0[1] * r0[1]; o0[1] = v0[0] * r0[1] + v0[1] * r0[0]; o0[2] = v0[2] * r0[2] - v0[3] * r0[3]; o0[3] = v0[2] * r0[3] + v0[3] * r0[2];
                o1[0] = v1[0] * r1[0] - v1[1] * r1[1]; o1[1] = v1[0] * r1[1] + v1[1] * r1[0]; o1[2] = v1[2] * r1[2] - v1[3] * r1[3]; o1[3] = v1[2] * r1[3] + v1[3] * r1[2];
                o0 = o0 * C2M; o1 = o1 * C2M; *(u32x4*)(QM + (size_t)row * QM_P + h * 96 + 64 + p0) = pack8(o0, o1); )
        }
    }
};
struct EpiKV { static constexpr bool PERM = true; static constexpr bool MID = false; static constexpr int NS = 16;
    bf16_t *KM, *VM; const float* SSQ;
    __device__ __forceinline__ float rs(int row) const { const f32x4 p = *(const f32x4*)(SSQ + (size_t)row * 4); return 1.f / sqrtf(((p[0] + p[1]) + (p[2] + p[3])) * (1.f / 128.f) + EPS); }
    __device__ __forceinline__ void operator()(const f32x4 (&acc)[2][2][4][2], const Unit& u, int wr, int wc, int fr, int fq_) const {
        int row0 = u.pm * BM + wr * 64 + fr, fq = fq_; asm volatile("" : "+v"(row0), "+v"(fq));
        if (u.pn < 2) { EPI_ROWS( const int cc = u.pn * 256 + c; const float r = rs(row); v0 = v0 * r; v1 = v1 * r; *(u32x4*)(KM + kimg<12>(row, cc >> 6, cc & 63)) = pack8(v0, v1); ) }
        else          { EPI_ROWS( const int cc = (u.pn - 2) * 256 + c; const float r = rs(row); v0 = v0 * r; v1 = v1 * r; *(u32x4*)(VM + (size_t)row * VM_P + cc) = pack8(v0, v1); ) }
    }
};
struct EpiResid { static constexpr bool PERM = true; static constexpr bool MID = false; static constexpr int NS = 0;
    const float* Xin; float* Xout; const float* gate  ; const float* rowscale; int rs_stride;
    __device__ __forceinline__ void operator()(const f32x4 (&acc)[2][2][4][2], const Unit& u, int wr, int wc, int fr, int fq) const {
        const int row0 = u.pm * BM + wr * 64 + fr; const int b = (u.pm * BM) >> 12;
        const float* gp = gate + (size_t)b * 6144 + u.pn * 256;
        EPI_ROWS( const f32x4 g0 = *(const f32x4*)(gp + c), g1 = *(const f32x4*)(gp + c + 4); const size_t off = (size_t)row * DM + u.pn * 256 + c;
            float rs = 1.f; if (rowscale) rs = rowscale[(size_t)row * rs_stride];
            const f32x4 x0 = *(const f32x4*)(Xin + off), x1 = *(const f32x4*)(Xin + off + 4);
            *(f32x4*)(Xout + off) = x0 + g0 * (v0 * rs); *(f32x4*)(Xout + off + 4) = x1 + g1 * (v1 * rs); )
    }
};
struct EpiSwiglu { static constexpr bool PERM = true; static constexpr bool MID = false; static constexpr int NS = 8;
    bf16_t* H;
    __device__ __forceinline__ void operator()(const f32x4 (&acc)[2][2][4][2], const Unit& u, int wr, int wc, int fr, int fq) const {
        const int row0 = u.pm * BM + wr * 64 + fr;
#pragma unroll
        for (int ai = 0; ai < 2; ++ai)
#pragma unroll
            for (int m = 0; m < 4; ++m) { const int row = row0 + ai * HALF + m * 16; f32x4 h[2];
#pragma unroll
                for (int n = 0; n < 2; ++n) { const f32x4 gv = acc[ai][0][m][n], uv = acc[ai][1][m][n];
#pragma unroll
                    for (int j = 0; j < 4; ++j) { const float e = __builtin_amdgcn_exp2f(-gv[j] * LOG2E); h[n][j] = gv[j] * __builtin_amdgcn_rcpf(1.f + e) * uv[j]; } }
                *(u32x4*)(H + (size_t)row * FF + u.pn * 128 + wc * 32 + 8 * fq) = pack8(h[0], h[1]); }
    }
};
struct EpiBf16Plain { static constexpr bool PERM = true; static constexpr bool MID = false; static constexpr int NS = 16; static constexpr int SCL0 = 0x7F7F7F7F, SCL1 = 0x7F7F7F7F;
    bf16_t* O; int ldc; float scale;
    __device__ __forceinline__ void operator()(const f32x4 (&acc)[2][2][4][2], const Unit& u, int wr, int wc, int fr, int fq) const {
        const int row0 = u.pm * BM + wr * 64 + fr;
        EPI_ROWS( v0 = v0 * scale; v1 = v1 * scale; *(u32x4*)(O + (size_t)row * ldc + u.pn * 256 + c) = pack8(v0, v1); )
    }
};
struct EpiWo { static constexpr bool PERM = true; static constexpr bool MID = true; static constexpr int NS = 16;
    bf16_t* O; const float* SSQ;
    __device__ __forceinline__ void sums(int row, float& s1, float& s2) const { const f32x4* p = (const f32x4*)(SSQ + (size_t)row * 16); const f32x4 a = p[0], b = p[1], c = p[2], d = p[3];
        s1 = ((a[0] + a[1]) + (a[2] + a[3])) + ((b[0] + b[1]) + (b[2] + b[3])); s2 = ((c[0] + c[1]) + (c[2] + c[3])) + ((d[0] + d[1]) + (d[2] + d[3])); }
    __device__ __forceinline__ void mid(f32x4 (&acc)[2][2][4][2], const Unit& u, int wr, int wc, int fr, int fq) const {
        int row0 = u.pm * BM + wr * 64 + fr; asm volatile("" : "+v"(row0));
#pragma unroll
        for (int ai = 0; ai < 2; ++ai)
#pragma unroll
            for (int m = 0; m < 4; ++m) { float s1, s2; sums(row0 + ai * HALF + m * 16, s1, s2); const float ratio = sqrtf((s2 * (1.f / 512.f) + EPS) / (s1 * (1.f / 512.f) + EPS));
#pragma unroll
                for (int bj = 0; bj < 2; ++bj)
#pragma unroll
                    for (int n = 0; n < 2; ++n) acc[ai][bj][m][n] = acc[ai][bj][m][n] * ratio;
                asm volatile("" : "+v"(acc[ai][0][m][0]), "+v"(acc[ai][0][m][1]), "+v"(acc[ai][1][m][0]), "+v"(acc[ai][1][m][1]) :: "memory"); }
    }
    __device__ __forceinline__ void operator()(const f32x4 (&acc)[2][2][4][2], const Unit& u, int wr, int wc, int fr, int fq) const {
        int row0 = u.pm * BM + wr * 64 + fr; asm volatile("" : "+v"(row0));
#pragma unroll
        for (int ai = 0; ai < 2; ++ai)
#pragma unroll
            for (int m = 0; m < 4; ++m) { const int row = row0 + ai * HALF + m * 16; float s1, s2; sums(row, s1, s2); const float r2 = 1.f / sqrtf(s2 * (1.f / 512.f) + EPS);
#pragma unroll
                for (int bj = 0; bj < 2; ++bj) { const int c = bj * HALF + wc * 32 + 8 * fq; *(u32x4*)(O + (size_t)row * DM + u.pn * 256 + c) = pack8(acc[ai][bj][m][0] * r2, acc[ai][bj][m][1] * r2); } }
    }
};
struct EpiSwigluF8 { static constexpr bool PERM = true; static constexpr bool MID = false; static constexpr int NS = 8; static constexpr int SCL0 = 0x7A7A7A7A, SCL1 = 0x7C7C7C7C;
    unsigned char* H;
    __device__ __forceinline__ void operator()(const f32x4 (&acc)[2][2][4][2], const Unit& u, int wr, int wc, int fr, int fq) const {
        const int row0 = u.pm * BM + wr * 64 + fr;
#pragma unroll
        for (int ai = 0; ai < 2; ++ai)
#pragma unroll
            for (int m = 0; m < 4; ++m) { const int row = row0 + ai * HALF + m * 16; float h[8];
#pragma unroll
                for (int n = 0; n < 2; ++n) { const f32x4 ga = acc[ai][0][m][n], ua = acc[ai][1][m][n];
#pragma unroll
                    for (int j = 0; j < 4; ++j) { const float e = __builtin_amdgcn_exp2f(ga[j]); const float hv = (ga[j] * ua[j]) * __builtin_amdgcn_rcpf(1.f + e);
                        h[4 * n + j] = __builtin_amdgcn_fmed3f(hv, -448.f, 448.f); } }
                int w0 = 0, w1 = 0;
                w0 = __builtin_amdgcn_cvt_pk_fp8_f32(h[0], h[1], w0, false); w0 = __builtin_amdgcn_cvt_pk_fp8_f32(h[2], h[3], w0, true);
                w1 = __builtin_amdgcn_cvt_pk_fp8_f32(h[4], h[5], w1, false); w1 = __builtin_amdgcn_cvt_pk_fp8_f32(h[6], h[7], w1, true);
                *(v2u*)(H + (size_t)row * FF + u.pn * 128 + wc * 32 + 8 * fq) = (v2u){(unsigned)w0, (unsigned)w1}; }
    }
};
struct MoeOrder : StaticOrder {
    int tend[8];
    __device__ __forceinline__ void load(const int* texp) {
#pragma unroll
        for (int e = 0; e < 8; ++e) tend[e] = __builtin_amdgcn_readfirstlane(texp[1 + e]); }
    __device__ __forceinline__ bool next(int i, Unit& u) const { if (!StaticOrder::next(i, u)) return false; int b = 0;
#pragma unroll
        for (int e = 0; e < 7; ++e) b += (u.pm >= tend[e]) ? 1 : 0;
        u.bsel = b; return true; }
};
struct EpiMoeDown { static constexpr bool PERM = true; static constexpr bool MID = false; static constexpr int NS = 0;
    float* X; const float* gate; const int* rowtok; const float* roww; float oscale;
    __device__ __forceinline__ void operator()(const f32x4 (&acc)[2][2][4][2], const Unit& u, int wr, int wc, int fr, int fq) const {
        const int row0 = u.pm * BM + wr * 64 + fr;
#pragma unroll
        for (int ai = 0; ai < 2; ++ai)
#pragma unroll
            for (int m = 0; m < 4; ++m) { const int slot = row0 + ai * HALF + m * 16; const int tok = rowtok[slot];
                if (tok >= 0) { const float w = roww[slot] * oscale; const float* gp = gate + (size_t)(tok >> 12) * 6144 + u.pn * 256; float* xp = X + (size_t)tok * DM + u.pn * 256;
#pragma unroll
                    for (int bj = 0; bj < 2; ++bj) { const int c = bj * HALF + wc * 32 + 8 * fq; const f32x4 v0 = acc[ai][bj][m][0], v1 = acc[ai][bj][m][1];
                        const f32x4 g0 = *(const f32x4*)(gp + c), g1 = *(const f32x4*)(gp + c + 4); const f32x4 x0 = *(const f32x4*)(xp + c), x1 = *(const f32x4*)(xp + c + 4);
                        *(f32x4*)(xp + c) = x0 + g0 * (v0 * w); *(f32x4*)(xp + c + 4) = x1 + g1 * (v1 * w); } } }
    }
};
struct MoeOrderD : MoeOrder {
    int mainU, mainM, tailSub, S, NT;
    __device__ __forceinline__ void init_d(int ntile, int NT_, int G_, int c_) {
        NT = NT_; const int per = G_ / 4; int tailM = (G_ % 4 == 0) ? ntile % per : 0; const int U = 4 * tailM;
        S = (7 * U <= G_ && NT_ % 14 == 0) ? 7 : ((2 * U <= G_ && NT_ % 4 == 0) ? 2 : 1); if (S == 1) tailM = 0;
        mainM = ntile - tailM; mainU = 4 * mainM; tailSub = 4 * tailM * S;
        StaticOrder::init(mainM * BM, 4 * BM, G_, c_); }
    __device__ __forceinline__ bool next(int i, Unit& u) const {
        const long L = (long)i * G + c;
        if (L < mainU) { StaticOrder::next(i, u); u.nt = NT; }
        else { const int j = (int)(L - mainU); if (j >= tailSub) return false;
            const int uu = j / S; u.part = j - uu * S; u.pm = mainM + (uu >> 2); u.pn = uu & 3; u.nt = NT / S; }
        int b = 0;
#pragma unroll
        for (int e = 0; e < 7; ++e) b += (u.pm >= tend[e]) ? 1 : 0;
        u.bsel = b; return true; }
};
struct EpiMoeY { static constexpr bool PERM = true; static constexpr bool MID = false; static constexpr int NS = 16; static constexpr int SCL0 = 0x7F7F7F7F, SCL1 = 0x7F7F7F7F;
    bf16_t* Y; bf16_t* Yp; int tail0; size_t pstride; float scale;
    __device__ __forceinline__ void operator()(const f32x4 (&acc)[2][2][4][2], const Unit& u, int wr, int wc, int fr, int fq) const {
        const int row0 = u.pm * BM + wr * 64 + fr;
        bf16_t* O = (u.part == 0) ? Y : Yp + (size_t)(u.part - 1) * pstride - (size_t)tail0 * DM;
        EPI_ROWS( v0 = v0 * scale; v1 = v1 * scale; *(u32x4*)(O + (size_t)row * DM + u.pn * 256 + c) = pack8(v0, v1); )
    }
};
}

#define XB_TMO      128
#define XB_XCNT(j)  (256  + 64 * (j))
#define XB_XSUB(j)  (1280 + 64 * (j))
#define XB_XGEN(j)  (2304 + 64 * (j))
#define XB_TOP      3328
#define XB_TOPGEN   3392
#define XCD_BAR_WORDS 3456
#define XB_SPIN_CAP (1u << 22)

__device__ __forceinline__ unsigned xb_ld(unsigned* p)              { return __hip_atomic_load(p, __ATOMIC_RELAXED, __HIP_MEMORY_SCOPE_AGENT); }
__device__ __forceinline__ unsigned xb_add(unsigned* p, unsigned v) { return __hip_atomic_fetch_add(p, v, __ATOMIC_RELAXED, __HIP_MEMORY_SCOPE_AGENT); }
__device__ __forceinline__ unsigned xb_xcc_id() { return (unsigned)__builtin_amdgcn_s_getreg((3 << 11) | 20) & 0xFu; }
#define XB_SPIN(cond, bar) do { unsigned _sp = 0; while (cond) { __builtin_amdgcn_s_sleep(1); \
    if ((++_sp & 255u) == 0u) { if (xb_ld(&(bar)[XB_TMO])) break; if (_sp > XB_SPIN_CAP) { atomicAdd(&(bar)[XB_TMO], 1u); break; } } } } while (0)

struct XcdBarrier { unsigned* bar; unsigned x; volatile LAS unsigned* st; };

__device__ __forceinline__ XcdBarrier xcd_barrier_post(unsigned* bar, volatile LAS unsigned* st) {
    XcdBarrier b; b.bar = bar; b.x = xb_xcc_id(); b.st = st;
    if (threadIdx.x == 0) (void)xb_add(&bar[XB_XCNT(b.x)], 1u);
    return b;
}
__device__ __forceinline__ void xcd_barrier_complete(unsigned* bar, unsigned x, unsigned& nloc, unsigned& nx) {
    const unsigned G = gridDim.x * gridDim.y * gridDim.z;
    unsigned sum, cnt, mine, sp = 0u;
    for (;;) {
        sum = 0u; cnt = 0u; mine = 0u;
#pragma unroll
        for (unsigned j = 0; j < 16; ++j) { const unsigned c = xb_ld(&bar[XB_XCNT(j)]); sum += c; cnt += (c > 0u) ? 1u : 0u; mine = (j == x) ? c : mine; }
        if (sum == G) break;
        __builtin_amdgcn_s_sleep(1);
        if ((++sp & 255u) == 0u) { if (xb_ld(&bar[XB_TMO])) break; if (sp > XB_SPIN_CAP) { atomicAdd(&bar[XB_TMO], 1u); break; } }
    }
    nloc = mine > 0u ? mine : 1u; nx = cnt > 0u ? cnt : 1u;
}
__device__ __forceinline__ void xcd_barrier(const XcdBarrier& b) {
    asm volatile("s_waitcnt vmcnt(0)" ::: "memory");
    __syncthreads();
    if (threadIdx.x == 0) {
        unsigned* bar = b.bar;
        __builtin_amdgcn_s_waitcnt(0);
        unsigned nloc = b.st[0], nx = b.st[1];
        if (nloc == 0u) { xcd_barrier_complete(bar, b.x, nloc, nx); b.st[0] = nloc; b.st[1] = nx; }
        const unsigned old = xb_add(&bar[XB_XSUB(b.x)], 1u);
        const unsigned gen = old / nloc;
        if (old + 1u == (gen + 1u) * nloc) {
            __builtin_amdgcn_fence(__ATOMIC_RELEASE, "agent");
            asm volatile("s_waitcnt vmcnt(0)" ::: "memory");
            const unsigned og = xb_add(&bar[XB_TOP], 1u);
            const unsigned tg = og / nx;
            if (og + 1u == (tg + 1u) * nx) xb_add(&bar[XB_TOPGEN], 1u);
            else XB_SPIN(xb_ld(&bar[XB_TOPGEN]) == tg, bar);
            __builtin_amdgcn_fence(__ATOMIC_ACQUIRE, "agent");
            xb_add(&bar[XB_XGEN(b.x)], 1u);
            asm volatile("s_waitcnt vmcnt(0)" ::: "memory");
        } else {
            XB_SPIN(xb_ld(&bar[XB_XGEN(b.x)]) == gen, bar);
            __builtin_amdgcn_fence(__ATOMIC_ACQUIRE, "agent");
            asm volatile("s_waitcnt vmcnt(0)" ::: "memory");
        }
    }
    __syncthreads();
}

struct Args {
    const float* in[24]; float* out; unsigned char* ws; int ph_lo, ph_hi;
};
struct Frame {
    LAS unsigned char* lds;
    int tid, lane, wave, vcu, G;
    unsigned char* ws;
};

template <class Src>
__device__ __forceinline__ void conv_item(const Src& src, int Ksrc, int Kpad, bf16* WT, LAS float* scr, int item, int lane, int nblk) {
    const int kb = item / nblk, nb = item % nblk, k0 = 64 * kb, n0 = 32 * nb;
    const float* colp = src(n0 + (lane & 31)); const int ld = src.ld;
#pragma unroll 8
    for (int i = 0; i < 32; ++i) { const int kk = 2 * i + (lane >> 5), k = k0 + kk; float v = 0.f; if (colp != nullptr && k < Ksrc) v = colp[(size_t)k * ld] * src.ksc(k); scr[kk * 33 + (lane & 31)] = v; }
    LDS_WAIT(); asm volatile("" ::: "memory");
    const int c = lane & 7;
#pragma unroll
    for (int j = 0; j < 4; ++j) { const int n = (lane >> 3) + 8 * j; const LAS float* s = scr + (8 * c) * 33 + n;
        v4u o; o.x = pk2(s[0 * 33], s[1 * 33]); o.y = pk2(s[2 * 33], s[3 * 33]); o.z = pk2(s[4 * 33], s[5 * 33]); o.w = pk2(s[6 * 33], s[7 * 33]);
        *(GAS v4u*)(WT + (size_t)(n0 + n) * Kpad + k0 + 8 * c) = o; }
    LDS_WAIT(); asm volatile("" ::: "memory");
}
template <class Src>
__device__ __forceinline__ void conv_matrix(Frame& F, const Src& src, int Ksrc, int Kpad, int Nout, bf16* WT, int rot = 0) {
    LAS float* scr = (LAS float*)(F.lds + F.wave * 16384);
    const int gw = F.vcu * NWAVES + F.wave, NGW = F.G * NWAVES, nblk = Nout / 32, nitems = (Kpad / 64) * nblk;
    for (int it = (gw + NGW - rot % NGW) % NGW; it < nitems; it += NGW) conv_item(src, Ksrc, Kpad, WT, scr, it, F.lane, nblk);
}
template <class Src>
__device__ __forceinline__ void conv_item64(const Src& src, int Ksrc, int Kpad, bf16* WT, LAS unsigned short* scr, int item, int lane, int nblk) {
    const int kb = item / nblk, nb = item % nblk, k0 = 64 * kb, n0 = 64 * nb;
    const int nn = (lane & 15) * 4, kq = lane >> 4;
    const float* colp = src(n0 + nn); const int ld = src.ld;
    f32x4 v[16];
#pragma unroll
    for (int i = 0; i < 16; ++i) { const int k = k0 + 4 * i + kq; v[i] = (k < Ksrc) ? *(const f32x4*)(colp + (size_t)k * ld) : (f32x4){0.f, 0.f, 0.f, 0.f}; }
#pragma unroll
    for (int i = 0; i < 16; ++i) { LAS unsigned* d = (LAS unsigned*)(scr + (4 * i + kq) * 66 + nn); d[0] = pk2(v[i].x, v[i].y); d[1] = pk2(v[i].z, v[i].w); }
    LDS_WAIT(); asm volatile("" ::: "memory");
    const int c = lane & 7;
#pragma unroll
    for (int j = 0; j < 8; ++j) { const int n = (lane >> 3) + 8 * j; const LAS unsigned short* sp = scr + (8 * c) * 66 + n;
        v4u o; o.x = (unsigned)sp[0 * 66] | ((unsigned)sp[1 * 66] << 16); o.y = (unsigned)sp[2 * 66] | ((unsigned)sp[3 * 66] << 16);
        o.z = (unsigned)sp[4 * 66] | ((unsigned)sp[5 * 66] << 16); o.w = (unsigned)sp[6 * 66] | ((unsigned)sp[7 * 66] << 16);
        *(GAS v4u*)(WT + (size_t)(n0 + n) * Kpad + k0 + 8 * c) = o; }
    LDS_WAIT(); asm volatile("" ::: "memory");
}
template <class Src>
__device__ __forceinline__ void conv_matrix64(Frame& F, const Src& src, int Ksrc, int Kpad, int Nout, bf16* WT) {
    LAS unsigned short* scr = (LAS unsigned short*)(F.lds + F.wave * 16384);
    const int gw = F.vcu * NWAVES + F.wave, NGW = F.G * NWAVES, nblk = Nout / 64, nitems = (Kpad / 64) * nblk;
    for (int it = gw; it < nitems; it += NGW) conv_item64(src, Ksrc, Kpad, WT, scr, it, F.lane, nblk);
}
template <class Src>
__device__ __forceinline__ void conv_item_f8(const Src& src, int Ksrc, int Kpad, unsigned char* WT, LAS unsigned* scr, int item, int lane, int nblk, float sc) {
    const int kb = item / nblk, nb = item % nblk, k0 = 128 * kb, n0 = 64 * nb;
    const int nn = (lane & 15) * 4, kq4 = lane >> 4;
    const float* colp = src(n0 + nn); const int ld = src.ld;
#pragma unroll 2
    for (int i = 0; i < 8; ++i) { const int kq = 4 * i + kq4, k = k0 + 4 * kq; f32x4 r[4];
#pragma unroll
        for (int q = 0; q < 4; ++q) r[q] = (k + q < Ksrc) ? *(const f32x4*)(colp + (size_t)(k + q) * ld) : (f32x4){0.f, 0.f, 0.f, 0.f};
#pragma unroll
        for (int j = 0; j < 4; ++j) { int w = 0; w = __builtin_amdgcn_cvt_pk_fp8_f32(r[0][j] * sc, r[1][j] * sc, w, false); w = __builtin_amdgcn_cvt_pk_fp8_f32(r[2][j] * sc, r[3][j] * sc, w, true); scr[kq * 65 + nn + j] = (unsigned)w; } }
    LDS_WAIT(); asm volatile("" ::: "memory");
    const int c = lane & 7;
#pragma unroll
    for (int j = 0; j < 8; ++j) { const int n = (lane >> 3) + 8 * j; const LAS unsigned* sp = scr + (4 * c) * 65 + n;
        v4u o; o.x = sp[0]; o.y = sp[65]; o.z = sp[130]; o.w = sp[195];
        *(GAS v4u*)(WT + (size_t)(n0 + n) * Kpad + k0 + 16 * c) = o; }
    LDS_WAIT(); asm volatile("" ::: "memory");
}
template <class Src>
__device__ __forceinline__ void conv_matrix_f8(Frame& F, const Src& src, int Ksrc, int Kpad, int Nout, unsigned char* WT, float sc) {
    LAS unsigned* scr = (LAS unsigned*)(F.lds + F.wave * 16384);
    const int gw = F.vcu * NWAVES + F.wave, NGW = F.G * NWAVES, nblk = Nout / 64, nitems = (Kpad / 128) * nblk;
    for (int it = gw; it < nitems; it += NGW) conv_item_f8(src, Ksrc, Kpad, WT, scr, it, F.lane, nblk, sc);
}
template <class Src, bool F8>
__device__ __forceinline__ void conv_matrix_wg(Frame& F, const Src& src, int Ksrc, int Kpad, int Nout, unsigned char* WT, float sc, int rot = 0) {
    constexpr int KT = F8 ? 128 : 64, RW = KT / 8;
    LAS unsigned short* l16 = (LAS unsigned short*)F.lds; LAS unsigned* l32 = (LAS unsigned*)F.lds;
    const int nblk = Nout / 256, nitems = (Kpad / KT) * nblk, ld = src.ld;
    for (int it = (F.vcu + F.G - rot % F.G) % F.G; it < nitems; it += F.G) {
        const int kb = it / nblk, nb = it % nblk, k0 = KT * kb, n0 = 256 * nb;
        const float* colp = src(n0 + 4 * F.lane); const float scn = sc * src.nsc(n0 + 4 * F.lane);
        f32x4 r[RW];
#pragma unroll
        for (int j = 0; j < RW; ++j) { const int k = k0 + F.wave * RW + j; r[j] = (k < Ksrc) ? *(const f32x4*)(colp + (size_t)k * ld) * src.ksc(k) : (f32x4){0.f, 0.f, 0.f, 0.f}; }
        if constexpr (F8) {
#pragma unroll
            for (int q4 = 0; q4 < RW / 4; ++q4) { const int kq = F.wave * (RW / 4) + q4;
#pragma unroll
                for (int j = 0; j < 4; ++j) { int w = 0; w = __builtin_amdgcn_cvt_pk_fp8_f32(r[4 * q4][j] * scn, r[4 * q4 + 1][j] * scn, w, false); w = __builtin_amdgcn_cvt_pk_fp8_f32(r[4 * q4 + 2][j] * scn, r[4 * q4 + 3][j] * scn, w, true);
                    l32[kq * 257 + 4 * F.lane + j] = (unsigned)w; } }
        } else {
#pragma unroll
            for (int j = 0; j < RW; ++j) { const int kk = F.wave * RW + j; LAS unsigned* d = (LAS unsigned*)(l16 + kk * 258 + 4 * F.lane); d[0] = pk2(r[j].x, r[j].y); d[1] = pk2(r[j].z, r[j].w); }
        }
        __syncthreads();
#pragma unroll
        for (int j = 0; j < 4; ++j) { const int task = F.tid + 512 * j, rr = task >> 3, c = task & 7; v4u o;
            if constexpr (F8) { const LAS unsigned* sp = l32 + (4 * c) * 257 + rr; o.x = sp[0]; o.y = sp[257]; o.z = sp[514]; o.w = sp[771];
                *(GAS v4u*)(WT + (size_t)(n0 + rr) * Kpad + k0 + 16 * c) = o; }
            else { const LAS unsigned short* sp = l16 + (8 * c) * 258 + rr;
                o.x = (unsigned)sp[0] | ((unsigned)sp[258] << 16); o.y = (unsigned)sp[2 * 258] | ((unsigned)sp[3 * 258] << 16); o.z = (unsigned)sp[4 * 258] | ((unsigned)sp[5 * 258] << 16); o.w = (unsigned)sp[6 * 258] | ((unsigned)sp[7 * 258] << 16);
                *(GAS v4u*)(WT + ((size_t)(n0 + rr) * Kpad + k0 + 8 * c) * 2) = o; }
        }
        __syncthreads();
    }
}
struct SrcPlain { const float* W; int ld; __device__ __forceinline__ const float* operator()(int n) const { return W + n; } __device__ __forceinline__ float ksc(int) const { return 1.f; } __device__ __forceinline__ float nsc(int) const { return 1.f; } };
struct SrcPlainG { const float* W; int ld; const float* g1; const float* g2;
    __device__ __forceinline__ const float* operator()(int n) const { return W + n; } __device__ __forceinline__ float ksc(int k) const { return k < 512 ? g1[k] : g2[k - 512]; } __device__ __forceinline__ float nsc(int) const { return 1.f; } };
struct SrcWin { const float* W; int ld;
    __device__ __forceinline__ float ksc(int) const { return 1.f; }
    __device__ __forceinline__ const float* operator()(int n) const {
        int s;
        if (n < 384) s = n;
        else if (n < 416) { const int p = n - 384; s = 384 + (p >> 1) + 16 * (p & 1); }
        else if (n < 424) s = 1952 + (n - 416);
        else if (n < 512) return nullptr;
        else if (n < 1024) s = 416 + (n - 512);
        else if (n < 1536) s = 928 + (n - 1024);
        else s = 1440 + (n - 1536);
        return W + s; } };
struct SrcWuq { const float* W; int ld; const float* g;
    __device__ __forceinline__ float ksc(int k) const { return g[k]; }
    __device__ __forceinline__ const float* operator()(int n) const {
        int s;
        if (n < 512) s = (n >> 6) * 96 + (n & 63);
        else { const int r = n - 512, h = r >> 5, p = r & 31; s = h * 96 + 64 + (p >> 1) + 16 * (p & 1); }
        return W + s; } };
struct SrcWukv { const float* W; int ld; const float* g;
    __device__ __forceinline__ float ksc(int k) const { return g[k]; }
    __device__ __forceinline__ const float* operator()(int n) const {
        int s;
        if (n < 512) s = (n >> 6) * 128 + (n & 63);
        else { const int r = n - 512; s = (r >> 6) * 128 + 64 + (r & 63); }
        return W + s; } };
struct SrcGU { const float* Wg; const float* Wu; int ld;
    __device__ __forceinline__ float ksc(int) const { return 1.f; }
    __device__ __forceinline__ float nsc(int n) const { return ((n & 255) < 128) ? -LOG2E : -SC_H / (4.f * LOG2E); }
    __device__ __forceinline__ const float* operator()(int n) const { const int t = n >> 8, w = n & 255; return (w < 128) ? (Wg + t * 128 + w) : (Wu + t * 128 + (w - 128)); } };

__device__ __forceinline__ void mod_phase(Frame& F, const float* c, const float* ada_w, const float* ada_b, float* MOD) {
    LAS float* cact = (LAS float*)F.lds;
    LAS float* red = cact + 8 * 1024;
    for (int i = F.tid; i < 8 * 1024; i += NWAVES * 64) { const float v = c[i]; cact[i] = v / (1.f + __expf(-v)); }
    __syncthreads();
    for (int item = F.vcu; item < 192; item += F.G) {
        const int l = item / 96, j = (item % 96) * 64 + F.lane;
        const float* wp = ada_w + (size_t)l * 1024 * 6144 + j;
        float acc[8];
#pragma unroll
        for (int b = 0; b < 8; ++b) acc[b] = 0.f;
        const int kb = F.wave * 128;
#pragma unroll 4
        for (int k = kb; k < kb + 128; ++k) { const float w = wp[(size_t)k * 6144];
#pragma unroll
            for (int b = 0; b < 8; ++b) acc[b] += cact[b * 1024 + k] * w; }
#pragma unroll
        for (int b = 0; b < 8; ++b) red[(F.wave * 8 + b) * 64 + F.lane] = acc[b];
        __syncthreads();
        { const int b = F.wave; float s = ada_b[l * 6144 + j];
#pragma unroll
          for (int w = 0; w < 8; ++w) s += red[(w * 8 + b) * 64 + F.lane];
          MOD[((size_t)l * 8 + b) * 6144 + j] = s; }
        __syncthreads();
    }
}

template <bool ROUTER, bool RESID, bool F8OUT = ROUTER>
__device__ __forceinline__ void norm_phase(Frame& F, const float* X, const float* g, const float* modl  , int part  , bf16* XN,
                                           const float* router_w, int* TOKE, float* TOKW, unsigned* CNT, const bf16* T, const float* rgate  , float* Xout) {
    const int gw = F.vcu * NWAVES + F.wave, NGW = F.G * NWAVES;
    if constexpr (ROUTER) { if (F.tid < 16) ((LAS unsigned*)(F.lds + LCNT_OFF))[F.tid] = 0u; __syncthreads(); }
    f32x4 gv[4];
#pragma unroll
    for (int j = 0; j < 4; ++j) gv[j] = *(const f32x4*)(g + 4 * F.lane + 256 * j);
    f32x4 vn[4]; v2u tn[4];
#pragma unroll
    for (int j = 0; j < 4; ++j) { vn[j] = ((const f32x4*)(X + (size_t)gw * DM) + F.lane)[64 * j]; if constexpr (RESID) tn[j] = ((const v2u*)(T + (size_t)gw * DM) + F.lane)[64 * j]; }
    for (int m = gw; m < M; m += NGW) {
        const int b = m >> 12;
        const f32x4* sh = (const f32x4*)(modl + (size_t)b * 6144 + part * 1024) + F.lane;
        const f32x4* sc = (const f32x4*)(modl + (size_t)b * 6144 + (part + 1) * 1024) + F.lane;
        f32x4 v[4]; v2u tc[4]; float s = 0.f;
#pragma unroll
        for (int j = 0; j < 4; ++j) { v[j] = vn[j]; if constexpr (RESID) tc[j] = tn[j]; }
        { const int mn = (m + NGW < M) ? m + NGW : m;
#pragma unroll
          for (int j = 0; j < 4; ++j) { vn[j] = ((const f32x4*)(X + (size_t)mn * DM) + F.lane)[64 * j]; if constexpr (RESID) tn[j] = ((const v2u*)(T + (size_t)mn * DM) + F.lane)[64 * j]; } }
        if constexpr (RESID) {
            const f32x4* gr = (const f32x4*)(rgate + (size_t)b * 6144) + F.lane; f32x4* xo = (f32x4*)(Xout + (size_t)m * DM) + F.lane;
#pragma unroll
            for (int j = 0; j < 4; ++j) { const v2u t = tc[j]; const f32x4 gg = gr[64 * j];
                v[j].x += gg.x * bf2f(t.x & 0xffffu); v[j].y += gg.y * bf2f(t.x >> 16); v[j].z += gg.z * bf2f(t.y & 0xffffu); v[j].w += gg.w * bf2f(t.y >> 16); xo[64 * j] = v[j]; }
        }
#pragma unroll
        for (int j = 0; j < 4; ++j) s += (v[j].x * v[j].x + v[j].y * v[j].y) + (v[j].z * v[j].z + v[j].w * v[j].w);
        const float r = 1.f / sqrtf(wave_sum(s) * (1.f / DM) + EPS);
        v2u* o8 = (v2u*)(XN + (size_t)m * DM) + F.lane; unsigned* o4 = (unsigned*)((unsigned char*)XN + (size_t)m * DM) + F.lane;
#pragma unroll
        for (int j = 0; j < 4; ++j) { const f32x4 a = sh[64 * j], c1 = sc[64 * j]; v[j] = (v[j] * r) * gv[j]; v[j] = v[j] * (c1 + 1.f) + a;
            if constexpr (F8OUT) { int w = 0; w = __builtin_amdgcn_cvt_pk_fp8_f32(fminf(fmaxf(v[j].x, -448.f), 448.f), fminf(fmaxf(v[j].y, -448.f), 448.f), w, false);
                w = __builtin_amdgcn_cvt_pk_fp8_f32(fminf(fmaxf(v[j].z, -448.f), 448.f), fminf(fmaxf(v[j].w, -448.f), 448.f), w, true); o4[64 * j] = (unsigned)w; }
            else { v2u w; w.x = pk2(v[j].x, v[j].y); w.y = pk2(v[j].z, v[j].w); o8[64 * j] = w; } }
        if constexpr (ROUTER) {
            float lg[8];
#pragma unroll
            for (int e = 0; e < 8; ++e) lg[e] = 0.f;
#pragma unroll
            for (int j = 0; j < 4; ++j)
#pragma unroll
                for (int q = 0; q < 4; ++q) { const float* rw = router_w + (size_t)(4 * F.lane + 256 * j + q) * 8; const f32x4 w0 = *(const f32x4*)rw, w1 = *(const f32x4*)(rw + 4); const float hv = v[j][q];
                    lg[0] += hv * w0.x; lg[1] += hv * w0.y; lg[2] += hv * w0.z; lg[3] += hv * w0.w; lg[4] += hv * w1.x; lg[5] += hv * w1.y; lg[6] += hv * w1.z; lg[7] += hv * w1.w; }
#pragma unroll
            for (int e = 0; e < 8; ++e) lg[e] = wave_sum(lg[e]);
            int e0 = 0; float v0 = lg[0];
#pragma unroll
            for (int e = 1; e < 8; ++e) if (lg[e] > v0) { v0 = lg[e]; e0 = e; }
            int e1 = -1; float v1 = -INFINITY;
#pragma unroll
            for (int e = 0; e < 8; ++e) if (e != e0 && lg[e] > v1) { v1 = lg[e]; e1 = e; }
            const float w1 = 1.f / (1.f + __expf(v0 - v1)), w0 = 1.f - w1;
            if (F.lane == 0) { TOKE[m] = e0 | (e1 << 8); *(f32x2*)(TOKW + 2 * (size_t)m) = (f32x2){w0, w1};
                LAS unsigned* lc = (LAS unsigned*)(F.lds + LCNT_OFF);
                __hip_atomic_fetch_add(lc + e0, 1u, __ATOMIC_RELAXED, __HIP_MEMORY_SCOPE_WORKGROUP); __hip_atomic_fetch_add(lc + e1, 1u, __ATOMIC_RELAXED, __HIP_MEMORY_SCOPE_WORKGROUP); }
        }
    }
    if constexpr (ROUTER) { __syncthreads(); if (F.tid < 16) CNT[F.vcu * 16 + F.tid] = ((LAS unsigned*)(F.lds + LCNT_OFF))[F.tid]; }
}

__device__ __forceinline__ void rope_phase(Frame& F, const int* positions, float* ROPE) {
    const int gw = F.vcu * NWAVES + F.wave, NGW = F.G * NWAVES;
    const int i = F.lane & 15; const float invf = powf(10000.f, -(float)i / 16.f);
    for (int m4 = gw; m4 < M / 4; m4 += NGW) { const int m = 4 * m4 + (F.lane >> 4);
        const float ang = (float)positions[m] * invf; float sn, cs; sincosf(ang, &sn, &cs);
        *(f32x2*)(ROPE + (size_t)m * 32 + 2 * i) = (f32x2){cs, sn}; }
}
__device__ __forceinline__ float log_sigmoid(float x) { return fminf(x, 0.f) - log1pf(__expf(-fabsf(x))); }
__device__ __forceinline__ void scan_phase(Frame& F, const float* FLOG, const float* fb, bf16* QF, bf16* KF) {
    const int sc = (int)blockIdx.x - (F.G - 64);
    if (sc >= 0) {
        const int b = sc >> 3, h = sc & 7; const float bias = fb[h];
        const size_t m0 = (size_t)b * SEQ + 8 * F.tid;
        LAS float* wtot = (LAS float*)(F.lds + LCNT_OFF + 512);
        float lf[8]; float tot = 0.f;
#pragma unroll
        for (int j = 0; j < 8; ++j) { lf[j] = log_sigmoid(FLOG[(m0 + j) * 8 + h] + bias); tot += lf[j]; }
        float inc = tot;
#pragma unroll
        for (int o = 1; o < 64; o <<= 1) { const float t = __shfl_up(inc, o); if (F.lane >= o) inc += t; }
        if (F.lane == 63) wtot[F.wave] = inc;
        __syncthreads();
        float run = inc - tot;
        for (int w = 0; w < F.wave; ++w) run += wtot[w];
#pragma unroll
        for (int j = 0; j < 8; ++j) { run += lf[j]; const float L = run * LOG2E;
            const unsigned hi = f2bf(L); const float r1 = L - bf2f(hi); const unsigned mi = f2bf(r1); const float r2 = r1 - bf2f(mi); const unsigned lo = f2bf(r2);
            const unsigned one = 0x3f80u;
            v4u q0, k0; const v4u z = (v4u){0u, 0u, 0u, 0u};
            q0.x = hi | (mi << 16); q0.y = lo | (one << 16); q0.z = one | (one << 16); q0.w = 0u;
            k0.x = one | (one << 16); k0.y = one | ((hi ^ 0x8000u) << 16); k0.z = (mi ^ 0x8000u) | ((lo ^ 0x8000u) << 16); k0.w = 0u;
            bf16* qp = QF + (m0 + j) * QF_P + h * 80 + 64; bf16* kp = KF + kimg<10>((int)(m0 + j), h, 64); bf16* kp2 = KF + kimg<10>((int)(m0 + j), h, 72);
            *(v4u*)qp = q0; *(v4u*)(qp + 8) = z; *(v4u*)kp = k0; *(v4u*)kp2 = z; }
    }
    __syncthreads();
}

__device__ __forceinline__ void route_phase(Frame& F, const unsigned* CNT  , const int* TOKE, int* ROWTOK, int* TOKSLOT, int* TEXP  ) {
    LAS unsigned* sh = (LAS unsigned*)(F.lds + LCNT_OFF);
    const int gw = F.vcu * NWAVES + F.wave, NGW = F.G * NWAVES;
    if (F.tid < 8) sh[64 + F.tid] = 0u;
    { const int e = F.wave; unsigned tot = 0u, pre = 0u;
#pragma unroll
        for (int j = 0; j < 4; ++j) { const int wg = F.lane + 64 * j; const unsigned v = (wg < F.G) ? CNT[wg * 16 + e] : 0u; tot += v; pre += (wg < F.vcu) ? v : 0u; }
#pragma unroll
        for (int o = 1; o < 64; o <<= 1) { tot += __shfl_xor(tot, o); pre += __shfl_xor(pre, o); }
        if (F.lane == 0) { sh[e] = tot; sh[16 + e] = pre; } }
    __syncthreads();
    if (F.tid < 8) { unsigned st = 0u;
        for (int t2 = 0; t2 < F.tid; ++t2) st += (sh[t2] + 255u) & ~255u;
        sh[48 + F.tid] = st; sh[32 + F.tid] = st + sh[16 + F.tid]; }
    __syncthreads();
    if (F.lane < 16) { const int m = gw + F.lane * NGW;
        if (m < M) { const int te = TOKE[m]; const int e0 = te & 255, e1 = te >> 8;
            const unsigned i0 = __hip_atomic_fetch_add(sh + 64 + e0, 1u, __ATOMIC_RELAXED, __HIP_MEMORY_SCOPE_WORKGROUP), i1 = __hip_atomic_fetch_add(sh + 64 + e1, 1u, __ATOMIC_RELAXED, __HIP_MEMORY_SCOPE_WORKGROUP);
            const unsigned s0 = sh[32 + e0] + i0, s1 = sh[32 + e1] + i1;
            ROWTOK[s0] = m; ROWTOK[s1] = m; TOKSLOT[2 * m] = (int)s0; TOKSLOT[2 * m + 1] = (int)s1; } }
    if (F.vcu < 8) { const unsigned tot = sh[F.vcu], seg = sh[48 + F.vcu], end = (tot + 255u) & ~255u;
        for (unsigned r = tot + F.tid; r < end; r += NWAVES * 64) ROWTOK[seg + r] = -1; }
    if (F.vcu == 16 && F.tid == 0) { int t = 0;
        for (int e = 0; e < 8; ++e) { t += (int)((sh[e] + 255u) >> 8); TEXP[1 + e] = t; }
        TEXP[0] = t; }
    __syncthreads();
}

__device__ __forceinline__ void outnorm_phase(Frame& F, bf16* O, const float* g1, const float* g2) {
    const int gw = F.vcu * NWAVES + F.wave, NGW = F.G * NWAVES;
    float ga[8], gb[8];
#pragma unroll
    for (int j = 0; j < 8; ++j) { ga[j] = g1[8 * F.lane + j]; gb[j] = g2[8 * F.lane + j]; }
    for (int m = gw; m < M; m += NGW) {
        v4u* p = (v4u*)(O + (size_t)m * O_P) + F.lane;
        const v4u a = p[0], b = p[64];
        float fa[8], fbv[8]; float sa = 0.f, sb = 0.f;
#pragma unroll
        for (int j = 0; j < 4; ++j) { fa[2 * j] = bf2f(a[j] & 0xffffu); fa[2 * j + 1] = bf2f(a[j] >> 16); fbv[2 * j] = bf2f(b[j] & 0xffffu); fbv[2 * j + 1] = bf2f(b[j] >> 16); }
#pragma unroll
        for (int j = 0; j < 8; ++j) { sa += fa[j] * fa[j]; sb += fbv[j] * fbv[j]; }
        const float ra = 1.f / sqrtf(wave_sum(sa) * (1.f / 512.f) + EPS), rb = 1.f / sqrtf(wave_sum(sb) * (1.f / 512.f) + EPS);
        v4u oa, ob;
#pragma unroll
        for (int j = 0; j < 4; ++j) { oa[j] = pk2(fa[2 * j] * ra * ga[2 * j], fa[2 * j + 1] * ra * ga[2 * j + 1]); ob[j] = pk2(fbv[2 * j] * rb * gb[2 * j], fbv[2 * j + 1] * rb * gb[2 * j + 1]); }
        p[0] = oa; p[64] = ob;
    }
}

__device__ __forceinline__ void final_phase(Frame& F, float* X, const float* g, const bf16* Y, const bf16* Yp, const int* TEXP, const int* TOKSLOT, const float* TOKW, const float* gf  ) {
    const int gw = F.vcu * NWAVES + F.wave, NGW = F.G * NWAVES;
    int tail0, S; size_t pstride;
    { pg8::MoeOrderD O; O.init_d(__builtin_amdgcn_readfirstlane(TEXP[0]), FF / 128, F.G, 0); S = O.S; tail0 = O.mainM * 256; pstride = (size_t)(O.tailSub / (4 * O.S)) * 256 * DM; }
    f32x4 gv[4];
#pragma unroll
    for (int j = 0; j < 4; ++j) gv[j] = *(const f32x4*)(g + 4 * F.lane + 256 * j);
    for (int m = gw; m < M; m += NGW) {
        const int b = m >> 12;
        f32x4* xr = (f32x4*)(X + (size_t)m * DM) + F.lane;
        const int s0 = TOKSLOT[2 * m], s1 = TOKSLOT[2 * m + 1]; const float w0 = TOKW[2 * m], w1 = TOKW[2 * m + 1];
        const v2u* y0 = (const v2u*)(Y + (size_t)s0 * DM) + F.lane; const v2u* y1 = (const v2u*)(Y + (size_t)s1 * DM) + F.lane; const f32x4* gr = (const f32x4*)(gf + (size_t)b * 6144) + F.lane;
        f32x4 v[4]; float s = 0.f;
#pragma unroll
        for (int j = 0; j < 4; ++j) { v[j] = xr[64 * j]; const v2u a = y0[64 * j], c = y1[64 * j]; const f32x4 gg = gr[64 * j];
            v[j].x += gg.x * (w0 * bf2f(a.x & 0xffffu) + w1 * bf2f(c.x & 0xffffu)); v[j].y += gg.y * (w0 * bf2f(a.x >> 16) + w1 * bf2f(c.x >> 16));
            v[j].z += gg.z * (w0 * bf2f(a.y & 0xffffu) + w1 * bf2f(c.y & 0xffffu)); v[j].w += gg.w * (w0 * bf2f(a.y >> 16) + w1 * bf2f(c.y >> 16));
        }
        if (S > 1 && (s0 >= tail0 || s1 >= tail0)) {
#pragma unroll 1
            for (int k = 0; k < 2; ++k) { const int sk = k ? s1 : s0; const float wk = k ? w1 : w0; if (sk < tail0) continue;
#pragma unroll 1
                for (int p = 1; p < S; ++p) { const v2u* yp = (const v2u*)(Yp + (size_t)(p - 1) * pstride + (size_t)(sk - tail0) * DM) + F.lane;
#pragma unroll
                    for (int j = 0; j < 4; ++j) { const v2u a = yp[64 * j]; const f32x4 gg = gr[64 * j];
                        v[j].x += gg.x * (wk * bf2f(a.x & 0xffffu)); v[j].y += gg.y * (wk * bf2f(a.x >> 16)); v[j].z += gg.z * (wk * bf2f(a.y & 0xffffu)); v[j].w += gg.w * (wk * bf2f(a.y >> 16)); } } } }
#pragma unroll
        for (int j = 0; j < 4; ++j) s += (v[j].x * v[j].x + v[j].y * v[j].y) + (v[j].z * v[j].z + v[j].w * v[j].w);
        const float r = 1.f / sqrtf(wave_sum(s) * (1.f / DM) + EPS);
#pragma unroll
        for (int j = 0; j < 4; ++j) xr[64 * j] = (v[j] * r) * gv[j];
    }
}

typedef __bf16 bf16x2_t __attribute__((ext_vector_type(2)));
template <int DQK>
__device__ __forceinline__ void attn_naive_unit(Frame& F, const bf16* Q, int qpitch, const bf16* K, int kpitch, const bf16* V, int vpitch, bf16* O  , int b, int h, int qb) {
    LAS unsigned* Ksh = (LAS unsigned*)F.lds;
    LAS float* Vsh = (LAS float*)(F.lds + 64 * DQK * 2);
    const int tid = F.tid, qpos = qb * 512 + tid; const size_t row = (size_t)b * SEQ + qpos;
    unsigned q[DQK / 2]; float o[64];
    { const bf16* qp = Q + row * qpitch + h * DQK;
#pragma unroll
      for (int d8 = 0; d8 < DQK / 8; ++d8) { const v4u w = *(const v4u*)(qp + 8 * d8);
#pragma unroll
          for (int j = 0; j < 4; ++j) q[4 * d8 + j] = w[j]; } }
#pragma unroll
    for (int d = 0; d < 64; ++d) o[d] = 0.f;
    float mrun = -INFINITY, l = 0.f;
    const int ntile = 8 * (qb + 1);
    for (int t = 0; t < ntile; ++t) {
        __syncthreads();
        for (int idx = tid; idx < 64 * DQK / 8; idx += NWAVES * 64) { const int r = idx / (DQK / 8), c8 = idx % (DQK / 8);
            const v4u w = *(const v4u*)(K + ((size_t)b * SEQ + t * 64 + r) * kpitch + h * DQK + 8 * c8); *(LAS v4u*)(Ksh + r * (DQK / 2) + 4 * c8) = w; }
        { const int r = tid >> 3, c8 = tid & 7; const v4u w = *(const v4u*)(V + ((size_t)b * SEQ + t * 64 + r) * vpitch + h * 64 + 8 * c8); LAS float* d = Vsh + r * 64 + 8 * c8;
#pragma unroll
          for (int j = 0; j < 4; ++j) { d[2 * j] = bf2f(w[j] & 0xffffu); d[2 * j + 1] = bf2f(w[j] >> 16); } }
        __syncthreads();
        const int kbase = t * 64;
#pragma unroll 1
        for (int gk = 0; gk < 16; ++gk) {
            float s[4]; float mx = -INFINITY;
#pragma unroll
            for (int j = 0; j < 4; ++j) { const LAS unsigned* kr = Ksh + (gk * 4 + j) * (DQK / 2); float a = 0.f;
#pragma unroll
                for (int d = 0; d < DQK / 2; ++d) a = __builtin_amdgcn_fdot2_f32_bf16(__builtin_bit_cast(bf16x2_t, q[d]), __builtin_bit_cast(bf16x2_t, kr[d]), a, false);
                s[j] = (kbase + gk * 4 + j <= qpos) ? a : -INFINITY; mx = fmaxf(mx, s[j]); asm volatile("" ::: "memory"); }
            const float mnew = fmaxf(mrun, mx);
            if (mnew > -INFINITY) {
                const float alpha = __builtin_amdgcn_exp2f(mrun - mnew);
                l *= alpha;
#pragma unroll
                for (int d = 0; d < 64; ++d) o[d] *= alpha;
#pragma unroll
                for (int j = 0; j < 4; ++j) { const float p = __builtin_amdgcn_exp2f(s[j] - mnew); l += p; const LAS float* vr = Vsh + (gk * 4 + j) * 64;
#pragma unroll
                    for (int dc = 0; dc < 4; ++dc) {
#pragma unroll
                        for (int d = 0; d < 16; ++d) o[dc * 16 + d] += p * vr[dc * 16 + d];
                        asm volatile("" ::: "memory"); } }
                mrun = mnew;
            }
        }
    }
    const float rl = 1.f / l;
    bf16* op = O + row * O_P + h * 64;
#pragma unroll
    for (int d8 = 0; d8 < 8; ++d8) { v4u w;
#pragma unroll
        for (int j = 0; j < 4; ++j) w[j] = pk2(o[8 * d8 + 2 * j] * rl, o[8 * d8 + 2 * j + 1] * rl);
        *(v4u*)(op + 8 * d8) = w; }
    __syncthreads();
}

namespace att {
using f32x16 = __attribute__((ext_vector_type(16))) float;
using s16x4 = __attribute__((ext_vector_type(4))) short;
using u32x4 = __attribute__((ext_vector_type(4))) unsigned;
typedef __attribute__((address_space(3))) const char* lds_cptr;
typedef short v4i16_t __attribute__((ext_vector_type(4)));
__device__ __forceinline__ int crow(int r, int hi) { return (r & 3) + 8 * (r >> 2) + 4 * hi; }
__device__ __forceinline__ void glds16(const void* gsrc, unsigned lds_dst) { unsigned keep;
    asm volatile("s_mov_b32 %0, m0\n\ts_mov_b32 m0, %2\n\ts_nop 0\n\tglobal_load_lds_dwordx4 %1, off\n\ts_mov_b32 m0, %0" : "=&s"(keep) : "v"(gsrc), "s"(lds_dst) : "memory"); }
__device__ __forceinline__ unsigned cvtpk(float lo, float hi) { unsigned r; asm("v_cvt_pk_bf16_f32 %0, %1, %2" : "=v"(r) : "v"(lo), "v"(hi)); return r; }
#define ATT_WAIT_BAR(N) asm volatile("s_waitcnt vmcnt(" #N ") lgkmcnt(0)\n\ts_barrier" ::: "memory")
constexpr float THR = 8.f;

__device__ __forceinline__ float max3f(float a, float b, float c) { float r; asm("v_max3_f32 %0, %1, %2, %3" : "=v"(r) : "v"(a), "v"(b), "v"(c)); return r; }
__device__ __forceinline__ float max2f(float a, float b) { float r; asm("v_max_f32_e32 %0, %1, %2" : "=v"(r) : "v"(a), "v"(b)); return r; }
__device__ __forceinline__ float fadd_s(float a, float b) { float r; asm("v_add_f32_e32 %0, %1, %2" : "=v"(r) : "v"(a), "v"(b)); return r; }
__device__ __forceinline__ float fsub_s(float a, float b) { float r; asm("v_sub_f32_e32 %0, %1, %2" : "=v"(r) : "v"(a), "v"(b)); return r; }
__device__ __forceinline__ float fmul_s(float a, float b) { float r; asm("v_mul_f32_e32 %0, %1, %2" : "=v"(r) : "v"(a), "v"(b)); return r; }

template <int DQK>
__device__ __forceinline__ void attn_unit(const bf16* Q, const bf16* K, const bf16* V, bf16* O, float* SSQO  , int b, int h, int qb, char* shm) {
    constexpr int NK = DQK / 16, NCH = DQK / 8, NX = NCH - 8, KBYTES = NCH * 1024, SLOT = KBYTES + 8192, PITCH = 8 * DQK;
    constexpr int LDS_WS = 3 * SLOT, LDS_OST = LDS_WS + 8 * 256;
    int tid_ = threadIdx.x; asm volatile("" : "+v"(tid_));
    const int tid = tid_, lane = tid & 63, r32 = lane & 31, hi = lane >> 5; const int wid = __builtin_amdgcn_readfirstlane(tid >> 6);
    const long rowbase = (long)b * SEQ; const int q0 = qb * 256;
    const bf16* Qw = Q + (rowbase + q0 + wid * 32) * PITCH + h * DQK;
    const bf16* Vh = V + rowbase * 512 + h * 64;
    const unsigned lds0 = (unsigned)(uintptr_t)shm;
    float* wsf = (float*)(shm + LDS_WS) + wid * 64;
    const int NT = 4 * (qb + 1);
    constexpr long KTILE = (long)NH * NCH * 512;
    const bf16* ksrc0 = K + kimg<NCH>((int)rowbase + (NT - 1) * 64, h, wid * 8) + lane * 8;
    const bf16* vsrc = Vh + ((long)(NT - 1) * 64 + 16 * (wid & 3) + (lane >> 2)) * 512 + (wid >> 2) * 32 + (lane & 3) * 8;
#define ATT_DMA(back, slotoff) do { const unsigned _d = (unsigned)__builtin_amdgcn_readfirstlane(lds0 + (slotoff)); \
        glds16(ksrc0 - (long)(back) * KTILE, _d + wid * 1024); if (wid < NX) glds16(ksrc0 - (long)(back) * KTILE + 8 * 512, _d + (8 + wid) * 1024); \
        glds16(vsrc - (long)(back) * 64 * 512, _d + KBYTES + wid * 1024); } while (0)
    ATT_DMA(0, 0); ATT_DMA(1, SLOT);
    bf16x8 qr[NK];
#pragma unroll
    for (int d0 = 0; d0 < NK; ++d0) qr[d0] = *reinterpret_cast<const bf16x8*>(&Qw[(long)r32 * PITCH + d0 * 16 + hi * 8]);
#pragma unroll
    for (int d0 = 0; d0 < NK; ++d0) asm volatile("" : "+v"(qr[d0]));
    asm volatile("s_waitcnt vmcnt(0)" ::: "memory");
    float mhat = 0.f, l_reg = 0.f; f32x16 o[2]; o[0] = f32x16{}; o[1] = f32x16{};
    const int jdiag = wid >> 1;
    const lds_cptr kp0 = (lds_cptr)shm + hi * 1024 + r32 * 16;
    const lds_cptr vp0 = (lds_cptr)shm + KBYTES + ((lane >> 4) & 1) * 32 + (lane & 3) * 8 + (4 * hi + ((lane & 15) >> 2)) * 64;
    f32x16 p0, p1; s16x4 vlo[8], vhi[8];
#define ATT_A(slot) do { \
        bf16x8 kf[2 * NK]; \
        _Pragma("unroll") for (int d0 = 0; d0 < NK; ++d0) { kf[2 * d0] = *(const __attribute__((address_space(3))) bf16x8*)(kp0 + (slot) + d0 * 2048); kf[2 * d0 + 1] = *(const __attribute__((address_space(3))) bf16x8*)(kp0 + (slot) + d0 * 2048 + 512); } \
        __builtin_amdgcn_sched_barrier(0); \
        _Pragma("unroll") for (int i = 0; i < 8; ++i) { \
            vlo[i] = __builtin_bit_cast(s16x4, __builtin_amdgcn_ds_read_tr16_b64_v4i16((__attribute__((address_space(3))) v4i16_t*)(vp0 + (slot) + (i >> 2) * 4096 + (i & 3) * 1024))); \
            vhi[i] = __builtin_bit_cast(s16x4, __builtin_amdgcn_ds_read_tr16_b64_v4i16((__attribute__((address_space(3))) v4i16_t*)(vp0 + (slot) + (i >> 2) * 4096 + (i & 3) * 1024 + 512))); } \
        __builtin_amdgcn_sched_barrier(0); \
        f32x16 c; \
        _Pragma("unroll") for (int r = 0; r < 16; ++r) c[r] = -mhat; \
        _Pragma("unroll") for (int i = 0; i < 2 * NK; ++i) asm volatile("" : "+v"(kf[i])); \
        p0 = __builtin_amdgcn_mfma_f32_32x32x16_bf16(kf[0], qr[0], c, 0, 0, 0); p1 = __builtin_amdgcn_mfma_f32_32x32x16_bf16(kf[1], qr[0], c, 0, 0, 0); \
        _Pragma("unroll") for (int d0 = 1; d0 < NK; ++d0) { p0 = __builtin_amdgcn_mfma_f32_32x32x16_bf16(kf[2 * d0], qr[d0], p0, 0, 0, 0); p1 = __builtin_amdgcn_mfma_f32_32x32x16_bf16(kf[2 * d0 + 1], qr[d0], p1, 0, 0, 0); } \
        _Pragma("unroll") for (int i = 0; i < 8; ++i) { asm volatile("" : "+v"(vlo[i])); asm volatile("" : "+v"(vhi[i])); } \
        asm volatile("s_nop 15\n\ts_nop 7" : "+v"(p0), "+v"(p1));        \
    } while (0)
#define ATT_B(MODE) do { \
        if (MODE == 1) { int qrel = wid * 32 + r32; asm volatile("" : "+v"(qrel)); const int kb = 64 * jdiag + 4 * hi; \
            _Pragma("unroll") for (int r = 0; r < 16; ++r) { const int kv = kb + (r & 3) + 8 * (r >> 2); if (kv > qrel) p0[r] = -INFINITY; if (kv + 32 > qrel) p1[r] = -INFINITY; } } \
        float rm; \
        { float a0 = max3f(p0[0], p0[1], p1[0]), a1 = max3f(p0[2], p0[3], p1[1]), a2 = max3f(p0[4], p0[5], p1[2]), a3 = max3f(p0[6], p0[7], p1[3]); \
          a0 = max3f(a0, p0[8], p0[9]); a1 = max3f(a1, p0[10], p0[11]); a2 = max3f(a2, p0[12], p0[13]); a3 = max3f(a3, p0[14], p0[15]); \
          a0 = max3f(a0, p1[4], p1[5]); a1 = max3f(a1, p1[6], p1[7]); a2 = max3f(a2, p1[8], p1[9]); a3 = max3f(a3, p1[10], p1[11]); \
          a0 = max3f(a0, p1[12], p1[13]); a1 = max3f(a1, p1[14], p1[15]); rm = max2f(max2f(a0, a1), max2f(a2, a3)); } \
        asm volatile("s_nop 1" : "+v"(rm));                                     \
        { auto rr = __builtin_amdgcn_permlane32_swap(__float_as_uint(rm), __float_as_uint(rm), false, false); float r0_ = __uint_as_float(rr[0]), r1_ = __uint_as_float(rr[1]); asm volatile("s_nop 1" : "+v"(r0_), "+v"(r1_)); rm = max2f(r0_, r1_); } \
        if (MODE == 1) { mhat += rm; \
            _Pragma("unroll") for (int r = 0; r < 16; ++r) { p0[r] = fsub_s(p0[r], rm); p1[r] = fsub_s(p1[r], rm); } } \
        else if (__builtin_expect(__any(rm > THR), 0)) { const float dl = fmaxf(rm, 0.f); mhat += dl; \
            _Pragma("unroll") for (int r = 0; r < 16; ++r) { p0[r] = fsub_s(p0[r], dl); p1[r] = fsub_s(p1[r], dl); } \
            const float f = __builtin_amdgcn_exp2f(-dl); l_reg *= f; if (hi == 0) wsf[r32] = f; \
            asm volatile("s_waitcnt lgkmcnt(0)" ::: "memory"); \
            _Pragma("unroll") for (int r4 = 0; r4 < 4; ++r4) { const f32x4 fv = *(const f32x4*)(wsf + 8 * r4 + 4 * hi); \
                _Pragma("unroll") for (int j = 0; j < 4; ++j) { o[0][4 * r4 + j] = fmul_s(o[0][4 * r4 + j], fv[j]); o[1][4 * r4 + j] = fmul_s(o[1][4 * r4 + j], fv[j]); } } } \
        _Pragma("unroll") for (int r = 0; r < 16; ++r) { p0[r] = __builtin_amdgcn_exp2f(p0[r]); p1[r] = __builtin_amdgcn_exp2f(p1[r]); } \
        asm volatile("s_nop 1" : "+v"(p0), "+v"(p1));                      \
        float sa0 = 0.f, sa1 = 0.f, sa2 = 0.f, sa3 = 0.f; \
        _Pragma("unroll") for (int r = 0; r < 16; r += 4) { \
            sa0 = fadd_s(sa0, p0[r]); sa1 = fadd_s(sa1, p0[r + 1]); sa2 = fadd_s(sa2, p0[r + 2]); sa3 = fadd_s(sa3, p0[r + 3]); \
            sa0 = fadd_s(sa0, p1[r]); sa1 = fadd_s(sa1, p1[r + 1]); sa2 = fadd_s(sa2, p1[r + 2]); sa3 = fadd_s(sa3, p1[r + 3]); } \
        l_reg += fadd_s(fadd_s(sa0, sa1), fadd_s(sa2, sa3)); \
        u32x4 pw[4]; \
        _Pragma("unroll") for (int j = 0; j < 4; ++j) { pw[0][j] = cvtpk(p0[2 * j], p0[2 * j + 1]); pw[1][j] = cvtpk(p0[8 + 2 * j], p0[8 + 2 * j + 1]); pw[2][j] = cvtpk(p1[2 * j], p1[2 * j + 1]); pw[3][j] = cvtpk(p1[8 + 2 * j], p1[8 + 2 * j + 1]); } \
        asm volatile("s_nop 3" : "+v"(pw[0]), "+v"(pw[1]), "+v"(pw[2]), "+v"(pw[3]), "+v"(o[0]), "+v"(o[1]));     \
        _Pragma("unroll") for (int ks = 0; ks < 4; ++ks) _Pragma("unroll") for (int d0 = 0; d0 < 2; ++d0) { const int i = d0 * 4 + ks; \
            const bf16x8 vf = (bf16x8){vlo[i][0], vlo[i][1], vlo[i][2], vlo[i][3], vhi[i][0], vhi[i][1], vhi[i][2], vhi[i][3]}; \
            o[d0] = __builtin_amdgcn_mfma_f32_32x32x16_bf16(__builtin_bit_cast(bf16x8, pw[ks]), vf, o[d0], 0, 0, 0); } \
    } while (0)
#define ATT_SYNC(k) do { if ((k) + 1 < NT) { if (wid < NX) ATT_WAIT_BAR(3); else ATT_WAIT_BAR(2); } else ATT_WAIT_BAR(0); } while (0)
    const bool late = wid >= 4;
    if (late) { ATT_SYNC(0); ATT_DMA(2, 2 * SLOT); }
#pragma unroll
    for (int s = 0; s < 4; ++s) {
        if (!late) { ATT_SYNC(s); if (s + 2 < NT) ATT_DMA(s + 2, ((s + 2) % 3) * SLOT); }
        const int jb = 3 - s;
        if (jb <= jdiag) ATT_A((s % 3) * SLOT);
        if (late && s + 1 < NT) { ATT_SYNC(s + 1); if (s + 3 < NT) ATT_DMA(s + 3, (s % 3) * SLOT); }
        if (jb == jdiag) ATT_B(1); else if (jb < jdiag) ATT_B(0);
    }
    int slot = SLOT, slot2 = 0;
#pragma unroll 1
    for (int s = 4; s < NT; ++s) {
        if (!late) { ATT_SYNC(s); if (s + 2 < NT) ATT_DMA(s + 2, slot2); }
        ATT_A(slot);
        if (late && s + 1 < NT) { ATT_SYNC(s + 1); if (s + 3 < NT) ATT_DMA(s + 3, slot); }
        ATT_B(0);
        slot = (slot == 2 * SLOT) ? 0 : slot + SLOT; slot2 = (slot2 == 2 * SLOT) ? 0 : slot2 + SLOT;
    }
#undef ATT_SYNC
#undef ATT_A
#undef ATT_B
    { auto rr = __builtin_amdgcn_permlane32_swap(__float_as_uint(l_reg), __float_as_uint(l_reg), false, false); l_reg = __uint_as_float(rr[0]) + __uint_as_float(rr[1]); }
    if (hi == 0) wsf[32 + r32] = l_reg; asm volatile("s_waitcnt lgkmcnt(0)" ::: "memory");
    float rli[16];
#pragma unroll
    for (int r = 0; r < 16; ++r) rli[r] = __builtin_amdgcn_rcpf(wsf[32 + crow(r, hi)]);
    bf16* Ow = O + (rowbase + q0 + wid * 32) * O_P + h * 64;
    { bf16* stg = (bf16*)(shm + LDS_OST) + wid * 2048;
#pragma unroll
      for (int r = 0; r < 16; ++r) { const int orow = crow(r, hi);
#pragma unroll
          for (int d0 = 0; d0 < 2; ++d0) stg[orow * 64 + d0 * 32 + r32] = (bf16)f2bf(o[d0][r] * rli[r]); }
      asm volatile("s_waitcnt lgkmcnt(0)" ::: "memory");
#pragma unroll
      for (int i = 0; i < 4; ++i) { const int row = i * 8 + (lane >> 3), ch = lane & 7; const u32x4 v = *(const u32x4*)(stg + row * 64 + ch * 8); *(u32x4*)(Ow + (long)row * O_P + ch * 8) = v;
          float ss = 0.f;
#pragma unroll
          for (int j = 0; j < 4; ++j) { const float lo_ = bf2f(v[j] & 0xffffu), hi_ = bf2f(v[j] >> 16); ss += lo_ * lo_ + hi_ * hi_; }
          ss += __shfl_xor(ss, 1); ss += __shfl_xor(ss, 2); ss += __shfl_xor(ss, 4);
          if (ch == 0) SSQO[(size_t)(rowbase + q0 + wid * 32 + row) * 16 + h] = ss; } }
    asm volatile("s_waitcnt lgkmcnt(0)\n\ts_barrier" ::: "memory");
#undef ATT_DMA
}
}

constexpr int PH_PRO = 0, PH_L0 = 1, PH_L1 = 11, PH_MOE = 19, PH_FINAL = 22, N_PHASES = 23;

__device__ __forceinline__ void weights_phase(Frame& F, const Args& args) {
    unsigned char* ws = args.ws;
#pragma unroll 1
    for (int l = 0; l < 2; ++l) {
        conv_matrix(F, SrcWin{args.in[6] + (size_t)l * 1024 * 1960, 1960}, 1024, 1024, INC, (bf16*)(ws + WS_WIN) + (size_t)l * INC * 1024, 1024 * l);
        conv_matrix(F, SrcWuq{args.in[8] + (size_t)l * 256 * 768, 768, args.in[7] + l * 256}, 256, 256, 768, (bf16*)(ws + WS_WUQ) + (size_t)l * 768 * 256, 96 * l);
        conv_matrix(F, SrcWukv{args.in[10] + (size_t)l * 128 * 1024, 1024, args.in[9] + l * 128}, 128, 128, 1024, (bf16*)(ws + WS_WUKV) + (size_t)l * 1024 * 128, 192 + 64 * l);
    }
    __syncthreads();
#pragma unroll 1
    for (int l = 0; l < 2; ++l)
        conv_matrix_wg<SrcPlainG, false>(F, SrcPlainG{args.in[14] + (size_t)l * 1024 * 1024, 1024, args.in[12] + l * 512, args.in[13] + l * 512}, 1024, 1024, 1024, ws + WS_WO + (size_t)l * 1024 * 1024 * 2, 1.f, 40 + 64 * l);
    conv_matrix_wg<SrcGU, true>(F, SrcGU{args.in[16], args.in[17], FF}, 1024, 1024, 2 * FF, ws + WS_WGU0, SC_WGU, 168);
    conv_matrix_wg<SrcPlain, true>(F, SrcPlain{args.in[18], 1024}, FF, FF, 1024, ws + WS_WD0, SC_WD, 136);
}

__global__ void __launch_bounds__(NWAVES * 64, 2) fwd_kernel(Args args) {
    extern __shared__ __attribute__((aligned(16))) unsigned char lds[];
    Frame F;
    F.lds = (LAS unsigned char*)lds;
    F.tid = threadIdx.x; F.lane = F.tid & 63; F.wave = __builtin_amdgcn_readfirstlane(F.tid >> 6);
    F.G = gridDim.x; { const int bx = blockIdx.x; F.vcu = (F.G % 8 == 0) ? (bx % 8) * (F.G / 8) + bx / 8 : bx; }
    F.ws = args.ws;
    unsigned char* ws = args.ws;
    for (int u = F.tid; u < (LDS_BYTES - LDSCTL_OFF) / 4; u += NWAVES * 64) ((LAS unsigned*)(F.lds + LDSCTL_OFF))[u] = 0u;
    __syncthreads();
#if MK_ONE_LAUNCH
    XcdBarrier bar = xcd_barrier_post((unsigned*)(ws + WS_CTL) + CW_BAR, (volatile LAS unsigned*)(F.lds + MISC_OFF) + 8);
#define SEAM(k) do { if (lo <= (k) && (k) + 1 < hi) xcd_barrier(bar); } while (0)
#else
#define SEAM(k) do { } while (0)
#endif
    const int lo = args.ph_lo, hi = args.ph_hi;
#ifndef PHSEL
#define PHSEL 0xFFFFu
#endif
#define IN(k) (lo <= (k) && (k) < hi)
#define SEL(kind) (((PHSEL) >> (kind)) & 1u)

#define FRESH() do { int t_ = threadIdx.x; asm volatile("" : "+v"(t_)); F.tid = t_; F.lane = t_ & 63; F.wave = __builtin_amdgcn_readfirstlane(t_ >> 6); } while (0)
#define INP(k) (args.in[k])
#define WSP(T, off) ((T*)(ws + (off)))
    float* X = args.out;

    if (SEL(0) && IN(PH_PRO)) { FRESH();
        rope_phase(F, (const int*)INP(2), WSP(float, WS_ROPE));
        mod_phase(F, INP(1), INP(3), INP(4), WSP(float, WS_MOD));
    }
    SEAM(PH_PRO);

#define LAYER_MIXER(l, pb) do { \
          \
        if (SEL(1) && IN(pb + 0)) { FRESH(); \
            if (l == 0) { norm_phase<false, false>(F, INP(0), INP(5), WSP(float, WS_MOD), 0, WSP(bf16, WS_XN), nullptr, nullptr, nullptr, nullptr, nullptr, nullptr, nullptr); weights_phase(F, args); } \
            else norm_phase<false, true>(F, X, INP(5) + 1024, WSP(float, WS_MOD) + (size_t)8 * 6144, 0, WSP(bf16, WS_XN), nullptr, nullptr, nullptr, nullptr, WSP(bf16, WS_T2), WSP(float, WS_MOD) + 5 * 1024, X); } \
        SEAM(pb + 0); \
          \
        if (SEL(2) && IN(pb + 1)) { \
            pg8::Gemm g{WSP(bf16, WS_XN), WSP(bf16, WS_WIN) + (size_t)l * INC * 1024, 1024, 0, nullptr}; pg8::StaticOrder S; S.init(M, INC, F.G, (int)blockIdx.x); \
            pg8::EpiInproj E{WSP(bf16, WS_CQN), WSP(bf16, WS_CKVN), WSP(bf16, WS_KM), WSP(float, WS_SSQQ), WSP(float, WS_SSQKV), WSP(float, WS_FLOG), WSP(float, WS_ROPE), WSP(bf16, WS_QF), WSP(bf16, WS_KF), WSP(bf16, WS_VF)}; \
            pg8::gemm_phase<pg8::EpiInproj, pg8::StaticOrder, true, true>(F.lds, g, S, E); } \
        SEAM(pb + 1); \
          \
        if (SEL(4) && IN(pb + 3)) { FRESH(); scan_phase(F, WSP(float, WS_FLOG), INP(11) + l * 8, WSP(bf16, WS_QF), WSP(bf16, WS_KF)); \
            { pg8::Gemm g{WSP(bf16, WS_CQN), WSP(bf16, WS_WUQ) + (size_t)l * 768 * 256, 256, 0, nullptr}; pg8::StaticOrder S; S.init(M, 768, F.G, (int)blockIdx.x); \
              pg8::EpiQ E{WSP(bf16, WS_QM), WSP(float, WS_ROPE), WSP(float, WS_SSQQ)}; pg8::gemm_phase<pg8::EpiQ, pg8::StaticOrder, true, true>(F.lds, g, S, E); } \
            { int kkv = 128; asm volatile("" : "+s"(kkv)); pg8::Gemm g{WSP(bf16, WS_CKVN), WSP(bf16, WS_WUKV) + (size_t)l * 1024 * 128, kkv, 0, nullptr}; pg8::StaticOrder S; S.init(M, 1024, F.G, (int)blockIdx.x); \
              pg8::EpiKV E{WSP(bf16, WS_KM), WSP(bf16, WS_VM), WSP(float, WS_SSQKV)}; pg8::gemm_phase<pg8::EpiKV, pg8::StaticOrder, true, true>(F.lds, g, S, E); } } \
        SEAM(pb + 3); \
          \
        if (SEL(5) && IN(pb + 4)) { \
            const int bh = F.vcu >> 2, s4 = F.vcu & 3, b = bh >> 3, h = bh & 7; \
            _Pragma("unroll 1") for (int i = 0; i < 4; ++i) { const int p = (i & 2) ? 7 - s4 : s4, qb = (i & 1) ? 15 - p : p; \
                att::attn_unit<96>(WSP(bf16, WS_QM), WSP(bf16, WS_KM), WSP(bf16, WS_VM), WSP(bf16, WS_O), WSP(float, WS_SSQO), b, h, qb, (char*)lds); } \
            _Pragma("unroll 1") for (int i = 0; i < 4; ++i) { const int p = (i & 2) ? 7 - s4 : s4, qb = (i & 1) ? 15 - p : p; \
                att::attn_unit<80>(WSP(bf16, WS_QF), WSP(bf16, WS_KF), WSP(bf16, WS_VF), WSP(bf16, WS_O) + 512, WSP(float, WS_SSQO) + 8, b, h, qb, (char*)lds); } } \
        SEAM(pb + 4); \
          \
        if (SEL(7) && IN(pb + 6)) { \
            pg8::Gemm g{WSP(bf16, WS_O), WSP(bf16, WS_WO) + (size_t)l * 1024 * 1024, 1024, 0, nullptr}; pg8::StaticOrder S; S.init(M, 1024, F.G, (int)blockIdx.x); \
            pg8::EpiWo E{WSP(bf16, WS_T1), WSP(float, WS_SSQO)}; \
            pg8::gemm_phase<pg8::EpiWo, pg8::StaticOrder, true, true>(F.lds, g, S, E); } \
        SEAM(pb + 6); \
    } while (0)

    LAYER_MIXER(0, PH_L0);
    if (SEL(8) && IN(PH_L0 + 7)) { FRESH(); norm_phase<false, true, true>(F, INP(0), INP(15), WSP(float, WS_MOD), 3, WSP(bf16, WS_XN8), nullptr, nullptr, nullptr, nullptr, WSP(bf16, WS_T1), WSP(float, WS_MOD) + 2 * 1024, X); }
    SEAM(PH_L0 + 7);
    if (SEL(9) && IN(PH_L0 + 8)) {
        pg8::Gemm g{WSP(bf16, WS_XN8), WSP(bf16, WS_WGU0), 512, 0, nullptr}; pg8::StaticOrder S; S.init(M, 2 * FF, F.G, (int)blockIdx.x);
        pg8::EpiSwigluF8 E{WSP(unsigned char, WS_H0)}; pg8::gemm_phase<pg8::EpiSwigluF8, pg8::StaticOrder, true, true, false, true>(F.lds, g, S, E);
    }
    SEAM(PH_L0 + 8);
    if (SEL(10) && IN(PH_L0 + 9)) {
        pg8::Gemm g{WSP(bf16, WS_H0), WSP(bf16, WS_WD0), FF / 2, 0, nullptr}; pg8::StaticOrder S; S.init(M, 1024, F.G, (int)blockIdx.x);
        pg8::EpiBf16Plain E{WSP(bf16, WS_T2), DM, 1.f / (SC_H * SC_WD)}; pg8::gemm_phase<pg8::EpiBf16Plain, pg8::StaticOrder, true, true, false, true>(F.lds, g, S, E);
    }
    SEAM(PH_L0 + 9);
    LAYER_MIXER(1, PH_L1);
    if (SEL(8) && IN(PH_L1 + 7)) { FRESH();
        norm_phase<true, true>(F, X, INP(15) + 1024, WSP(float, WS_MOD) + (size_t)8 * 6144, 3, WSP(bf16, WS_XN8), INP(19), WSP(int, WS_TOKE), WSP(float, WS_TOKW), WSP(unsigned, WS_CNT), WSP(bf16, WS_T1), WSP(float, WS_MOD) + (size_t)8 * 6144 + 2 * 1024, X);
#pragma unroll 1
        for (int e = 0; e < NE; ++e) {
            conv_matrix_wg<SrcGU, true>(F, SrcGU{INP(20) + (size_t)e * 1024 * FF, INP(21) + (size_t)e * 1024 * FF, FF}, 1024, 1024, 2 * FF, WSP(unsigned char, WS_WGU8) + (size_t)e * 2 * FF * 1024, SC_WGU);
            conv_matrix_wg<SrcPlain, true>(F, SrcPlain{INP(22) + (size_t)e * FF * 1024, 1024}, FF, FF, 1024, WSP(unsigned char, WS_WD8) + (size_t)e * 1024 * FF, SC_WD);
        }
    }
    SEAM(PH_L1 + 7);
    if (SEL(11) && IN(PH_MOE)) { FRESH(); route_phase(F, WSP(unsigned, WS_CNT), WSP(int, WS_TOKE), WSP(int, WS_ROWTOK), WSP(int, WS_TOKSLOT), WSP(int, WS_TEXP)); }
    SEAM(PH_MOE);
    if (SEL(11) && IN(PH_MOE + 1)) { const int* texp = WSP(int, WS_TEXP); const int ntile = __builtin_amdgcn_readfirstlane(texp[0]);
        pg8::Gemm g{WSP(bf16, WS_XN8), WSP(bf16, WS_WGU8), 512, (size_t)2 * FF * 1024, WSP(int, WS_ROWTOK)};
        pg8::MoeOrder S; S.init(ntile * 256, 2 * FF, F.G, (int)blockIdx.x); S.load(texp);
        pg8::EpiSwigluF8 E{WSP(unsigned char, WS_H8)}; pg8::gemm_phase<pg8::EpiSwigluF8, pg8::MoeOrder, true, true, true, true>(F.lds, g, S, E); }
    SEAM(PH_MOE + 1);
    if (SEL(12) && IN(PH_MOE + 2)) { const int* texp = WSP(int, WS_TEXP); const int ntile = __builtin_amdgcn_readfirstlane(texp[0]);
        pg8::Gemm g{(const bf16*)WSP(unsigned char, WS_H8), WSP(bf16, WS_WD8), FF / 2, (size_t)1024 * FF, nullptr};
        pg8::MoeOrderD S; S.init_d(ntile, FF / 128, F.G, (int)blockIdx.x); S.load(texp);
        pg8::EpiMoeY E{WSP(bf16, WS_Y), WSP(bf16, WS_YP), S.mainM * 256, (size_t)(ntile - S.mainM) * 256 * DM, 1.f / (SC_H * SC_WD)};
        pg8::gemm_phase<pg8::EpiMoeY, pg8::MoeOrderD, true, true, false, true, true>(F.lds, g, S, E); }
    SEAM(PH_MOE + 2);
    if (SEL(13) && IN(PH_FINAL)) { FRESH(); final_phase(F, X, INP(23), WSP(bf16, WS_Y), WSP(bf16, WS_YP), WSP(int, WS_TEXP), WSP(int, WS_TOKSLOT), WSP(float, WS_TOKW), WSP(float, WS_MOD) + (size_t)8 * 6144 + 5 * 1024); }
#undef IN
#undef SEAM
}

extern "C" void kernel_launch(void* const* d_in, const int* in_sizes, int n_in, void* d_out, int out_size, void* d_ws, size_t ws_size, hipStream_t stream) {
    static int grid = 0;
    if (grid == 0) {
        if (n_in != 24 || out_size != M * DM || ws_size < WS_END) { fprintf(stderr, "kernel_launch: unexpected shapes (n_in %d out %d ws %zu)\n", n_in, out_size, ws_size); grid = -1; return; }
        int dev = 0, cus = 0, per_cu = 0;
        if (hipGetDevice(&dev) != hipSuccess || hipDeviceGetAttribute(&cus, hipDeviceAttributeMultiprocessorCount, dev) != hipSuccess) { grid = -1; return; }
        if (hipFuncSetAttribute((const void*)fwd_kernel, hipFuncAttributeMaxDynamicSharedMemorySize, LDS_BYTES) != hipSuccess) { fprintf(stderr, "kernel_launch: hipFuncSetAttribute failed\n"); grid = -1; return; }
        if (hipOccupancyMaxActiveBlocksPerMultiprocessor(&per_cu, (const void*)fwd_kernel, NWAVES * 64, LDS_BYTES) != hipSuccess || per_cu < 1)
            fprintf(stderr, "kernel_launch: occupancy query reports %d\n", per_cu);
        (void)hipGetLastError();
        grid = cus;
        if (grid != 256) fprintf(stderr, "kernel_launch: %d CUs (built for 256)\n", grid);
    }
    if (grid < 0) return;
    (void)hipMemsetAsync((char*)d_ws + WS_CTL, 0, CTL_ZERO_BYTES, stream);
    Args a{};
    for (int i = 0; i < 24; ++i) a.in[i] = (const float*)d_in[i];
    a.out = (float*)d_out; a.ws = (unsigned char*)d_ws;
#if MK_ONE_LAUNCH
    a.ph_lo = 0; a.ph_hi = N_PHASES;
    hipLaunchKernelGGL(fwd_kernel, dim3(grid), dim3(NWAVES * 64), LDS_BYTES, stream, a);
#else
    for (int p = 0; p < N_PHASES; ++p) { a.ph_lo = p; a.ph_hi = p + 1; hipLaunchKernelGGL(fwd_kernel, dim3(grid), dim3(NWAVES * 64), LDS_BYTES, stream, a); }
#endif
}
```

```cpp
#include <hip/hip_runtime.h>
#include <cstdio>
#include <cstdint>
#include <cmath>

#ifndef MK_ONE_LAUNCH
#define MK_ONE_LAUNCH 1
#endif

#define GAS __attribute__((address_space(1)))
#define LAS __attribute__((address_space(3)))
typedef unsigned short bf16;
typedef unsigned v4u __attribute__((ext_vector_type(4)));
typedef unsigned v2u __attribute__((ext_vector_type(2)));
typedef float f32x4 __attribute__((ext_vector_type(4)));
typedef float f32x2 __attribute__((ext_vector_type(2)));
typedef short bf16x8 __attribute__((ext_vector_type(8)));
typedef GAS unsigned gu32;
typedef int v8i __attribute__((ext_vector_type(8)));
typedef int v4i __attribute__((ext_vector_type(4)));
typedef v8i v8i_a16 __attribute__((aligned(16)));

constexpr int NB = 8, SEQ = 4096, DM = 1024, M = NB * SEQ, NH = 8, FF = 3584, NE = 8;
constexpr int INC = 2048;
constexpr int PA_P = 512, QM_P = 768, KM_P = 768, VM_P = 512, QF_P = 640, KF_P = 640, VF_P = 512, O_P = 1024;
constexpr float LOG2E = 1.4426950408889634f;
constexpr float C2M = 0.10206207261596575f * LOG2E;
constexpr float C2F = 0.125f * LOG2E;
constexpr float EPS = 1e-6f;

constexpr size_t MiB = 1u << 20;
constexpr size_t WS_CTL = 0, CTL_ZERO_BYTES = 1 * MiB;
constexpr size_t WS_MOD = 1 * MiB;
constexpr size_t WS_WIN = 4 * MiB, WS_WUQ = 12 * MiB, WS_WUKV = 13 * MiB, WS_WO = 14 * MiB, WS_WGU0 = 18 * MiB, WS_WD0 = 32 * MiB;
constexpr size_t WS_XN = 40 * MiB;
constexpr size_t WS_R = 104 * MiB;
constexpr size_t WS_PA = WS_R, WS_CQN = 168 * MiB, WS_CKVN = 184 * MiB, WS_QM = 200 * MiB, WS_KM = 248 * MiB, WS_VM = 296 * MiB,
                 WS_QF = 328 * MiB, WS_KF = 368 * MiB, WS_VF = 408 * MiB, WS_O = 440 * MiB, WS_ROPE = 504 * MiB;
constexpr size_t WS_SSQQ = WS_PA, WS_SSQKV = WS_PA + 1 * MiB, WS_FLOG = WS_PA + 2 * MiB, WS_SSQO = WS_PA + 4 * MiB;
constexpr size_t WS_H0 = WS_R;
constexpr size_t WS_WGU8 = WS_R, WS_WD8 = 160 * MiB, WS_H8 = 192 * MiB;
constexpr size_t WS_XN8 = WS_XN;
constexpr int MOE_MAXTILE = 136, MOE_MAXROW = MOE_MAXTILE * 256;
constexpr size_t H8_ROUND = (size_t)MOE_MAXROW * FF;
constexpr float SC_WGU = 32.f, SC_WD = 64.f, SC_H = 4.f;
constexpr size_t WS_T1 = 200 * MiB, WS_T2 = 328 * MiB;
constexpr size_t WS_YP = WS_R;
constexpr size_t WS_Y = 432 * MiB;
constexpr size_t WS_RT = 570 * MiB;
constexpr size_t WS_ROWTOK = WS_RT, WS_TOKSLOT = WS_RT + 512 * 1024, WS_TOKE = WS_RT + 1024 * 1024, WS_TOKW = WS_RT + 1280 * 1024, WS_CNT = WS_RT + 1536 * 1024, WS_TEXP = WS_RT + 1600 * 1024;
constexpr size_t WS_END = 572 * MiB;
constexpr int LCNT_OFF = 126976;
constexpr int CW_BAR = 4096;

constexpr int RING_BYTES = 131072;
constexpr int LDSCTL_OFF = RING_BYTES, MISC_OFF = LDSCTL_OFF + 320;
constexpr int LDS_BYTES = 147456;
constexpr int NWAVES = 8;

#define LDS_WAIT() asm volatile("s_waitcnt lgkmcnt(0)" ::: "memory")
#define VM_WAIT() asm volatile("s_waitcnt vmcnt(0)" ::: "memory")
__device__ __forceinline__ unsigned f2bf(float f) { unsigned u = __builtin_bit_cast(unsigned, f); return (u + 0x7fffu + ((u >> 16) & 1u)) >> 16; }
__device__ __forceinline__ unsigned pk2(float lo, float hi) { return f2bf(lo) | (f2bf(hi) << 16); }
__device__ __forceinline__ float bf2f(unsigned h) { return __builtin_bit_cast(float, h << 16); }
__device__ __forceinline__ float wave_sum(float v) {
#pragma unroll
    for (int o = 1; o < 64; o <<= 1) v += __shfl_xor(v, o);
    return v;
}

template <int NCH> __host__ __device__ __forceinline__ size_t kimg(int row, int h, int d) {
    const int b = row >> 12, t = row & 4095;
    return (((((size_t)(b * 64 + (t >> 6)) * NH + h) * NCH + (d >> 3)) << 9) + (size_t)(((t & 63) << 3) + (d & 7)));
}

__host__ __device__ __forceinline__ size_t vimg(int row, int h, int d) {
    const int b = row >> 12, t = row & 4095;
    return (((((size_t)(b * 64 + (t >> 6)) * NH + h) * 8 + ((d >> 5) * 4 + ((t >> 4) & 3))) << 9) + (size_t)(((t & 15) << 5) + (d & 31)));
}

namespace pg8 {
#define PG8_LAS __attribute__((address_space(3)))
typedef unsigned short bf16_t;
typedef unsigned u32x4 __attribute__((ext_vector_type(4)));
constexpr int BM = 256, BK = 64, HALF = 128, HTB = HALF * BK * 2, STAGE_BYTES = 8 * HTB, NXCD = 8, WGM = 8;

__host__ __device__ __forceinline__ int lds_byte(int r, int c) { const int st = (r >> 4) * 2 + (c >> 5), rr = r & 15, cc = c & 31, ob = rr * 64 + cc * 2; return st * 1024 + (ob ^ (((ob >> 9) & 1) << 5)); }
__host__ __device__ __forceinline__ void stage_rc(int b, int& R, int& C) { const int st = b / 1024, sb = b % 1024, swz = sb ^ (((sb >> 9) & 1) << 5); R = (st >> 1) * 16 + swz / 64; C = (st & 1) * 32 + (swz % 64) / 2; }
__host__ __device__ __forceinline__ int perm32(int rho) { const int n = rho >> 4, i = rho & 15; return 8 * (i >> 2) + 4 * n + (i & 3); }

struct Unit { int pm, pn, bsel, part, nt; };
struct Gemm { const bf16_t* A; const bf16_t* Bt; int K; size_t bstride; const int* rowidx; };

struct StaticOrder {
    int nM, nN, nwg, G, c;
    __host__ __device__ void init(int M_, int N_, int G_, int c_) { nM = M_ / BM; nN = N_ / BM; nwg = nM * nN; G = G_; c = c_; }
    __host__ __device__ bool next(int i, Unit& u) const {
        const long L = (long)i * G + c; if (L >= nwg) return false;
        int wgid = (int)L; { const int q = nwg / NXCD, r = nwg % NXCD, xcd = wgid % NXCD, off = wgid / NXCD; wgid = (xcd < r ? xcd * (q + 1) : r * (q + 1) + (xcd - r) * q) + off; }
        const int nig = WGM * nN, gid = wgid / nig, fm = gid * WGM, gsz = (nM - fm) < WGM ? (nM - fm) : WGM;
        u.pm = fm + ((wgid % nig) % gsz); u.pn = (wgid % nig) / gsz; u.bsel = 0; u.part = 0; u.nt = 0; return true;
    }
};

__device__ __forceinline__ unsigned cvt_pk_bf16(float lo, float hi) { unsigned r; asm volatile("v_cvt_pk_bf16_f32 %0, %1, %2" : "=v"(r) : "v"(lo), "v"(hi)); return r; }

template <class Epi, class Sched, bool ALIGN_EPI = false, bool SP2 = false, bool GATHER = false, bool F8 = false, bool SPLITK = false>
__device__ __forceinline__ void gemm_phase(PG8_LAS unsigned char* lds, const Gemm g, const Sched& S, const Epi& E) {
    int tid_ = threadIdx.x; asm volatile("" : "+v"(tid_));
    const int tid = tid_, wid = __builtin_amdgcn_readfirstlane(tid >> 6), lane = tid & 63, wr = wid >> 2, wc = wid & 3, fr = lane & 15, fq = lane >> 4;
    const int K = g.K, nt = K / BK;
    unsigned voffA[2], voffB[2];
#pragma unroll
    for (int i = 0; i < 2; ++i) { int R, C; stage_rc(tid * 16 + i * 8192, R, C); const int Rb = Epi::PERM ? ((R & ~31) + perm32(R & 31)) : R;
        voffA[i] = (unsigned)(R * K + C) * 2u; voffB[i] = (unsigned)(Rb * K + C) * 2u; }
    asm volatile("" : "+v"(voffA[0]), "+v"(voffA[1]), "+v"(voffB[0]), "+v"(voffB[1]));
    const size_t kstep = (size_t)(BK * 2);
    const size_t hstep = (size_t)HALF * K * 2;
    const size_t tstep = 2 * hstep;
    const unsigned ldsw = (unsigned)wid * 1024u;
    int aoff = lds_byte(wr * 64 + fr, fq * 8), boff = lds_byte(wc * 32 + fr, fq * 8);
    asm volatile("" : "+v"(aoff), "+v"(boff));
#define PG8_SA(b, h) (((b) * 2 + (h)) * HTB)
#define PG8_SB(b, h) ((4 + (b) * 2 + (h)) * HTB)
#define PG8_STAGE(bufoff, gbase, voff) do { _Pragma("unroll") for (int _i = 0; _i < 2; ++_i) \
        __builtin_amdgcn_global_load_lds((const unsigned*)((const char*)(gbase) + (voff)[_i]), (PG8_LAS unsigned*)(lds + (bufoff) + ldsw + _i * 8192), 16, 0, 0); } while (0)
    unsigned gofC[2][2] = {{0u, 0u}, {0u, 0u}}, gofN[2][2] = {{0u, 0u}, {0u, 0u}}; int gR[2] = {0, 0}; unsigned gC[2] = {0u, 0u};
    if constexpr (GATHER) {
#pragma unroll
        for (int i = 0; i < 2; ++i) { int R, C; stage_rc(tid * 16 + i * 8192, R, C); gR[i] = R; gC[i] = (unsigned)C * 2u; }
        asm volatile("" : "+v"(gR[0]), "+v"(gR[1]), "+v"(gC[0]), "+v"(gC[1]));
    }
#define PG8_GOF(dst, unit) do { _Pragma("unroll") for (int _h = 0; _h < 2; ++_h) _Pragma("unroll") for (int _i = 0; _i < 2; ++_i) { int _t = g.rowidx[(unit).pm * BM + _h * HALF + gR[_i]]; _t = _t < 0 ? 0 : _t; \
        dst[_h][_i] = (unsigned)_t * (unsigned)(K * 2) + gC[_i]; } } while (0)
#define PG8_GTOK(dst, unit) do { _Pragma("unroll") for (int _h = 0; _h < 2; ++_h) _Pragma("unroll") for (int _i = 0; _i < 2; ++_i) dst[_h][_i] = (unsigned)g.rowidx[(unit).pm * BM + _h * HALF + gR[_i]]; } while (0)
#define PG8_GCVT(dst) do { _Pragma("unroll") for (int _h = 0; _h < 2; ++_h) _Pragma("unroll") for (int _i = 0; _i < 2; ++_i) { int _t = (int)dst[_h][_i]; _t = _t < 0 ? 0 : _t; dst[_h][_i] = (unsigned)_t * (unsigned)(K * 2) + gC[_i]; } } while (0)
#define PG8_STAGE_A(bufoff, tptr, h, kb, nx) do { if constexpr (GATHER) { _Pragma("unroll") for (int _i = 0; _i < 2; ++_i) { const unsigned _o = (nx) ? gofN[h][_i] : gofC[h][_i]; \
        __builtin_amdgcn_global_load_lds((const unsigned*)((const char*)g.A + (kb) + _o), (PG8_LAS unsigned*)(lds + (bufoff) + ldsw + _i * 8192), 16, 0, 0); } } \
        else PG8_STAGE(bufoff, (tptr) + (h) * hstep, voffA); } while (0)
#define PG8_LD32(p) __builtin_shufflevector(*(const PG8_LAS v4i*)(p), *(const PG8_LAS v4i*)((p) + 1024), 0, 1, 2, 3, 4, 5, 6, 7)
#define PG8_LDA(dst, b, h) do { if constexpr (F8) { _Pragma("unroll") for (int m = 0; m < 4; ++m) dst##8[m] = PG8_LD32(lds + PG8_SA(b, h) + aoff + m * 2048); } \
        else { _Pragma("unroll") for (int m = 0; m < 4; ++m) _Pragma("unroll") for (int k = 0; k < 2; ++k) dst[m][k] = *(const PG8_LAS bf16x8*)(lds + PG8_SA(b, h) + aoff + m * 2048 + k * 1024); } } while (0)
#define PG8_LDB(dst, b, h) do { if constexpr (F8) { _Pragma("unroll") for (int n = 0; n < 2; ++n) dst##8[n] = PG8_LD32(lds + PG8_SB(b, h) + boff + n * 2048); } \
        else { _Pragma("unroll") for (int n = 0; n < 2; ++n) _Pragma("unroll") for (int k = 0; k < 2; ++k) dst[n][k] = *(const PG8_LAS bf16x8*)(lds + PG8_SB(b, h) + boff + n * 2048 + k * 1024); } } while (0)
#define PG8_MMA(ai, bj, At, Bt) do { __builtin_amdgcn_s_setprio(1); if constexpr (F8) { _Pragma("unroll") for (int m = 0; m < 4; ++m) _Pragma("unroll") for (int n = 0; n < 2; ++n) \
            asm volatile("v_mfma_scale_f32_16x16x128_f8f6f4 %0, %1, %2, %0, %3, %4 op_sel_hi:[0,0,0]" : "+v"(acc[ai][bj][m][n]) : "v"(Bt##8[n]), "v"(At##8[m]), "v"((bj) == 0 ? f8scl : f8scl1), "v"(f8one)); } \
        else { _Pragma("unroll") for (int m = 0; m < 4; ++m) _Pragma("unroll") for (int n = 0; n < 2; ++n) _Pragma("unroll") for (int k = 0; k < 2; ++k) \
            acc[ai][bj][m][n] = __builtin_amdgcn_mfma_f32_16x16x32_bf16(Bt[n][k], At[m][k], acc[ai][bj][m][n], 0, 0, 0); } __builtin_amdgcn_s_setprio(0); } while (0)
#define PG8_WAIT_V(n) asm volatile("s_waitcnt vmcnt(" #n ")" ::: "memory")
#define PG8_WAIT_L(n) asm volatile("s_waitcnt lgkmcnt(" #n ")" ::: "memory")
#define PG8_WAIT_V8P(post) do { if (post) asm volatile("s_waitcnt vmcnt(%0)" :: "n"(8 + Epi::NS) : "memory"); else asm volatile("s_waitcnt vmcnt(8)" ::: "memory"); } while (0)
#define PG8_BAR __builtin_amdgcn_s_barrier()
#define PG8_SCHED __builtin_amdgcn_sched_barrier(0)
    Unit cur, nxt; int ui = 0;
    if (!S.next(0, cur)) return;
    f32x4 acc[2][2][4][2];
#pragma unroll
    for (int a = 0; a < 2; ++a)
#pragma unroll
        for (int b = 0; b < 2; ++b)
#pragma unroll
            for (int m = 0; m < 4; ++m)
#pragma unroll
                for (int n = 0; n < 2; ++n) acc[a][b][m][n] = (f32x4){0.f, 0.f, 0.f, 0.f};
    bf16x8 At[4][2], B0[2][2], B1[2][2]; v8i At8[4], B08[2], B18[2];
    int f8scl = 0x7F7F7F7F, f8scl1 = 0x7F7F7F7F, f8one = 0x7F7F7F7F;
    if constexpr (F8) { f8scl = Epi::SCL0; f8scl1 = Epi::SCL1; }
    asm volatile("" : "+v"(f8scl), "+v"(f8scl1), "+v"(f8one));
    int ntc = nt; size_t kofc = 0;
    if constexpr (SPLITK) { ntc = cur.nt; kofc = (size_t)(cur.part * cur.nt) * kstep; }
    const char* cA = (const char*)g.A + (size_t)cur.pm * tstep + kofc; const char* cB = (const char*)g.Bt + (size_t)cur.bsel * g.bstride + (size_t)cur.pn * tstep + kofc;
    if constexpr (GATHER) { PG8_GOF(gofC, cur); }
    if constexpr (SP2) {
        PG8_STAGE(PG8_SB(0, 0), cB, voffB); PG8_STAGE(PG8_SB(0, 1), cB + hstep, voffB); PG8_STAGE_A(PG8_SA(0, 0), cA, 0, 0, false); PG8_STAGE_A(PG8_SA(0, 1), cA, 1, 0, false);
        if (wr == 1) PG8_BAR;
        PG8_WAIT_V(2); PG8_BAR;
        PG8_STAGE(PG8_SB(1, 0), cB + kstep, voffB); PG8_STAGE_A(PG8_SA(1, 0), cA + kstep, 0, kstep, false); PG8_STAGE(PG8_SB(1, 1), cB + hstep + kstep, voffB);
        PG8_WAIT_V(6); PG8_BAR;
    } else {
        PG8_STAGE(PG8_SB(0, 0), cB, voffB); PG8_STAGE(PG8_SA(0, 0), cA, voffA); PG8_STAGE(PG8_SB(0, 1), cB + hstep, voffB); PG8_STAGE(PG8_SA(0, 1), cA + hstep, voffA);
        if (wr == 1) PG8_BAR;
        PG8_WAIT_V(4); PG8_BAR;
        PG8_STAGE(PG8_SB(1, 0), cB + kstep, voffB); PG8_STAGE(PG8_SA(1, 0), cA + kstep, voffA); PG8_STAGE(PG8_SB(1, 1), cB + hstep + kstep, voffB);
        PG8_WAIT_V(6); PG8_BAR;
    }
    for (;;) {
        const bool has_next = S.next(ui + 1, nxt);
        if constexpr (GATHER) { if (has_next) { PG8_GTOK(gofN, nxt); } }
        size_t kofn = 0; if constexpr (SPLITK) { if (has_next) kofn = (size_t)(nxt.part * nxt.nt) * kstep; }
        const char* nA = has_next ? (const char*)g.A + (size_t)nxt.pm * tstep + kofn : cA; const char* nB = has_next ? (const char*)g.Bt + (size_t)nxt.bsel * g.bstride + (size_t)nxt.pn * tstep + kofn : cB;
#pragma unroll 1
        for (int t = 0; t < ntc; t += 2) {
            const bool last = (t == ntc - 2);
            const char* a1 = cA + (size_t)(t + 1) * kstep;
            const char* a2 = last ? nA : cA + (size_t)(t + 2) * kstep; const char* b2 = last ? nB : cB + (size_t)(t + 2) * kstep;
            const char* a3 = a2 + kstep; const char* b3 = b2 + kstep;
            if constexpr (GATHER) { if (last && has_next) { PG8_GCVT(gofN); } }
            if constexpr (Epi::MID) { if (t == nt / 2) E.mid(acc, cur, wr, wc, fr, fq); }
            const size_t k1 = (size_t)(t + 1) * kstep, k2 = last ? (size_t)0 : (size_t)(t + 2) * kstep, k3 = k2 + kstep; const bool nx = last && has_next;
            if constexpr (SP2) {
            const bool post = (t == 0) && (ui > 0);
            PG8_LDB(B0, 0, 0); PG8_LDB(B1, 0, 1); PG8_SCHED; PG8_LDA(At, 0, 0); PG8_STAGE_A(PG8_SA(1, 1), a1, 1, k1, false);
            PG8_WAIT_V8P(post); PG8_WAIT_L(0); PG8_BAR; PG8_MMA(0, 0, At, B0); PG8_MMA(0, 1, At, B1); PG8_BAR; PG8_SCHED;
            PG8_LDA(At, 0, 1); PG8_STAGE(PG8_SB(0, 0), b2, voffB); PG8_STAGE(PG8_SB(0, 1), b2 + hstep, voffB); PG8_STAGE_A(PG8_SA(0, 0), a2, 0, k2, nx);
            PG8_WAIT_V8P(post); PG8_WAIT_L(0); PG8_BAR; PG8_MMA(1, 0, At, B0); PG8_MMA(1, 1, At, B1); PG8_BAR; PG8_SCHED;
            PG8_LDB(B0, 1, 0); PG8_LDB(B1, 1, 1); PG8_SCHED; PG8_LDA(At, 1, 0); PG8_STAGE_A(PG8_SA(0, 1), a2, 1, k2, nx);
            PG8_WAIT_V(8); PG8_WAIT_L(0); PG8_BAR; PG8_MMA(0, 0, At, B0); PG8_MMA(0, 1, At, B1); PG8_BAR; PG8_SCHED;
            PG8_LDA(At, 1, 1); PG8_STAGE(PG8_SB(1, 0), b3, voffB); PG8_STAGE(PG8_SB(1, 1), b3 + hstep, voffB); PG8_STAGE_A(PG8_SA(1, 0), a3, 0, k3, nx);
            PG8_WAIT_V(8); PG8_WAIT_L(0); PG8_BAR; PG8_MMA(1, 0, At, B0); PG8_MMA(1, 1, At, B1); PG8_BAR; PG8_SCHED;
            } else {
            static_assert(!GATHER || SP2, "GATHER is wired into the SP2 loop only");
            PG8_LDB(B0, 0, 0); PG8_SCHED; PG8_LDA(At, 0, 0); PG8_STAGE(PG8_SA(1, 1), a1 + hstep, voffA);
            PG8_WAIT_L(8); PG8_BAR; PG8_WAIT_L(0); PG8_MMA(0, 0, At, B0); PG8_BAR; PG8_SCHED;
            PG8_LDB(B1, 0, 1); PG8_STAGE(PG8_SB(0, 0), b2, voffB);
            PG8_BAR; PG8_WAIT_L(0); PG8_MMA(0, 1, At, B1); PG8_BAR;
            PG8_LDA(At, 0, 1); PG8_STAGE(PG8_SA(0, 0), a2, voffA);
            PG8_BAR; PG8_WAIT_L(0); PG8_MMA(1, 0, At, B0); PG8_BAR; PG8_SCHED;
            PG8_STAGE(PG8_SB(0, 1), b2 + hstep, voffB);
            PG8_WAIT_V(6); PG8_BAR; PG8_MMA(1, 1, At, B1); PG8_BAR;
            PG8_LDB(B0, 1, 0); PG8_SCHED; PG8_LDA(At, 1, 0); PG8_STAGE(PG8_SA(0, 1), a2 + hstep, voffA);
            PG8_WAIT_L(8); PG8_BAR; PG8_WAIT_L(0); PG8_MMA(0, 0, At, B0); PG8_BAR; PG8_SCHED;
            PG8_LDB(B1, 1, 1); PG8_STAGE(PG8_SB(1, 0), b3, voffB);
            PG8_BAR; PG8_WAIT_L(0); PG8_MMA(0, 1, At, B1); PG8_BAR;
            PG8_LDA(At, 1, 1); PG8_STAGE(PG8_SA(1, 0), a3, voffA);
            PG8_BAR; PG8_WAIT_L(0); PG8_MMA(1, 0, At, B0); PG8_BAR; PG8_SCHED;
            PG8_STAGE(PG8_SB(1, 1), b3 + hstep, voffB);
            PG8_WAIT_V(6); PG8_BAR; PG8_MMA(1, 1, At, B1); PG8_BAR;
            }
        }
        if constexpr (ALIGN_EPI) { if (wr == 0) PG8_BAR; }
        if constexpr (F8) asm volatile("s_nop 15\n\ts_nop 15" ::: "memory");
        E(acc, cur, wr, wc, fr, fq);
        if (!has_next) break;
#pragma unroll
        for (int a = 0; a < 2; ++a)
#pragma unroll
            for (int b = 0; b < 2; ++b)
#pragma unroll
                for (int m = 0; m < 4; ++m)
#pragma unroll
                    for (int n = 0; n < 2; ++n) acc[a][b][m][n] = (f32x4){0.f, 0.f, 0.f, 0.f};
        cur = nxt; cA = nA; cB = nB; ++ui; if constexpr (SPLITK) ntc = cur.nt;
        if constexpr (GATHER) { _Pragma("unroll") for (int _h = 0; _h < 2; ++_h) _Pragma("unroll") for (int _i = 0; _i < 2; ++_i) gofC[_h][_i] = gofN[_h][_i]; }
        if constexpr (ALIGN_EPI) { if (wr == 1) PG8_BAR; }
    }
    PG8_WAIT_V(0);
    if constexpr (!ALIGN_EPI) { if (wr == 0) PG8_BAR; }
    PG8_BAR;
#undef PG8_SA
#undef PG8_SB
#undef PG8_STAGE
#undef PG8_STAGE_A
#undef PG8_GOF
#undef PG8_GTOK
#undef PG8_GCVT
#undef PG8_LDA
#undef PG8_LD32
#undef PG8_LDB
#undef PG8_MMA
#undef PG8_WAIT_V
#undef PG8_WAIT_L
#undef PG8_WAIT_V8P
#undef PG8_BAR
#undef PG8_SCHED
}

#define EPI_ROWS(...) _Pragma("unroll") for (int ai = 0; ai < 2; ++ai) _Pragma("unroll") for (int m = 0; m < 4; ++m) { const int row = row0 + ai * HALF + m * 16; \
        _Pragma("unroll") for (int bj = 0; bj < 2; ++bj) { const int c = bj * HALF + wc * 32 + 8 * fq; f32x4 v0 = acc[ai][bj][m][0], v1 = acc[ai][bj][m][1]; __VA_ARGS__ } }
__device__ __forceinline__ u32x4 pack8(f32x4 v0, f32x4 v1) { u32x4 w; w.x = cvt_pk_bf16(v0[0], v0[1]); w.y = cvt_pk_bf16(v0[2], v0[3]); w.z = cvt_pk_bf16(v1[0], v1[1]); w.w = cvt_pk_bf16(v1[2], v1[3]); return w; }

__device__ __forceinline__ float ssq8(f32x4 a, f32x4 b) { return (a[0] * a[0] + a[1] * a[1]) + (a[2] * a[2] + a[3] * a[3]) + (b[0] * b[0] + b[1] * b[1]) + (b[2] * b[2] + b[3] * b[3]); }
struct EpiInproj { static constexpr bool PERM = true; static constexpr bool MID = false; static constexpr int NS = 16;
    bf16_t *CQ, *CKV, *KM; float *SSQQ, *SSQKV, *FLOG; const float* ROPE; bf16_t *QF, *KF, *VF;
    __device__ __forceinline__ void operator()(const f32x4 (&acc)[2][2][4][2], const Unit& u, int wr, int wc, int fr, int fq_) const {
        int row0 = u.pm * BM + wr * 64 + fr, fq = fq_; asm volatile("" : "+v"(row0), "+v"(fq));
        if (u.pn == 0) {
#pragma unroll
            for (int ai = 0; ai < 2; ++ai)
#pragma unroll
                for (int m = 0; m < 4; ++m) { const int row = row0 + ai * HALF + m * 16; float ss = 0.f;
#pragma unroll
                    for (int bj = 0; bj < 2; ++bj) { const int c = bj * HALF + wc * 32 + 8 * fq; const f32x4 v0 = acc[ai][bj][m][0], v1 = acc[ai][bj][m][1];
                        *(u32x4*)(CQ + (size_t)row * 256 + c) = pack8(v0, v1); ss += ssq8(v0, v1); }
                    ss += __shfl_xor(ss, 16); ss += __shfl_xor(ss, 32);
                    if (fq == 0) SSQQ[(size_t)row * 4 + wc] = ss; }
        } else if (u.pn == 1) {
#pragma unroll
            for (int ai = 0; ai < 2; ++ai)
#pragma unroll
                for (int m = 0; m < 4; ++m) { const int row = row0 + ai * HALF + m * 16; const int c = wc * 32 + 8 * fq;
                    { const f32x4 v0 = acc[ai][0][m][0], v1 = acc[ai][0][m][1]; *(u32x4*)(CKV + (size_t)row * 128 + c) = pack8(v0, v1);
                      float ss = ssq8(v0, v1); ss += __shfl_xor(ss, 16); ss += __shfl_xor(ss, 32); if (fq == 0) SSQKV[(size_t)row * 4 + wc] = ss; }
                    const f32x4 v0 = acc[ai][1][m][0], v1 = acc[ai][1][m][1];
                    if (wc == 0) { const f32x4* rp = (const f32x4*)(ROPE + (size_t)row * 32 + 8 * fq); const f32x4 r0 = rp[0], r1 = rp[1]; f32x4 o0, o1;
                        o0[0] = v0[0] * r0[0] - v0[1] * r0[1]; o0[1] = v0[0] * r0[1] + v0[1] * r0[0]; o0[2] = v0[2] * r0[2] - v0[3] * r0[3]; o0[3] = v0[2] * r0[3] + v0[3] * r0[2];
                        o1[0] = v1[0] * r1[0] - v1[1] * r1[1]; o1[1] = v1[0] * r1[1] + v1[1] * r1[0]; o1[2] = v1[2] * r1[2] - v1[3] * r1[3]; o1[3] = v1[2] * r1[3] + v1[3] * r1[2];
                        const u32x4 w = pack8(o0, o1);
#pragma unroll
                        for (int h = 0; h < 8; ++h) *(u32x4*)(KM + kimg<12>(row, h, 64 + 8 * fq)) = w; }
                    else if (wc == 1 && fq == 0) { float* p = FLOG + (size_t)row * 8; *(f32x4*)p = v0; *(f32x4*)(p + 4) = v1; } }
        } else {
            const int grp = (u.pn >> 1) - 1, cb = (u.pn & 1) * 256;
            if (grp == 0)      { EPI_ROWS( const int cc = cb + c; v0 = v0 * C2F; v1 = v1 * C2F; *(u32x4*)(QF + (size_t)row * QF_P + (cc >> 6) * 80 + (cc & 63)) = pack8(v0, v1); ) }
            else if (grp == 1) { EPI_ROWS( const int cc = cb + c; *(u32x4*)(KF + kimg<10>(row, cc >> 6, cc & 63)) = pack8(v0, v1); ) }
            else               { EPI_ROWS( const int cc = cb + c; *(u32x4*)(VF + vimg(row, cc >> 6, cc & 63)) = pack8(v0, v1); ) }
        }
    }
};
struct EpiQ { static constexpr bool PERM = true; static constexpr bool MID = false; static constexpr int NS = 16;
    bf16_t* QM; const float* ROPE; const float* SSQ;
    __device__ __forceinline__ float rs(int row) const { const f32x4 p = *(const f32x4*)(SSQ + (size_t)row * 4); return C2M / sqrtf(((p[0] + p[1]) + (p[2] + p[3])) * (1.f / 256.f) + EPS); }
    __device__ __forceinline__ void operator()(const f32x4 (&acc)[2][2][4][2], const Unit& u, int wr, int wc, int fr, int fq) const {
        const int row0 = u.pm * BM + wr * 64 + fr;
        if (u.pn < 2) {
            EPI_ROWS( const int cc = u.pn * 256 + c; const float C2M = rs(row); v0 = v0 * C2M; v1 = v1 * C2M; *(u32x4*)(QM + (size_t)row * QM_P + (cc >> 6) * 96 + (cc & 63)) = pack8(v0, v1); )
        } else {
            EPI_ROWS( const int h = c >> 5, p0 = c & 31; const float C2M = rs(row); const f32x4* rp = (const f32x4*)(ROPE + (size_t)row * 32 + p0);
                const f32x4 r0 = rp[0], r1 = rp[1]; f32x4 o0, o1;
                o0[0] = v0[0] * r0[0] - v0[1] * r0[1]; o0[1] = v0[0] * r0[1] + v0[1] * r0[0]; o0[2] = v0[2] * r0[2] - v0[3] * r0[3]; o0[3] = v0[2] * r0[3] + v0[3] * r0[2];
                o1[0] = v1[0] * r1[0] - v1[1] * r1[1]; o1[1] = v1[0] * r1[1] + v1[1] * r1[0]; o1[2] = v1[2] * r1[2] - v1[3] * r1[3]; o1[3] = v1[2] * r1[3] + v1[3] * r1[2];
                o0 = o0 * C2M; o1 = o1 * C2M; *(u32x4*)(QM + (size_t)row * QM_P + h * 96 + 64 + p0) = pack8(o0, o1); )
        }
    }
};
struct EpiKV { static constexpr bool PERM = true; static constexpr bool MID = false; static constexpr int NS = 16;
    bf16_t *KM, *VM; const float* SSQ;
    __device__ __forceinline__ float rs(int row) const { const f32x4 p = *(const f32x4*)(SSQ + (size_t)row * 4); return 1.f / sqrtf(((p[0] + p[1]) + (p[2] + p[3])) * (1.f / 128.f) + EPS); }
    __device__ __forceinline__ void operator()(const f32x4 (&acc)[2][2][4][2], const Unit& u, int wr, int wc, int fr, int fq_) const {
        int row0 = u.pm * BM + wr * 64 + fr, fq = fq_; asm volatile("" : "+v"(row0), "+v"(fq));
        if (u.pn < 2) { EPI_ROWS( const int cc = u.pn * 256 + c; const float r = rs(row); v0 = v0 * r; v1 = v1 * r; *(u32x4*)(KM + kimg<12>(row, cc >> 6, cc & 63)) = pack8(v0, v1); ) }
        else          { EPI_ROWS( const int cc = (u.pn - 2) * 256 + c; const float r = rs(row); v0 = v0 * r; v1 = v1 * r; *(u32x4*)(VM + vimg(row, cc >> 6, cc & 63)) = pack8(v0, v1); ) }
    }
};
struct EpiResid { static constexpr bool PERM = true; static constexpr bool MID = false; static constexpr int NS = 0;
    const float* Xin; float* Xout; const float* gate  ; const float* rowscale; int rs_stride;
    __device__ __forceinline__ void operator()(const f32x4 (&acc)[2][2][4][2], const Unit& u, int wr, int wc, int fr, int fq) const {
        const int row0 = u.pm * BM + wr * 64 + fr; const int b = (u.pm * BM) >> 12;
        const float* gp = gate + (size_t)b * 6144 + u.pn * 256;
        EPI_ROWS( const f32x4 g0 = *(const f32x4*)(gp + c), g1 = *(const f32x4*)(gp + c + 4); const size_t off = (size_t)row * DM + u.pn * 256 + c;
            float rs = 1.f; if (rowscale) rs = rowscale[(size_t)row * rs_stride];
            const f32x4 x0 = *(const f32x4*)(Xin + off), x1 = *(const f32x4*)(Xin + off + 4);
            *(f32x4*)(Xout + off) = x0 + g0 * (v0 * rs); *(f32x4*)(Xout + off + 4) = x1 + g1 * (v1 * rs); )
    }
};
struct EpiSwiglu { static constexpr bool PERM = true; static constexpr bool MID = false; static constexpr int NS = 8;
    bf16_t* H;
    __device__ __forceinline__ void operator()(const f32x4 (&acc)[2][2][4][2], const Unit& u, int wr, int wc, int fr, int fq) const {
        const int row0 = u.pm * BM + wr * 64 + fr;
#pragma unroll
        for (int ai = 0; ai < 2; ++ai)
#pragma unroll
            for (int m = 0; m < 4; ++m) { const int row = row0 + ai * HALF + m * 16; f32x4 h[2];
#pragma unroll
                for (int n = 0; n < 2; ++n) { const f32x4 gv = acc[ai][0][m][n], uv = acc[ai][1][m][n];
#pragma unroll
                    for (int j = 0; j < 4; ++j) { const float e = __builtin_amdgcn_exp2f(-gv[j] * LOG2E); h[n][j] = gv[j] * __builtin_amdgcn_rcpf(1.f + e) * uv[j]; } }
                *(u32x4*)(H + (size_t)row * FF + u.pn * 128 + wc * 32 + 8 * fq) = pack8(h[0], h[1]); }
    }
};
struct EpiBf16Plain { static constexpr bool PERM = true; static constexpr bool MID = false; static constexpr int NS = 16; static constexpr int SCL0 = 0x7F7F7F7F, SCL1 = 0x7F7F7F7F;
    bf16_t* O; int ldc; float scale;
    __device__ __forceinline__ void operator()(const f32x4 (&acc)[2][2][4][2], const Unit& u, int wr, int wc, int fr, int fq) const {
        const int row0 = u.pm * BM + wr * 64 + fr;
        EPI_ROWS( v0 = v0 * scale; v1 = v1 * scale; *(u32x4*)(O + (size_t)row * ldc + u.pn * 256 + c) = pack8(v0, v1); )
    }
};
struct EpiWo { static constexpr bool PERM = true; static constexpr bool MID = true; static constexpr int NS = 16;
    bf16_t* O; const float* SSQ;
    __device__ __forceinline__ void sums(int row, float& s1, float& s2) const { const f32x4* p = (const f32x4*)(SSQ + (size_t)row * 16); const f32x4 a = p[0], b = p[1], c = p[2], d = p[3];
        s1 = ((a[0] + a[1]) + (a[2] + a[3])) + ((b[0] + b[1]) + (b[2] + b[3])); s2 = ((c[0] + c[1]) + (c[2] + c[3])) + ((d[0] + d[1]) + (d[2] + d[3])); }
    __device__ __forceinline__ void mid(f32x4 (&acc)[2][2][4][2], const Unit& u, int wr, int wc, int fr, int fq) const {
        int row0 = u.pm * BM + wr * 64 + fr; asm volatile("" : "+v"(row0));
#pragma unroll
        for (int ai = 0; ai < 2; ++ai)
#pragma unroll
            for (int m = 0; m < 4; ++m) { float s1, s2; sums(row0 + ai * HALF + m * 16, s1, s2); const float ratio = sqrtf((s2 * (1.f / 512.f) + EPS) / (s1 * (1.f / 512.f) + EPS));
#pragma unroll
                for (int bj = 0; bj < 2; ++bj)
#pragma unroll
                    for (int n = 0; n < 2; ++n) acc[ai][bj][m][n] = acc[ai][bj][m][n] * ratio;
                asm volatile("" : "+v"(acc[ai][0][m][0]), "+v"(acc[ai][0][m][1]), "+v"(acc[ai][1][m][0]), "+v"(acc[ai][1][m][1]) :: "memory"); }
    }
    __device__ __forceinline__ void operator()(const f32x4 (&acc)[2][2][4][2], const Unit& u, int wr, int wc, int fr, int fq) const {
        int row0 = u.pm * BM + wr * 64 + fr; asm volatile("" : "+v"(row0));
#pragma unroll
        for (int ai = 0; ai < 2; ++ai)
#pragma unroll
            for (int m = 0; m < 4; ++m) { const int row = row0 + ai * HALF + m * 16; float s1, s2; sums(row, s1, s2); const float r2 = 1.f / sqrtf(s2 * (1.f / 512.f) + EPS);
#pragma unroll
                for (int bj = 0; bj < 2; ++bj) { const int c = bj * HALF + wc * 32 + 8 * fq; *(u32x4*)(O + (size_t)row * DM + u.pn * 256 + c) = pack8(acc[ai][bj][m][0] * r2, acc[ai][bj][m][1] * r2); } }
    }
};
struct EpiSwigluF8 { static constexpr bool PERM = true; static constexpr bool MID = false; static constexpr int NS = 8; static constexpr int SCL0 = 0x7A7A7A7A, SCL1 = 0x7C7C7C7C;
    unsigned char* H;
    __device__ __forceinline__ void operator()(const f32x4 (&acc)[2][2][4][2], const Unit& u, int wr, int wc, int fr, int fq) const {
        const int row0 = u.pm * BM + wr * 64 + fr;
#pragma unroll
        for (int ai = 0; ai < 2; ++ai)
#pragma unroll
            for (int m = 0; m < 4; ++m) { const int row = row0 + ai * HALF + m * 16; float h[8];
#pragma unroll
                for (int n = 0; n < 2; ++n) { const f32x4 ga = acc[ai][0][m][n], ua = acc[ai][1][m][n];
#pragma unroll
                    for (int j = 0; j < 4; ++j) { const float e = __builtin_amdgcn_exp2f(ga[j]); const float hv = (ga[j] * ua[j]) * __builtin_amdgcn_rcpf(1.f + e);
                        h[4 * n + j] = __builtin_amdgcn_fmed3f(hv, -448.f, 448.f); } }
                int w0 = 0, w1 = 0;
                w0 = __builtin_amdgcn_cvt_pk_fp8_f32(h[0], h[1], w0, false); w0 = __builtin_amdgcn_cvt_pk_fp8_f32(h[2], h[3], w0, true);
                w1 = __builtin_amdgcn_cvt_pk_fp8_f32(h[4], h[5], w1, false); w1 = __builtin_amdgcn_cvt_pk_fp8_f32(h[6], h[7], w1, true);
                *(v2u*)(H + (size_t)row * FF + u.pn * 128 + wc * 32 + 8 * fq) = (v2u){(unsigned)w0, (unsigned)w1}; }
    }
};
struct MoeOrder : StaticOrder {
    int tend[8];
    __device__ __forceinline__ void load(const int* texp) {
#pragma unroll
        for (int e = 0; e < 8; ++e) tend[e] = __builtin_amdgcn_readfirstlane(texp[1 + e]); }
    __device__ __forceinline__ bool next(int i, Unit& u) const { if (!StaticOrder::next(i, u)) return false; int b = 0;
#pragma unroll
        for (int e = 0; e < 7; ++e) b += (u.pm >= tend[e]) ? 1 : 0;
        u.bsel = b; return true; }
};
struct EpiMoeDown { static constexpr bool PERM = true; static constexpr bool MID = false; static constexpr int NS = 0;
    float* X; const float* gate; const int* rowtok; const float* roww; float oscale;
    __device__ __forceinline__ void operator()(const f32x4 (&acc)[2][2][4][2], const Unit& u, int wr, int wc, int fr, int fq) const {
        const int row0 = u.pm * BM + wr * 64 + fr;
#pragma unroll
        for (int ai = 0; ai < 2; ++ai)
#pragma unroll
            for (int m = 0; m < 4; ++m) { const int slot = row0 + ai * HALF + m * 16; const int tok = rowtok[slot];
                if (tok >= 0) { const float w = roww[slot] * oscale; const float* gp = gate + (size_t)(tok >> 12) * 6144 + u.pn * 256; float* xp = X + (size_t)tok * DM + u.pn * 256;
#pragma unroll
                    for (int bj = 0; bj < 2; ++bj) { const int c = bj * HALF + wc * 32 + 8 * fq; const f32x4 v0 = acc[ai][bj][m][0], v1 = acc[ai][bj][m][1];
                        const f32x4 g0 = *(const f32x4*)(gp + c), g1 = *(const f32x4*)(gp + c + 4); const f32x4 x0 = *(const f32x4*)(xp + c), x1 = *(const f32x4*)(xp + c + 4);
                        *(f32x4*)(xp + c) = x0 + g0 * (v0 * w); *(f32x4*)(xp + c + 4) = x1 + g1 * (v1 * w); } } }
    }
};
struct MoeOrderD : MoeOrder {
    int mainU, mainM, tailSub, S, NT;
    __device__ __forceinline__ void init_d(int ntile, int NT_, int G_, int c_) {
        NT = NT_; const int per = G_ / 4; int tailM = (G_ % 4 == 0) ? ntile % per : 0; const int U = 4 * tailM;
        S = (7 * U <= G_ && NT_ % 14 == 0) ? 7 : ((2 * U <= G_ && NT_ % 4 == 0) ? 2 : 1); if (S == 1) tailM = 0;
        mainM = ntile - tailM; mainU = 4 * mainM; tailSub = 4 * tailM * S;
        StaticOrder::init(mainM * BM, 4 * BM, G_, c_); }
    __device__ __forceinline__ bool next(int i, Unit& u) const {
        const long L = (long)i * G + c;
        if (L < mainU) { StaticOrder::next(i, u); u.nt = NT; }
        else { const int j = (int)(L - mainU); if (j >= tailSub) return false;
            const int uu = j / S; u.part = j - uu * S; u.pm = mainM + (uu >> 2); u.pn = uu & 3; u.nt = NT / S; }
        int b = 0;
#pragma unroll
        for (int e = 0; e < 7; ++e) b += (u.pm >= tend[e]) ? 1 : 0;
        u.bsel = b; return true; }
};
struct EpiMoeY { static constexpr bool PERM = true; static constexpr bool MID = false; static constexpr int NS = 16; static constexpr int SCL0 = 0x7F7F7F7F, SCL1 = 0x7F7F7F7F;
    bf16_t* Y; bf16_t* Yp; int tail0; size_t pstride; float scale;
    __device__ __forceinline__ void operator()(const f32x4 (&acc)[2][2][4][2], const Unit& u, int wr, int wc, int fr, int fq) const {
        const int row0 = u.pm * BM + wr * 64 + fr;
        bf16_t* O = (u.part == 0) ? Y : Yp + (size_t)(u.part - 1) * pstride - (size_t)tail0 * DM;
        EPI_ROWS( v0 = v0 * scale; v1 = v1 * scale; *(u32x4*)(O + (size_t)row * DM + u.pn * 256 + c) = pack8(v0, v1); )
    }
};
}

#define XB_TMO      128
#define XB_XCNT(j)  (256  + 64 * (j))
#define XB_XSUB(j)  (1280 + 64 * (j))
#define XB_XGEN(j)  (2304 + 64 * (j))
#define XB_TOP      3328
#define XB_TOPGEN   3392
#define XCD_BAR_WORDS 3456
#define XB_SPIN_CAP (1u << 22)

__device__ __forceinline__ unsigned xb_ld(unsigned* p)              { return __hip_atomic_load(p, __ATOMIC_RELAXED, __HIP_MEMORY_SCOPE_AGENT); }
__device__ __forceinline__ unsigned xb_add(unsigned* p, unsigned v) { return __hip_atomic_fetch_add(p, v, __ATOMIC_RELAXED, __HIP_MEMORY_SCOPE_AGENT); }
__device__ __forceinline__ unsigned xb_xcc_id() { return (unsigned)__builtin_amdgcn_s_getreg((3 << 11) | 20) & 0xFu; }
#define XB_SPIN(cond, bar) do { unsigned _sp = 0; while (cond) { __builtin_amdgcn_s_sleep(1); \
    if ((++_sp & 255u) == 0u) { if (xb_ld(&(bar)[XB_TMO])) break; if (_sp > XB_SPIN_CAP) { atomicAdd(&(bar)[XB_TMO], 1u); break; } } } } while (0)

struct XcdBarrier { unsigned* bar; unsigned x; volatile LAS unsigned* st; };

__device__ __forceinline__ XcdBarrier xcd_barrier_post(unsigned* bar, volatile LAS unsigned* st) {
    XcdBarrier b; b.bar = bar; b.x = xb_xcc_id(); b.st = st;
    if (threadIdx.x == 0) (void)xb_add(&bar[XB_XCNT(b.x)], 1u);
    return b;
}
__device__ __forceinline__ void xcd_barrier_complete(unsigned* bar, unsigned x, unsigned& nloc, unsigned& nx) {
    const unsigned G = gridDim.x * gridDim.y * gridDim.z;
    unsigned sum, cnt, mine, sp = 0u;
    for (;;) {
        sum = 0u; cnt = 0u; mine = 0u;
#pragma unroll
        for (unsigned j = 0; j < 16; ++j) { const unsigned c = xb_ld(&bar[XB_XCNT(j)]); sum += c; cnt += (c > 0u) ? 1u : 0u; mine = (j == x) ? c : mine; }
        if (sum == G) break;
        __builtin_amdgcn_s_sleep(1);
        if ((++sp & 255u) == 0u) { if (xb_ld(&bar[XB_TMO])) break; if (sp > XB_SPIN_CAP) { atomicAdd(&bar[XB_TMO], 1u); break; } }
    }
    nloc = mine > 0u ? mine : 1u; nx = cnt > 0u ? cnt : 1u;
}
__device__ __forceinline__ void xcd_barrier(const XcdBarrier& b) {
    asm volatile("s_waitcnt vmcnt(0)" ::: "memory");
    __syncthreads();
    if (threadIdx.x == 0) {
        unsigned* bar = b.bar;
        __builtin_amdgcn_s_waitcnt(0);
        unsigned nloc = b.st[0], nx = b.st[1];
        if (nloc == 0u) { xcd_barrier_complete(bar, b.x, nloc, nx); b.st[0] = nloc; b.st[1] = nx; }
        const unsigned old = xb_add(&bar[XB_XSUB(b.x)], 1u);
        const unsigned gen = old / nloc;
        if (old + 1u == (gen + 1u) * nloc) {
            __builtin_amdgcn_fence(__ATOMIC_RELEASE, "agent");
            asm volatile("s_waitcnt vmcnt(0)" ::: "memory");
            const unsigned og = xb_add(&bar[XB_TOP], 1u);
            const unsigned tg = og / nx;
            if (og + 1u == (tg + 1u) * nx) xb_add(&bar[XB_TOPGEN], 1u);
            else XB_SPIN(xb_ld(&bar[XB_TOPGEN]) == tg, bar);
            __builtin_amdgcn_fence(__ATOMIC_ACQUIRE, "agent");
            xb_add(&bar[XB_XGEN(b.x)], 1u);
            asm volatile("s_waitcnt vmcnt(0)" ::: "memory");
        } else {
            XB_SPIN(xb_ld(&bar[XB_XGEN(b.x)]) == gen, bar);
            __builtin_amdgcn_fence(__ATOMIC_ACQUIRE, "agent");
            asm volatile("s_waitcnt vmcnt(0)" ::: "memory");
        }
    }
    __syncthreads();
}

struct Args {
    const float* in[24]; float* out; unsigned char* ws; int ph_lo, ph_hi;
};
struct Frame {
    LAS unsigned char* lds;
    int tid, lane, wave, vcu, G;
    unsigned char* ws;
};

template <class Src>
__device__ __forceinline__ void conv_item(const Src& src, int Ksrc, int Kpad, bf16* WT, LAS float* scr, int item, int lane, int nblk) {
    const int kb = item / nblk, nb = item % nblk, k0 = 64 * kb, n0 = 32 * nb;
    const float* colp = src(n0 + (lane & 31)); const int ld = src.ld;
#pragma unroll 8
    for (int i = 0; i < 32; ++i) { const int kk = 2 * i + (lane >> 5), k = k0 + kk; float v = 0.f; if (colp != nullptr && k < Ksrc) v = colp[(size_t)k * ld] * src.ksc(k); scr[kk * 33 + (lane & 31)] = v; }
    LDS_WAIT(); asm volatile("" ::: "memory");
    const int c = lane & 7;
#pragma unroll
    for (int j = 0; j < 4; ++j) { const int n = (lane >> 3) + 8 * j; const LAS float* s = scr + (8 * c) * 33 + n;
        v4u o; o.x = pk2(s[0 * 33], s[1 * 33]); o.y = pk2(s[2 * 33], s[3 * 33]); o.z = pk2(s[4 * 33], s[5 * 33]); o.w = pk2(s[6 * 33], s[7 * 33]);
        *(GAS v4u*)(WT + (size_t)(n0 + n) * Kpad + k0 + 8 * c) = o; }
    LDS_WAIT(); asm volatile("" ::: "memory");
}
template <class Src>
__device__ __forceinline__ void conv_matrix(Frame& F, const Src& src, int Ksrc, int Kpad, int Nout, bf16* WT, int rot = 0) {
    LAS float* scr = (LAS float*)(F.lds + F.wave * 16384);
    const int gw = F.vcu * NWAVES + F.wave, NGW = F.G * NWAVES, nblk = Nout / 32, nitems = (Kpad / 64) * nblk;
    for (int it = (gw + NGW - rot % NGW) % NGW; it < nitems; it += NGW) conv_item(src, Ksrc, Kpad, WT, scr, it, F.lane, nblk);
}
template <class Src>
__device__ __forceinline__ void conv_item64(const Src& src, int Ksrc, int Kpad, bf16* WT, LAS unsigned short* scr, int item, int lane, int nblk) {
    const int kb = item / nblk, nb = item % nblk, k0 = 64 * kb, n0 = 64 * nb;
    const int nn = (lane & 15) * 4, kq = lane >> 4;
    const float* colp = src(n0 + nn); const int ld = src.ld;
    f32x4 v[16];
#pragma unroll
    for (int i = 0; i < 16; ++i) { const int k = k0 + 4 * i + kq; v[i] = (k < Ksrc) ? *(const f32x4*)(colp + (size_t)k * ld) : (f32x4){0.f, 0.f, 0.f, 0.f}; }
#pragma unroll
    for (int i = 0; i < 16; ++i) { LAS unsigned* d = (LAS unsigned*)(scr + (4 * i + kq) * 66 + nn); d[0] = pk2(v[i].x, v[i].y); d[1] = pk2(v[i].z, v[i].w); }
    LDS_WAIT(); asm volatile("" ::: "memory");
    const int c = lane & 7;
#pragma unroll
    for (int j = 0; j < 8; ++j) { const int n = (lane >> 3) + 8 * j; const LAS unsigned short* sp = scr + (8 * c) * 66 + n;
        v4u o; o.x = (unsigned)sp[0 * 66] | ((unsigned)sp[1 * 66] << 16); o.y = (unsigned)sp[2 * 66] | ((unsigned)sp[3 * 66] << 16);
        o.z = (unsigned)sp[4 * 66] | ((unsigned)sp[5 * 66] << 16); o.w = (unsigned)sp[6 * 66] | ((unsigned)sp[7 * 66] << 16);
        *(GAS v4u*)(WT + (size_t)(n0 + n) * Kpad + k0 + 8 * c) = o; }
    LDS_WAIT(); asm volatile("" ::: "memory");
}
template <class Src>
__device__ __forceinline__ void conv_matrix64(Frame& F, const Src& src, int Ksrc, int Kpad, int Nout, bf16* WT) {
    LAS unsigned short* scr = (LAS unsigned short*)(F.lds + F.wave * 16384);
    const int gw = F.vcu * NWAVES + F.wave, NGW = F.G * NWAVES, nblk = Nout / 64, nitems = (Kpad / 64) * nblk;
    for (int it = gw; it < nitems; it += NGW) conv_item64(src, Ksrc, Kpad, WT, scr, it, F.lane, nblk);
}
template <class Src>
__device__ __forceinline__ void conv_item_f8(const Src& src, int Ksrc, int Kpad, unsigned char* WT, LAS unsigned* scr, int item, int lane, int nblk, float sc) {
    const int kb = item / nblk, nb = item % nblk, k0 = 128 * kb, n0 = 64 * nb;
    const int nn = (lane & 15) * 4, kq4 = lane >> 4;
    const float* colp = src(n0 + nn); const int ld = src.ld;
#pragma unroll 2
    for (int i = 0; i < 8; ++i) { const int kq = 4 * i + kq4, k = k0 + 4 * kq; f32x4 r[4];
#pragma unroll
        for (int q = 0; q < 4; ++q) r[q] = (k + q < Ksrc) ? *(const f32x4*)(colp + (size_t)(k + q) * ld) : (f32x4){0.f, 0.f, 0.f, 0.f};
#pragma unroll
        for (int j = 0; j < 4; ++j) { int w = 0; w = __builtin_amdgcn_cvt_pk_fp8_f32(r[0][j] * sc, r[1][j] * sc, w, false); w = __builtin_amdgcn_cvt_pk_fp8_f32(r[2][j] * sc, r[3][j] * sc, w, true); scr[kq * 65 + nn + j] = (unsigned)w; } }
    LDS_WAIT(); asm volatile("" ::: "memory");
    const int c = lane & 7;
#pragma unroll
    for (int j = 0; j < 8; ++j) { const int n = (lane >> 3) + 8 * j; const LAS unsigned* sp = scr + (4 * c) * 65 + n;
        v4u o; o.x = sp[0]; o.y = sp[65]; o.z = sp[130]; o.w = sp[195];
        *(GAS v4u*)(WT + (size_t)(n0 + n) * Kpad + k0 + 16 * c) = o; }
    LDS_WAIT(); asm volatile("" ::: "memory");
}
template <class Src>
__device__ __forceinline__ void conv_matrix_f8(Frame& F, const Src& src, int Ksrc, int Kpad, int Nout, unsigned char* WT, float sc) {
    LAS unsigned* scr = (LAS unsigned*)(F.lds + F.wave * 16384);
    const int gw = F.vcu * NWAVES + F.wave, NGW = F.G * NWAVES, nblk = Nout / 64, nitems = (Kpad / 128) * nblk;
    for (int it = gw; it < nitems; it += NGW) conv_item_f8(src, Ksrc, Kpad, WT, scr, it, F.lane, nblk, sc);
}
template <class Src, bool F8>
__device__ __forceinline__ void conv_matrix_wg(Frame& F, const Src& src, int Ksrc, int Kpad, int Nout, unsigned char* WT, float sc, int rot = 0) {
    constexpr int KT = F8 ? 128 : 64, RW = KT / 8;
    LAS unsigned short* l16 = (LAS unsigned short*)F.lds; LAS unsigned* l32 = (LAS unsigned*)F.lds;
    const int nblk = Nout / 256, nitems = (Kpad / KT) * nblk, ld = src.ld;
    for (int it = (F.vcu + F.G - rot % F.G) % F.G; it < nitems; it += F.G) {
        const int kb = it / nblk, nb = it % nblk, k0 = KT * kb, n0 = 256 * nb;
        const float* colp = src(n0 + 4 * F.lane); const float scn = sc * src.nsc(n0 + 4 * F.lane);
        f32x4 r[RW];
#pragma unroll
        for (int j = 0; j < RW; ++j) { const int k = k0 + F.wave * RW + j; r[j] = (k < Ksrc) ? *(const f32x4*)(colp + (size_t)k * ld) * src.ksc(k) : (f32x4){0.f, 0.f, 0.f, 0.f}; }
        if constexpr (F8) {
#pragma unroll
            for (int q4 = 0; q4 < RW / 4; ++q4) { const int kq = F.wave * (RW / 4) + q4;
#pragma unroll
                for (int j = 0; j < 4; ++j) { int w = 0; w = __builtin_amdgcn_cvt_pk_fp8_f32(r[4 * q4][j] * scn, r[4 * q4 + 1][j] * scn, w, false); w = __builtin_amdgcn_cvt_pk_fp8_f32(r[4 * q4 + 2][j] * scn, r[4 * q4 + 3][j] * scn, w, true);
                    l32[kq * 257 + 4 * F.lane + j] = (unsigned)w; } }
        } else {
#pragma unroll
            for (int j = 0; j < RW; ++j) { const int kk = F.wave * RW + j; LAS unsigned* d = (LAS unsigned*)(l16 + kk * 258 + 4 * F.lane); d[0] = pk2(r[j].x, r[j].y); d[1] = pk2(r[j].z, r[j].w); }
        }
        __syncthreads();
#pragma unroll
        for (int j = 0; j < 4; ++j) { const int task = F.tid + 512 * j, rr = task >> 3, c = task & 7; v4u o;
            if constexpr (F8) { const LAS unsigned* sp = l32 + (4 * c) * 257 + rr; o.x = sp[0]; o.y = sp[257]; o.z = sp[514]; o.w = sp[771];
                *(GAS v4u*)(WT + (size_t)(n0 + rr) * Kpad + k0 + 16 * c) = o; }
            else { const LAS unsigned short* sp = l16 + (8 * c) * 258 + rr;
                o.x = (unsigned)sp[0] | ((unsigned)sp[258] << 16); o.y = (unsigned)sp[2 * 258] | ((unsigned)sp[3 * 258] << 16); o.z = (unsigned)sp[4 * 258] | ((unsigned)sp[5 * 258] << 16); o.w = (unsigned)sp[6 * 258] | ((unsigned)sp[7 * 258] << 16);
                *(GAS v4u*)(WT + ((size_t)(n0 + rr) * Kpad + k0 + 8 * c) * 2) = o; }
        }
        __syncthreads();
    }
}
struct SrcPlain { const float* W; int ld; __device__ __forceinline__ const float* operator()(int n) const { return W + n; } __device__ __forceinline__ float ksc(int) const { return 1.f; } __device__ __forceinline__ float nsc(int) const { return 1.f; } };
struct SrcPlainG { const float* W; int ld; const float* g1; const float* g2;
    __device__ __forceinline__ const float* operator()(int n) const { return W + n; } __device__ __forceinline__ float ksc(int k) const { return k < 512 ? g1[k] : g2[k - 512]; } __device__ __forceinline__ float nsc(int) const { return 1.f; } };
struct SrcWin { const float* W; int ld;
    __device__ __forceinline__ float ksc(int) const { return 1.f; }
    __device__ __forceinline__ const float* operator()(int n) const {
        int s;
        if (n < 384) s = n;
        else if (n < 416) { const int p = n - 384; s = 384 + (p >> 1) + 16 * (p & 1); }
        else if (n < 424) s = 1952 + (n - 416);
        else if (n < 512) return nullptr;
        else if (n < 1024) s = 416 + (n - 512);
        else if (n < 1536) s = 928 + (n - 1024);
        else s = 1440 + (n - 1536);
        return W + s; } };
struct SrcWuq { const float* W; int ld; const float* g;
    __device__ __forceinline__ float ksc(int k) const { return g[k]; }
    __device__ __forceinline__ const float* operator()(int n) const {
        int s;
        if (n < 512) s = (n >> 6) * 96 + (n & 63);
        else { const int r = n - 512, h = r >> 5, p = r & 31; s = h * 96 + 64 + (p >> 1) + 16 * (p & 1); }
        return W + s; } };
struct SrcWukv { const float* W; int ld; const float* g;
    __device__ __forceinline__ float ksc(int k) const { return g[k]; }
    __device__ __forceinline__ const float* operator()(int n) const {
        int s;
        if (n < 512) s = (n >> 6) * 128 + (n & 63);
        else { const int r = n - 512; s = (r >> 6) * 128 + 64 + (r & 63); }
        return W + s; } };
struct SrcGU { const float* Wg; const float* Wu; int ld;
    __device__ __forceinline__ float ksc(int) const { return 1.f; }
    __device__ __forceinline__ float nsc(int n) const { return ((n & 255) < 128) ? -LOG2E : -SC_H / (4.f * LOG2E); }
    __device__ __forceinline__ const float* operator()(int n) const { const int t = n >> 8, w = n & 255; return (w < 128) ? (Wg + t * 128 + w) : (Wu + t * 128 + (w - 128)); } };

__device__ __forceinline__ void mod_phase(Frame& F, const float* c, const float* ada_w, const float* ada_b, float* MOD) {
    LAS float* cact = (LAS float*)F.lds;
    LAS float* red = cact + 8 * 1024;
    for (int i = F.tid; i < 8 * 1024; i += NWAVES * 64) { const float v = c[i]; cact[i] = v / (1.f + __expf(-v)); }
    __syncthreads();
    for (int item = F.vcu; item < 192; item += F.G) {
        const int l = item / 96, j = (item % 96) * 64 + F.lane;
        const float* wp = ada_w + (size_t)l * 1024 * 6144 + j;
        float acc[8];
#pragma unroll
        for (int b = 0; b < 8; ++b) acc[b] = 0.f;
        const int kb = F.wave * 128;
#pragma unroll 4
        for (int k = kb; k < kb + 128; ++k) { const float w = wp[(size_t)k * 6144];
#pragma unroll
            for (int b = 0; b < 8; ++b) acc[b] += cact[b * 1024 + k] * w; }
#pragma unroll
        for (int b = 0; b < 8; ++b) red[(F.wave * 8 + b) * 64 + F.lane] = acc[b];
        __syncthreads();
        { const int b = F.wave; float s = ada_b[l * 6144 + j];
#pragma unroll
          for (int w = 0; w < 8; ++w) s += red[(w * 8 + b) * 64 + F.lane];
          MOD[((size_t)l * 8 + b) * 6144 + j] = s; }
        __syncthreads();
    }
}

template <bool ROUTER, bool RESID, bool F8OUT = ROUTER>
__device__ __forceinline__ void norm_phase(Frame& F, const float* X, const float* g, const float* modl  , int part  , bf16* XN,
                                           const float* router_w, int* TOKE, float* TOKW, unsigned* CNT, const bf16* T, const float* rgate  , float* Xout) {
    const int gw = F.vcu * NWAVES + F.wave, NGW = F.G * NWAVES;
    if constexpr (ROUTER) { if (F.tid < 16) ((LAS unsigned*)(F.lds + LCNT_OFF))[F.tid] = 0u; __syncthreads(); }
    f32x4 gv[4];
#pragma unroll
    for (int j = 0; j < 4; ++j) gv[j] = *(const f32x4*)(g + 4 * F.lane + 256 * j);
    f32x4 vn[4]; v2u tn[4];
#pragma unroll
    for (int j = 0; j < 4; ++j) { vn[j] = ((const f32x4*)(X + (size_t)gw * DM) + F.lane)[64 * j]; if constexpr (RESID) tn[j] = ((const v2u*)(T + (size_t)gw * DM) + F.lane)[64 * j]; }
    for (int m = gw; m < M; m += NGW) {
        const int b = m >> 12;
        const f32x4* sh = (const f32x4*)(modl + (size_t)b * 6144 + part * 1024) + F.lane;
        const f32x4* sc = (const f32x4*)(modl + (size_t)b * 6144 + (part + 1) * 1024) + F.lane;
        f32x4 v[4]; v2u tc[4]; float s = 0.f;
#pragma unroll
        for (int j = 0; j < 4; ++j) { v[j] = vn[j]; if constexpr (RESID) tc[j] = tn[j]; }
        { const int mn = (m + NGW < M) ? m + NGW : m;
#pragma unroll
          for (int j = 0; j < 4; ++j) { vn[j] = ((const f32x4*)(X + (size_t)mn * DM) + F.lane)[64 * j]; if constexpr (RESID) tn[j] = ((const v2u*)(T + (size_t)mn * DM) + F.lane)[64 * j]; } }
        if constexpr (RESID) {
            const f32x4* gr = (const f32x4*)(rgate + (size_t)b * 6144) + F.lane; f32x4* xo = (f32x4*)(Xout + (size_t)m * DM) + F.lane;
#pragma unroll
            for (int j = 0; j < 4; ++j) { const v2u t = tc[j]; const f32x4 gg = gr[64 * j];
                v[j].x += gg.x * bf2f(t.x & 0xffffu); v[j].y += gg.y * bf2f(t.x >> 16); v[j].z += gg.z * bf2f(t.y & 0xffffu); v[j].w += gg.w * bf2f(t.y >> 16); xo[64 * j] = v[j]; }
        }
#pragma unroll
        for (int j = 0; j < 4; ++j) s += (v[j].x * v[j].x + v[j].y * v[j].y) + (v[j].z * v[j].z + v[j].w * v[j].w);
        const float r = 1.f / sqrtf(wave_sum(s) * (1.f / DM) + EPS);
        v2u* o8 = (v2u*)(XN + (size_t)m * DM) + F.lane; unsigned* o4 = (unsigned*)((unsigned char*)XN + (size_t)m * DM) + F.lane;
#pragma unroll
        for (int j = 0; j < 4; ++j) { const f32x4 a = sh[64 * j], c1 = sc[64 * j]; v[j] = (v[j] * r) * gv[j]; v[j] = v[j] * (c1 + 1.f) + a;
            if constexpr (F8OUT) { int w = 0; w = __builtin_amdgcn_cvt_pk_fp8_f32(fminf(fmaxf(v[j].x, -448.f), 448.f), fminf(fmaxf(v[j].y, -448.f), 448.f), w, false);
                w = __builtin_amdgcn_cvt_pk_fp8_f32(fminf(fmaxf(v[j].z, -448.f), 448.f), fminf(fmaxf(v[j].w, -448.f), 448.f), w, true); o4[64 * j] = (unsigned)w; }
            else { v2u w; w.x = pk2(v[j].x, v[j].y); w.y = pk2(v[j].z, v[j].w); o8[64 * j] = w; } }
        if constexpr (ROUTER) {
            float lg[8];
#pragma unroll
            for (int e = 0; e < 8; ++e) lg[e] = 0.f;
#pragma unroll
            for (int j = 0; j < 4; ++j)
#pragma unroll
                for (int q = 0; q < 4; ++q) { const float* rw = router_w + (size_t)(4 * F.lane + 256 * j + q) * 8; const f32x4 w0 = *(const f32x4*)rw, w1 = *(const f32x4*)(rw + 4); const float hv = v[j][q];
                    lg[0] += hv * w0.x; lg[1] += hv * w0.y; lg[2] += hv * w0.z; lg[3] += hv * w0.w; lg[4] += hv * w1.x; lg[5] += hv * w1.y; lg[6] += hv * w1.z; lg[7] += hv * w1.w; }
#pragma unroll
            for (int e = 0; e < 8; ++e) lg[e] = wave_sum(lg[e]);
            int e0 = 0; float v0 = lg[0];
#pragma unroll
            for (int e = 1; e < 8; ++e) if (lg[e] > v0) { v0 = lg[e]; e0 = e; }
            int e1 = -1; float v1 = -INFINITY;
#pragma unroll
            for (int e = 0; e < 8; ++e) if (e != e0 && lg[e] > v1) { v1 = lg[e]; e1 = e; }
            const float w1 = 1.f / (1.f + __expf(v0 - v1)), w0 = 1.f - w1;
            if (F.lane == 0) { TOKE[m] = e0 | (e1 << 8); *(f32x2*)(TOKW + 2 * (size_t)m) = (f32x2){w0, w1};
                LAS unsigned* lc = (LAS unsigned*)(F.lds + LCNT_OFF);
                __hip_atomic_fetch_add(lc + e0, 1u, __ATOMIC_RELAXED, __HIP_MEMORY_SCOPE_WORKGROUP); __hip_atomic_fetch_add(lc + e1, 1u, __ATOMIC_RELAXED, __HIP_MEMORY_SCOPE_WORKGROUP); }
        }
    }
    if constexpr (ROUTER) { __syncthreads(); if (F.tid < 16) CNT[F.vcu * 16 + F.tid] = ((LAS unsigned*)(F.lds + LCNT_OFF))[F.tid]; }
}

__device__ __forceinline__ void rope_phase(Frame& F, const int* positions, float* ROPE) {
    const int gw = F.vcu * NWAVES + F.wave, NGW = F.G * NWAVES;
    const int i = F.lane & 15; const float invf = powf(10000.f, -(float)i / 16.f);
    for (int m4 = gw; m4 < M / 4; m4 += NGW) { const int m = 4 * m4 + (F.lane >> 4);
        const float ang = (float)positions[m] * invf; float sn, cs; sincosf(ang, &sn, &cs);
        *(f32x2*)(ROPE + (size_t)m * 32 + 2 * i) = (f32x2){cs, sn}; }
}
__device__ __forceinline__ float log_sigmoid(float x) { return fminf(x, 0.f) - log1pf(__expf(-fabsf(x))); }
__device__ __forceinline__ void scan_phase(Frame& F, const float* FLOG, const float* fb, bf16* QF, bf16* KF) {
    const int sc = (int)blockIdx.x - (F.G - 64);
    if (sc >= 0) {
        const int b = sc >> 3, h = sc & 7; const float bias = fb[h];
        const size_t m0 = (size_t)b * SEQ + 8 * F.tid;
        LAS float* wtot = (LAS float*)(F.lds + LCNT_OFF + 512);
        float lf[8]; float tot = 0.f;
#pragma unroll
        for (int j = 0; j < 8; ++j) { lf[j] = log_sigmoid(FLOG[(m0 + j) * 8 + h] + bias); tot += lf[j]; }
        float inc = tot;
#pragma unroll
        for (int o = 1; o < 64; o <<= 1) { const float t = __shfl_up(inc, o); if (F.lane >= o) inc += t; }
        if (F.lane == 63) wtot[F.wave] = inc;
        __syncthreads();
        float run = inc - tot;
        for (int w = 0; w < F.wave; ++w) run += wtot[w];
#pragma unroll
        for (int j = 0; j < 8; ++j) { run += lf[j]; const float L = run * LOG2E;
            const unsigned hi = f2bf(L); const float r1 = L - bf2f(hi); const unsigned mi = f2bf(r1); const float r2 = r1 - bf2f(mi); const unsigned lo = f2bf(r2);
            const unsigned one = 0x3f80u;
            v4u q0, k0; const v4u z = (v4u){0u, 0u, 0u, 0u};
            q0.x = hi | (mi << 16); q0.y = lo | (one << 16); q0.z = one | (one << 16); q0.w = 0u;
            k0.x = one | (one << 16); k0.y = one | ((hi ^ 0x8000u) << 16); k0.z = (mi ^ 0x8000u) | ((lo ^ 0x8000u) << 16); k0.w = 0u;
            bf16* qp = QF + (m0 + j) * QF_P + h * 80 + 64; bf16* kp = KF + kimg<10>((int)(m0 + j), h, 64); bf16* kp2 = KF + kimg<10>((int)(m0 + j), h, 72);
            *(v4u*)qp = q0; *(v4u*)(qp + 8) = z; *(v4u*)kp = k0; *(v4u*)kp2 = z; }
    }
    __syncthreads();
}

__device__ __forceinline__ void route_phase(Frame& F, const unsigned* CNT  , const int* TOKE, int* ROWTOK, int* TOKSLOT, int* TEXP  ) {
    LAS unsigned* sh = (LAS unsigned*)(F.lds + LCNT_OFF);
    const int gw = F.vcu * NWAVES + F.wave, NGW = F.G * NWAVES;
    if (F.tid < 8) sh[64 + F.tid] = 0u;
    { const int e = F.wave; unsigned tot = 0u, pre = 0u;
#pragma unroll
        for (int j = 0; j < 4; ++j) { const int wg = F.lane + 64 * j; const unsigned v = (wg < F.G) ? CNT[wg * 16 + e] : 0u; tot += v; pre += (wg < F.vcu) ? v : 0u; }
#pragma unroll
        for (int o = 1; o < 64; o <<= 1) { tot += __shfl_xor(tot, o); pre += __shfl_xor(pre, o); }
        if (F.lane == 0) { sh[e] = tot; sh[16 + e] = pre; } }
    __syncthreads();
    if (F.tid < 8) { unsigned st = 0u;
        for (int t2 = 0; t2 < F.tid; ++t2) st += (sh[t2] + 255u) & ~255u;
        sh[48 + F.tid] = st; sh[32 + F.tid] = st + sh[16 + F.tid]; }
    __syncthreads();
    if (F.lane < 16) { const int m = gw + F.lane * NGW;
        if (m < M) { const int te = TOKE[m]; const int e0 = te & 255, e1 = te >> 8;
            const unsigned i0 = __hip_atomic_fetch_add(sh + 64 + e0, 1u, __ATOMIC_RELAXED, __HIP_MEMORY_SCOPE_WORKGROUP), i1 = __hip_atomic_fetch_add(sh + 64 + e1, 1u, __ATOMIC_RELAXED, __HIP_MEMORY_SCOPE_WORKGROUP);
            const unsigned s0 = sh[32 + e0] + i0, s1 = sh[32 + e1] + i1;
            ROWTOK[s0] = m; ROWTOK[s1] = m; TOKSLOT[2 * m] = (int)s0; TOKSLOT[2 * m + 1] = (int)s1; } }
    if (F.vcu < 8) { const unsigned tot = sh[F.vcu], seg = sh[48 + F.vcu], end = (tot + 255u) & ~255u;
        for (unsigned r = tot + F.tid; r < end; r += NWAVES * 64) ROWTOK[seg + r] = -1; }
    if (F.vcu == 16 && F.tid == 0) { int t = 0;
        for (int e = 0; e < 8; ++e) { t += (int)((sh[e] + 255u) >> 8); TEXP[1 + e] = t; }
        TEXP[0] = t; }
    __syncthreads();
}

__device__ __forceinline__ void outnorm_phase(Frame& F, bf16* O, const float* g1, const float* g2) {
    const int gw = F.vcu * NWAVES + F.wave, NGW = F.G * NWAVES;
    float ga[8], gb[8];
#pragma unroll
    for (int j = 0; j < 8; ++j) { ga[j] = g1[8 * F.lane + j]; gb[j] = g2[8 * F.lane + j]; }
    for (int m = gw; m < M; m += NGW) {
        v4u* p = (v4u*)(O + (size_t)m * O_P) + F.lane;
        const v4u a = p[0], b = p[64];
        float fa[8], fbv[8]; float sa = 0.f, sb = 0.f;
#pragma unroll
        for (int j = 0; j < 4; ++j) { fa[2 * j] = bf2f(a[j] & 0xffffu); fa[2 * j + 1] = bf2f(a[j] >> 16); fbv[2 * j] = bf2f(b[j] & 0xffffu); fbv[2 * j + 1] = bf2f(b[j] >> 16); }
#pragma unroll
        for (int j = 0; j < 8; ++j) { sa += fa[j] * fa[j]; sb += fbv[j] * fbv[j]; }
        const float ra = 1.f / sqrtf(wave_sum(sa) * (1.f / 512.f) + EPS), rb = 1.f / sqrtf(wave_sum(sb) * (1.f / 512.f) + EPS);
        v4u oa, ob;
#pragma unroll
        for (int j = 0; j < 4; ++j) { oa[j] = pk2(fa[2 * j] * ra * ga[2 * j], fa[2 * j + 1] * ra * ga[2 * j + 1]); ob[j] = pk2(fbv[2 * j] * rb * gb[2 * j], fbv[2 * j + 1] * rb * gb[2 * j + 1]); }
        p[0] = oa; p[64] = ob;
    }
}

__device__ __forceinline__ void final_phase(Frame& F, float* X, const float* g, const bf16* Y, const bf16* Yp, const int* TEXP, const int* TOKSLOT, const float* TOKW, const float* gf  ) {
    const int gw = F.vcu * NWAVES + F.wave, NGW = F.G * NWAVES;
    int tail0, S; size_t pstride;
    { pg8::MoeOrderD O; O.init_d(__builtin_amdgcn_readfirstlane(TEXP[0]), FF / 128, F.G, 0); S = O.S; tail0 = O.mainM * 256; pstride = (size_t)(O.tailSub / (4 * O.S)) * 256 * DM; }
    f32x4 gv[4];
#pragma unroll
    for (int j = 0; j < 4; ++j) gv[j] = *(const f32x4*)(g + 4 * F.lane + 256 * j);
    for (int m = gw; m < M; m += NGW) {
        const int b = m >> 12;
        f32x4* xr = (f32x4*)(X + (size_t)m * DM) + F.lane;
        const int s0 = TOKSLOT[2 * m], s1 = TOKSLOT[2 * m + 1]; const float w0 = TOKW[2 * m], w1 = TOKW[2 * m + 1];
        const v2u* y0 = (const v2u*)(Y + (size_t)s0 * DM) + F.lane; const v2u* y1 = (const v2u*)(Y + (size_t)s1 * DM) + F.lane; const f32x4* gr = (const f32x4*)(gf + (size_t)b * 6144) + F.lane;
        f32x4 v[4]; float s = 0.f;
#pragma unroll
        for (int j = 0; j < 4; ++j) { v[j] = xr[64 * j]; const v2u a = y0[64 * j], c = y1[64 * j]; const f32x4 gg = gr[64 * j];
            v[j].x += gg.x * (w0 * bf2f(a.x & 0xffffu) + w1 * bf2f(c.x & 0xffffu)); v[j].y += gg.y * (w0 * bf2f(a.x >> 16) + w1 * bf2f(c.x >> 16));
            v[j].z += gg.z * (w0 * bf2f(a.y & 0xffffu) + w1 * bf2f(c.y & 0xffffu)); v[j].w += gg.w * (w0 * bf2f(a.y >> 16) + w1 * bf2f(c.y >> 16));
        }
        if (S > 1 && (s0 >= tail0 || s1 >= tail0)) {
#pragma unroll 1
            for (int k = 0; k < 2; ++k) { const int sk = k ? s1 : s0; const float wk = k ? w1 : w0; if (sk < tail0) continue;
#pragma unroll 1
                for (int p = 1; p < S; ++p) { const v2u* yp = (const v2u*)(Yp + (size_t)(p - 1) * pstride + (size_t)(sk - tail0) * DM) + F.lane;
#pragma unroll
                    for (int j = 0; j < 4; ++j) { const v2u a = yp[64 * j]; const f32x4 gg = gr[64 * j];
                        v[j].x += gg.x * (wk * bf2f(a.x & 0xffffu)); v[j].y += gg.y * (wk * bf2f(a.x >> 16)); v[j].z += gg.z * (wk * bf2f(a.y & 0xffffu)); v[j].w += gg.w * (wk * bf2f(a.y >> 16)); } } } }
#pragma unroll
        for (int j = 0; j < 4; ++j) s += (v[j].x * v[j].x + v[j].y * v[j].y) + (v[j].z * v[j].z + v[j].w * v[j].w);
        const float r = 1.f / sqrtf(wave_sum(s) * (1.f / DM) + EPS);
#pragma unroll
        for (int j = 0; j < 4; ++j) xr[64 * j] = (v[j] * r) * gv[j];
    }
}

typedef __bf16 bf16x2_t __attribute__((ext_vector_type(2)));
template <int DQK>
__device__ __forceinline__ void attn_naive_unit(Frame& F, const bf16* Q, int qpitch, const bf16* K, int kpitch, const bf16* V, int vpitch, bf16* O  , int b, int h, int qb) {
    LAS unsigned* Ksh = (LAS unsigned*)F.lds;
    LAS float* Vsh = (LAS float*)(F.lds + 64 * DQK * 2);
    const int tid = F.tid, qpos = qb * 512 + tid; const size_t row = (size_t)b * SEQ + qpos;
    unsigned q[DQK / 2]; float o[64];
    { const bf16* qp = Q + row * qpitch + h * DQK;
#pragma unroll
      for (int d8 = 0; d8 < DQK / 8; ++d8) { const v4u w = *(const v4u*)(qp + 8 * d8);
#pragma unroll
          for (int j = 0; j < 4; ++j) q[4 * d8 + j] = w[j]; } }
#pragma unroll
    for (int d = 0; d < 64; ++d) o[d] = 0.f;
    float mrun = -INFINITY, l = 0.f;
    const int ntile = 8 * (qb + 1);
    for (int t = 0; t < ntile; ++t) {
        __syncthreads();
        for (int idx = tid; idx < 64 * DQK / 8; idx += NWAVES * 64) { const int r = idx / (DQK / 8), c8 = idx % (DQK / 8);
            const v4u w = *(const v4u*)(K + ((size_t)b * SEQ + t * 64 + r) * kpitch + h * DQK + 8 * c8); *(LAS v4u*)(Ksh + r * (DQK / 2) + 4 * c8) = w; }
        { const int r = tid >> 3, c8 = tid & 7; const v4u w = *(const v4u*)(V + ((size_t)b * SEQ + t * 64 + r) * vpitch + h * 64 + 8 * c8); LAS float* d = Vsh + r * 64 + 8 * c8;
#pragma unroll
          for (int j = 0; j < 4; ++j) { d[2 * j] = bf2f(w[j] & 0xffffu); d[2 * j + 1] = bf2f(w[j] >> 16); } }
        __syncthreads();
        const int kbase = t * 64;
#pragma unroll 1
        for (int gk = 0; gk < 16; ++gk) {
            float s[4]; float mx = -INFINITY;
#pragma unroll
            for (int j = 0; j < 4; ++j) { const LAS unsigned* kr = Ksh + (gk * 4 + j) * (DQK / 2); float a = 0.f;
#pragma unroll
                for (int d = 0; d < DQK / 2; ++d) a = __builtin_amdgcn_fdot2_f32_bf16(__builtin_bit_cast(bf16x2_t, q[d]), __builtin_bit_cast(bf16x2_t, kr[d]), a, false);
                s[j] = (kbase + gk * 4 + j <= qpos) ? a : -INFINITY; mx = fmaxf(mx, s[j]); asm volatile("" ::: "memory"); }
            const float mnew = fmaxf(mrun, mx);
            if (mnew > -INFINITY) {
                const float alpha = __builtin_amdgcn_exp2f(mrun - mnew);
                l *= alpha;
#pragma unroll
                for (int d = 0; d < 64; ++d) o[d] *= alpha;
#pragma unroll
                for (int j = 0; j < 4; ++j) { const float p = __builtin_amdgcn_exp2f(s[j] - mnew); l += p; const LAS float* vr = Vsh + (gk * 4 + j) * 64;
#pragma unroll
                    for (int dc = 0; dc < 4; ++dc) {
#pragma unroll
                        for (int d = 0; d < 16; ++d) o[dc * 16 + d] += p * vr[dc * 16 + d];
                        asm volatile("" ::: "memory"); } }
                mrun = mnew;
            }
        }
    }
    const float rl = 1.f / l;
    bf16* op = O + row * O_P + h * 64;
#pragma unroll
    for (int d8 = 0; d8 < 8; ++d8) { v4u w;
#pragma unroll
        for (int j = 0; j < 4; ++j) w[j] = pk2(o[8 * d8 + 2 * j] * rl, o[8 * d8 + 2 * j + 1] * rl);
        *(v4u*)(op + 8 * d8) = w; }
    __syncthreads();
}

namespace att {
using f32x16 = __attribute__((ext_vector_type(16))) float;
using s16x4 = __attribute__((ext_vector_type(4))) short;
using u32x4 = __attribute__((ext_vector_type(4))) unsigned;
typedef __attribute__((address_space(3))) const char* lds_cptr;
typedef short v4i16_t __attribute__((ext_vector_type(4)));
__device__ __forceinline__ int crow(int r, int hi) { return (r & 3) + 8 * (r >> 2) + 4 * hi; }
__device__ __forceinline__ void glds16(const void* gsrc, unsigned lds_dst) { unsigned keep;
    asm volatile("s_mov_b32 %0, m0\n\ts_mov_b32 m0, %2\n\ts_nop 0\n\tglobal_load_lds_dwordx4 %1, off\n\ts_mov_b32 m0, %0" : "=&s"(keep) : "v"(gsrc), "s"(lds_dst) : "memory"); }
__device__ __forceinline__ unsigned cvtpk(float lo, float hi) { unsigned r; asm("v_cvt_pk_bf16_f32 %0, %1, %2" : "=v"(r) : "v"(lo), "v"(hi)); return r; }
#define ATT_WAIT_BAR(N) asm volatile("s_waitcnt vmcnt(" #N ") lgkmcnt(0)\n\ts_barrier" ::: "memory")
constexpr float THR = 8.f;

__device__ __forceinline__ float max3f(float a, float b, float c) { float r; asm("v_max3_f32 %0, %1, %2, %3" : "=v"(r) : "v"(a), "v"(b), "v"(c)); return r; }
__device__ __forceinline__ float max2f(float a, float b) { float r; asm("v_max_f32_e32 %0, %1, %2" : "=v"(r) : "v"(a), "v"(b)); return r; }
__device__ __forceinline__ float fadd_s(float a, float b) { float r; asm("v_add_f32_e32 %0, %1, %2" : "=v"(r) : "v"(a), "v"(b)); return r; }
__device__ __forceinline__ float fsub_s(float a, float b) { float r; asm("v_sub_f32_e32 %0, %1, %2" : "=v"(r) : "v"(a), "v"(b)); return r; }
__device__ __forceinline__ float fmul_s(float a, float b) { float r; asm("v_mul_f32_e32 %0, %1, %2" : "=v"(r) : "v"(a), "v"(b)); return r; }

template <int DQK>
__device__ __forceinline__ void attn_unit(const bf16* Q, const bf16* K, const bf16* V, bf16* O, float* SSQO  , int b, int h, int qb, char* shm) {
    constexpr int NK = DQK / 16, NCH = DQK / 8, NX = NCH - 8, KBYTES = NCH * 1024, SLOT = KBYTES + 8192, PITCH = 8 * DQK;
    constexpr int LDS_WS = 3 * SLOT, LDS_OST = LDS_WS + 8 * 256;
    int tid_ = threadIdx.x; asm volatile("" : "+v"(tid_));
    const int tid = tid_, lane = tid & 63, r32 = lane & 31, hi = lane >> 5; const int wid = __builtin_amdgcn_readfirstlane(tid >> 6);
    const long rowbase = (long)b * SEQ; const int q0 = qb * 256;
    const bf16* Qw = Q + (rowbase + q0 + wid * 32) * PITCH + h * DQK;
    const unsigned lds0 = (unsigned)(uintptr_t)shm;
    float* wsf = (float*)(shm + LDS_WS) + wid * 64;
    const int NT = 4 * (qb + 1);
    constexpr long KTILE = (long)NH * NCH * 512;
    const bf16* ksrc0 = K + kimg<NCH>((int)rowbase + (NT - 1) * 64, h, wid * 8) + lane * 8;
    constexpr long VTILE = (long)NH * 8 * 512;
    const bf16* vsrc = V + vimg((int)rowbase + (NT - 1) * 64, h, 0) + wid * 512 + lane * 8;
#define ATT_DMA(back, slotoff) do { const unsigned _d = (unsigned)__builtin_amdgcn_readfirstlane(lds0 + (slotoff)); \
        glds16(ksrc0 - (long)(back) * KTILE, _d + wid * 1024); if (wid < NX) glds16(ksrc0 - (long)(back) * KTILE + 8 * 512, _d + (8 + wid) * 1024); \
        glds16(vsrc - (long)(back) * VTILE, _d + KBYTES + wid * 1024); } while (0)
    ATT_DMA(0, 0); ATT_DMA(1, SLOT);
    bf16x8 qr[NK];
#pragma unroll
    for (int d0 = 0; d0 < NK; ++d0) qr[d0] = *reinterpret_cast<const bf16x8*>(&Qw[(long)r32 * PITCH + d0 * 16 + hi * 8]);
#pragma unroll
    for (int d0 = 0; d0 < NK; ++d0) asm volatile("" : "+v"(qr[d0]));
    asm volatile("s_waitcnt vmcnt(0)" ::: "memory");
    float mhat = 0.f, l_reg = 0.f; f32x16 o[2]; o[0] = f32x16{}; o[1] = f32x16{};
    const int jdiag = wid >> 1;
    const lds_cptr kp0 = (lds_cptr)shm + hi * 1024 + r32 * 16;
    const lds_cptr vp0 = (lds_cptr)shm + KBYTES + ((lane >> 4) & 1) * 32 + (lane & 3) * 8 + (4 * hi + ((lane & 15) >> 2)) * 64;
    f32x16 p0, p1; s16x4 vlo[8], vhi[8];
#define ATT_A(slot) do { \
        bf16x8 kf[2 * NK]; \
        _Pragma("unroll") for (int d0 = 0; d0 < NK; ++d0) { kf[2 * d0] = *(const __attribute__((address_space(3))) bf16x8*)(kp0 + (slot) + d0 * 2048); kf[2 * d0 + 1] = *(const __attribute__((address_space(3))) bf16x8*)(kp0 + (slot) + d0 * 2048 + 512); } \
        __builtin_amdgcn_sched_barrier(0); \
        _Pragma("unroll") for (int i = 0; i < 8; ++i) { \
            vlo[i] = __builtin_bit_cast(s16x4, __builtin_amdgcn_ds_read_tr16_b64_v4i16((__attribute__((address_space(3))) v4i16_t*)(vp0 + (slot) + (i >> 2) * 4096 + (i & 3) * 1024))); \
            vhi[i] = __builtin_bit_cast(s16x4, __builtin_amdgcn_ds_read_tr16_b64_v4i16((__attribute__((address_space(3))) v4i16_t*)(vp0 + (slot) + (i >> 2) * 4096 + (i & 3) * 1024 + 512))); } \
        __builtin_amdgcn_sched_barrier(0); \
        f32x16 c; \
        _Pragma("unroll") for (int r = 0; r < 16; ++r) c[r] = -mhat; \
        _Pragma("unroll") for (int i = 0; i < 2 * NK; ++i) asm volatile("" : "+v"(kf[i])); \
        p0 = __builtin_amdgcn_mfma_f32_32x32x16_bf16(kf[0], qr[0], c, 0, 0, 0); p1 = __builtin_amdgcn_mfma_f32_32x32x16_bf16(kf[1], qr[0], c, 0, 0, 0); \
        _Pragma("unroll") for (int d0 = 1; d0 < NK; ++d0) { p0 = __builtin_amdgcn_mfma_f32_32x32x16_bf16(kf[2 * d0], qr[d0], p0, 0, 0, 0); p1 = __builtin_amdgcn_mfma_f32_32x32x16_bf16(kf[2 * d0 + 1], qr[d0], p1, 0, 0, 0); } \
        _Pragma("unroll") for (int i = 0; i < 8; ++i) { asm volatile("" : "+v"(vlo[i])); asm volatile("" : "+v"(vhi[i])); } \
        asm volatile("s_nop 15\n\ts_nop 7" : "+v"(p0), "+v"(p1));        \
    } while (0)
#define ATT_B(MODE) do { \
        if (MODE == 1) { int qrel = wid * 32 + r32; asm volatile("" : "+v"(qrel)); const int kb = 64 * jdiag + 4 * hi; \
            _Pragma("unroll") for (int r = 0; r < 16; ++r) { const int kv = kb + (r & 3) + 8 * (r >> 2); if (kv > qrel) p0[r] = -INFINITY; if (kv + 32 > qrel) p1[r] = -INFINITY; } } \
        float rm; \
        { float a0 = max3f(p0[0], p0[1], p1[0]), a1 = max3f(p0[2], p0[3], p1[1]), a2 = max3f(p0[4], p0[5], p1[2]), a3 = max3f(p0[6], p0[7], p1[3]); \
          a0 = max3f(a0, p0[8], p0[9]); a1 = max3f(a1, p0[10], p0[11]); a2 = max3f(a2, p0[12], p0[13]); a3 = max3f(a3, p0[14], p0[15]); \
          a0 = max3f(a0, p1[4], p1[5]); a1 = max3f(a1, p1[6], p1[7]); a2 = max3f(a2, p1[8], p1[9]); a3 = max3f(a3, p1[10], p1[11]); \
          a0 = max3f(a0, p1[12], p1[13]); a1 = max3f(a1, p1[14], p1[15]); rm = max2f(max2f(a0, a1), max2f(a2, a3)); } \
        asm volatile("s_nop 1" : "+v"(rm));                                     \
        { auto rr = __builtin_amdgcn_permlane32_swap(__float_as_uint(rm), __float_as_uint(rm), false, false); float r0_ = __uint_as_float(rr[0]), r1_ = __uint_as_float(rr[1]); asm volatile("s_nop 1" : "+v"(r0_), "+v"(r1_)); rm = max2f(r0_, r1_); } \
        if (MODE == 1) { mhat += rm; \
            _Pragma("unroll") for (int r = 0; r < 16; ++r) { p0[r] = fsub_s(p0[r], rm); p1[r] = fsub_s(p1[r], rm); } } \
        else if (__builtin_expect(__any(rm > THR), 0)) { const float dl = fmaxf(rm, 0.f); mhat += dl; \
            _Pragma("unroll") for (int r = 0; r < 16; ++r) { p0[r] = fsub_s(p0[r], dl); p1[r] = fsub_s(p1[r], dl); } \
            const float f = __builtin_amdgcn_exp2f(-dl); l_reg *= f; if (hi == 0) wsf[r32] = f; \
            asm volatile("s_waitcnt lgkmcnt(0)" ::: "memory"); \
            _Pragma("unroll") for (int r4 = 0; r4 < 4; ++r4) { const f32x4 fv = *(const f32x4*)(wsf + 8 * r4 + 4 * hi); \
                _Pragma("unroll") for (int j = 0; j < 4; ++j) { o[0][4 * r4 + j] = fmul_s(o[0][4 * r4 + j], fv[j]); o[1][4 * r4 + j] = fmul_s(o[1][4 * r4 + j], fv[j]); } } } \
        _Pragma("unroll") for (int r = 0; r < 16; ++r) { p0[r] = __builtin_amdgcn_exp2f(p0[r]); p1[r] = __builtin_amdgcn_exp2f(p1[r]); } \
        asm volatile("s_nop 1" : "+v"(p0), "+v"(p1));                      \
        float sa0 = 0.f, sa1 = 0.f, sa2 = 0.f, sa3 = 0.f; \
        _Pragma("unroll") for (int r = 0; r < 16; r += 4) { \
            sa0 = fadd_s(sa0, p0[r]); sa1 = fadd_s(sa1, p0[r + 1]); sa2 = fadd_s(sa2, p0[r + 2]); sa3 = fadd_s(sa3, p0[r + 3]); \
            sa0 = fadd_s(sa0, p1[r]); sa1 = fadd_s(sa1, p1[r + 1]); sa2 = fadd_s(sa2, p1[r + 2]); sa3 = fadd_s(sa3, p1[r + 3]); } \
        l_reg += fadd_s(fadd_s(sa0, sa1), fadd_s(sa2, sa3)); \
        u32x4 pw[4]; \
        _Pragma("unroll") for (int j = 0; j < 4; ++j) { pw[0][j] = cvtpk(p0[2 * j], p0[2 * j + 1]); pw[1][j] = cvtpk(p0[8 + 2 * j], p0[8 + 2 * j + 1]); pw[2][j] = cvtpk(p1[2 * j], p1[2 * j + 1]); pw[3][j] = cvtpk(p1[8 + 2 * j], p1[8 + 2 * j + 1]); } \
        asm volatile("s_nop 3" : "+v"(pw[0]), "+v"(pw[1]), "+v"(pw[2]), "+v"(pw[3]), "+v"(o[0]), "+v"(o[1]));     \
        _Pragma("unroll") for (int ks = 0; ks < 4; ++ks) _Pragma("unroll") for (int d0 = 0; d0 < 2; ++d0) { const int i = d0 * 4 + ks; \
            const bf16x8 vf = (bf16x8){vlo[i][0], vlo[i][1], vlo[i][2], vlo[i][3], vhi[i][0], vhi[i][1], vhi[i][2], vhi[i][3]}; \
            o[d0] = __builtin_amdgcn_mfma_f32_32x32x16_bf16(__builtin_bit_cast(bf16x8, pw[ks]), vf, o[d0], 0, 0, 0); } \
    } while (0)
#define ATT_SYNC(k) do { if ((k) + 1 < NT) { if (wid < NX) ATT_WAIT_BAR(3); else ATT_WAIT_BAR(2); } else ATT_WAIT_BAR(0); } while (0)
    const bool late = wid >= 4;
    if (late) { ATT_SYNC(0); ATT_DMA(2, 2 * SLOT); }
#pragma unroll
    for (int s = 0; s < 4; ++s) {
        if (!late) { ATT_SYNC(s); if (s + 2 < NT) ATT_DMA(s + 2, ((s + 2) % 3) * SLOT); }
        const int jb = 3 - s;
        if (jb <= jdiag) ATT_A((s % 3) * SLOT);
        if (late && s + 1 < NT) { ATT_SYNC(s + 1); if (s + 3 < NT) ATT_DMA(s + 3, (s % 3) * SLOT); }
        if (jb == jdiag) ATT_B(1); else if (jb < jdiag) ATT_B(0);
    }
    int slot = SLOT, slot2 = 0;
#pragma unroll 1
    for (int s = 4; s < NT; ++s) {
        if (!late) { ATT_SYNC(s); if (s + 2 < NT) ATT_DMA(s + 2, slot2); }
        ATT_A(slot);
        if (late && s + 1 < NT) { ATT_SYNC(s + 1); if (s + 3 < NT) ATT_DMA(s + 3, slot); }
        ATT_B(0);
        slot = (slot == 2 * SLOT) ? 0 : slot + SLOT; slot2 = (slot2 == 2 * SLOT) ? 0 : slot2 + SLOT;
    }
#undef ATT_SYNC
#undef ATT_A
#undef ATT_B
    { auto rr = __builtin_amdgcn_permlane32_swap(__float_as_uint(l_reg), __float_as_uint(l_reg), false, false); l_reg = __uint_as_float(rr[0]) + __uint_as_float(rr[1]); }
    if (hi == 0) wsf[32 + r32] = l_reg; asm volatile("s_waitcnt lgkmcnt(0)" ::: "memory");
    float rli[16];
#pragma unroll
    for (int r = 0; r < 16; ++r) rli[r] = __builtin_amdgcn_rcpf(wsf[32 + crow(r, hi)]);
    bf16* Ow = O + (rowbase + q0 + wid * 32) * O_P + h * 64;
    { bf16* stg = (bf16*)(shm + LDS_OST) + wid * 2048;
#pragma unroll
      for (int r = 0; r < 16; ++r) { const int orow = crow(r, hi);
#pragma unroll
          for (int d0 = 0; d0 < 2; ++d0) stg[orow * 64 + d0 * 32 + r32] = (bf16)f2bf(o[d0][r] * rli[r]); }
      asm volatile("s_waitcnt lgkmcnt(0)" ::: "memory");
#pragma unroll
      for (int i = 0; i < 4; ++i) { const int row = i * 8 + (lane >> 3), ch = lane & 7; const u32x4 v = *(const u32x4*)(stg + row * 64 + ch * 8); *(u32x4*)(Ow + (long)row * O_P + ch * 8) = v;
          float ss = 0.f;
#pragma unroll
          for (int j = 0; j < 4; ++j) { const float lo_ = bf2f(v[j] & 0xffffu), hi_ = bf2f(v[j] >> 16); ss += lo_ * lo_ + hi_ * hi_; }
          ss += __shfl_xor(ss, 1); ss += __shfl_xor(ss, 2); ss += __shfl_xor(ss, 4);
          if (ch == 0) SSQO[(size_t)(rowbase + q0 + wid * 32 + row) * 16 + h] = ss; } }
    asm volatile("s_waitcnt lgkmcnt(0)\n\ts_barrier" ::: "memory");
#undef ATT_DMA
}
}

constexpr int PH_PRO = 0, PH_L0 = 1, PH_L1 = 11, PH_MOE = 19, PH_FINAL = 22, N_PHASES = 23;

__device__ __forceinline__ void weights_phase(Frame& F, const Args& args) {
    unsigned char* ws = args.ws;
#pragma unroll 1
    for (int l = 0; l < 2; ++l) {
        conv_matrix(F, SrcWin{args.in[6] + (size_t)l * 1024 * 1960, 1960}, 1024, 1024, INC, (bf16*)(ws + WS_WIN) + (size_t)l * INC * 1024, 1024 * l);
        conv_matrix(F, SrcWuq{args.in[8] + (size_t)l * 256 * 768, 768, args.in[7] + l * 256}, 256, 256, 768, (bf16*)(ws + WS_WUQ) + (size_t)l * 768 * 256, 96 * l);
        conv_matrix(F, SrcWukv{args.in[10] + (size_t)l * 128 * 1024, 1024, args.in[9] + l * 128}, 128, 128, 1024, (bf16*)(ws + WS_WUKV) + (size_t)l * 1024 * 128, 192 + 64 * l);
    }
    __syncthreads();
#pragma unroll 1
    for (int l = 0; l < 2; ++l)
        conv_matrix_wg<SrcPlainG, false>(F, SrcPlainG{args.in[14] + (size_t)l * 1024 * 1024, 1024, args.in[12] + l * 512, args.in[13] + l * 512}, 1024, 1024, 1024, ws + WS_WO + (size_t)l * 1024 * 1024 * 2, 1.f, 40 + 64 * l);
    conv_matrix_wg<SrcGU, true>(F, SrcGU{args.in[16], args.in[17], FF}, 1024, 1024, 2 * FF, ws + WS_WGU0, SC_WGU, 168);
    conv_matrix_wg<SrcPlain, true>(F, SrcPlain{args.in[18], 1024}, FF, FF, 1024, ws + WS_WD0, SC_WD, 136);
}

__global__ void __launch_bounds__(NWAVES * 64, 2) fwd_kernel(Args args) {
    extern __shared__ __attribute__((aligned(16))) unsigned char lds[];
    Frame F;
    F.lds = (LAS unsigned char*)lds;
    F.tid = threadIdx.x; F.lane = F.tid & 63; F.wave = __builtin_amdgcn_readfirstlane(F.tid >> 6);
    F.G = gridDim.x; { const int bx = blockIdx.x; F.vcu = (F.G % 8 == 0) ? (bx % 8) * (F.G / 8) + bx / 8 : bx; }
    F.ws = args.ws;
    unsigned char* ws = args.ws;
    for (int u = F.tid; u < (LDS_BYTES - LDSCTL_OFF) / 4; u += NWAVES * 64) ((LAS unsigned*)(F.lds + LDSCTL_OFF))[u] = 0u;
    __syncthreads();
#if MK_ONE_LAUNCH
    XcdBarrier bar = xcd_barrier_post((unsigned*)(ws + WS_CTL) + CW_BAR, (volatile LAS unsigned*)(F.lds + MISC_OFF) + 8);
#define SEAM(k) do { if (lo <= (k) && (k) + 1 < hi) xcd_barrier(bar); } while (0)
#else
#define SEAM(k) do { } while (0)
#endif
    const int lo = args.ph_lo, hi = args.ph_hi;
#ifndef PHSEL
#define PHSEL 0xFFFFu
#endif
#define IN(k) (lo <= (k) && (k) < hi)
#define SEL(kind) (((PHSEL) >> (kind)) & 1u)

#define FRESH() do { int t_ = threadIdx.x; asm volatile("" : "+v"(t_)); F.tid = t_; F.lane = t_ & 63; F.wave = __builtin_amdgcn_readfirstlane(t_ >> 6); } while (0)
#define INP(k) (args.in[k])
#define WSP(T, off) ((T*)(ws + (off)))
    float* X = args.out;

    if (SEL(0) && IN(PH_PRO)) { FRESH();
        rope_phase(F, (const int*)INP(2), WSP(float, WS_ROPE));
        mod_phase(F, INP(1), INP(3), INP(4), WSP(float, WS_MOD));
    }
    SEAM(PH_PRO);

#define LAYER_MIXER(l, pb) do { \
          \
        if (SEL(1) && IN(pb + 0)) { FRESH(); \
            if (l == 0) { norm_phase<false, false>(F, INP(0), INP(5), WSP(float, WS_MOD), 0, WSP(bf16, WS_XN), nullptr, nullptr, nullptr, nullptr, nullptr, nullptr, nullptr); weights_phase(F, args); } \
            else norm_phase<false, true>(F, X, INP(5) + 1024, WSP(float, WS_MOD) + (size_t)8 * 6144, 0, WSP(bf16, WS_XN), nullptr, nullptr, nullptr, nullptr, WSP(bf16, WS_T2), WSP(float, WS_MOD) + 5 * 1024, X); } \
        SEAM(pb + 0); \
          \
        if (SEL(2) && IN(pb + 1)) { \
            pg8::Gemm g{WSP(bf16, WS_XN), WSP(bf16, WS_WIN) + (size_t)l * INC * 1024, 1024, 0, nullptr}; pg8::StaticOrder S; S.init(M, INC, F.G, (int)blockIdx.x); \
            pg8::EpiInproj E{WSP(bf16, WS_CQN), WSP(bf16, WS_CKVN), WSP(bf16, WS_KM), WSP(float, WS_SSQQ), WSP(float, WS_SSQKV), WSP(float, WS_FLOG), WSP(float, WS_ROPE), WSP(bf16, WS_QF), WSP(bf16, WS_KF), WSP(bf16, WS_VF)}; \
            pg8::gemm_phase<pg8::EpiInproj, pg8::StaticOrder, true, true>(F.lds, g, S, E); } \
        SEAM(pb + 1); \
          \
        if (SEL(4) && IN(pb + 3)) { FRESH(); scan_phase(F, WSP(float, WS_FLOG), INP(11) + l * 8, WSP(bf16, WS_QF), WSP(bf16, WS_KF)); \
            { pg8::Gemm g{WSP(bf16, WS_CQN), WSP(bf16, WS_WUQ) + (size_t)l * 768 * 256, 256, 0, nullptr}; pg8::StaticOrder S; S.init(M, 768, F.G, (int)blockIdx.x); \
              pg8::EpiQ E{WSP(bf16, WS_QM), WSP(float, WS_ROPE), WSP(float, WS_SSQQ)}; pg8::gemm_phase<pg8::EpiQ, pg8::StaticOrder, true, true>(F.lds, g, S, E); } \
            { int kkv = 128; asm volatile("" : "+s"(kkv)); pg8::Gemm g{WSP(bf16, WS_CKVN), WSP(bf16, WS_WUKV) + (size_t)l * 1024 * 128, kkv, 0, nullptr}; pg8::StaticOrder S; S.init(M, 1024, F.G, (int)blockIdx.x); \
              pg8::EpiKV E{WSP(bf16, WS_KM), WSP(bf16, WS_VM), WSP(float, WS_SSQKV)}; pg8::gemm_phase<pg8::EpiKV, pg8::StaticOrder, true, true>(F.lds, g, S, E); } } \
        SEAM(pb + 3); \
          \
        if (SEL(5) && IN(pb + 4)) { \
            const int bh = F.vcu >> 2, s4 = F.vcu & 3, b = bh >> 3, h = bh & 7; \
            _Pragma("unroll 1") for (int i = 0; i < 4; ++i) { const int p = (i & 2) ? 7 - s4 : s4, qb = (i & 1) ? 15 - p : p; \
                att::attn_unit<96>(WSP(bf16, WS_QM), WSP(bf16, WS_KM), WSP(bf16, WS_VM), WSP(bf16, WS_O), WSP(float, WS_SSQO), b, h, qb, (char*)lds); } \
            _Pragma("unroll 1") for (int i = 0; i < 4; ++i) { const int p = (i & 2) ? 7 - s4 : s4, qb = (i & 1) ? 15 - p : p; \
                att::attn_unit<80>(WSP(bf16, WS_QF), WSP(bf16, WS_KF), WSP(bf16, WS_VF), WSP(bf16, WS_O) + 512, WSP(float, WS_SSQO) + 8, b, h, qb, (char*)lds); } } \
        SEAM(pb + 4); \
          \
        if (SEL(7) && IN(pb + 6)) { \
            pg8::Gemm g{WSP(bf16, WS_O), WSP(bf16, WS_WO) + (size_t)l * 1024 * 1024, 1024, 0, nullptr}; pg8::StaticOrder S; S.init(M, 1024, F.G, (int)blockIdx.x); \
            pg8::EpiWo E{WSP(bf16, WS_T1), WSP(float, WS_SSQO)}; \
            pg8::gemm_phase<pg8::EpiWo, pg8::StaticOrder, true, true>(F.lds, g, S, E); } \
        SEAM(pb + 6); \
    } while (0)

    LAYER_MIXER(0, PH_L0);
    if (SEL(8) && IN(PH_L0 + 7)) { FRESH(); norm_phase<false, true, true>(F, INP(0), INP(15), WSP(float, WS_MOD), 3, WSP(bf16, WS_XN8), nullptr, nullptr, nullptr, nullptr, WSP(bf16, WS_T1), WSP(float, WS_MOD) + 2 * 1024, X); }
    SEAM(PH_L0 + 7);
    if (SEL(9) && IN(PH_L0 + 8)) {
        pg8::Gemm g{WSP(bf16, WS_XN8), WSP(bf16, WS_WGU0), 512, 0, nullptr}; pg8::StaticOrder S; S.init(M, 2 * FF, F.G, (int)blockIdx.x);
        pg8::EpiSwigluF8 E{WSP(unsigned char, WS_H0)}; pg8::gemm_phase<pg8::EpiSwigluF8, pg8::StaticOrder, true, true, false, true>(F.lds, g, S, E);
    }
    SEAM(PH_L0 + 8);
    if (SEL(10) && IN(PH_L0 + 9)) {
        pg8::Gemm g{WSP(bf16, WS_H0), WSP(bf16, WS_WD0), FF / 2, 0, nullptr}; pg8::StaticOrder S; S.init(M, 1024, F.G, (int)blockIdx.x);
        pg8::EpiBf16Plain E{WSP(bf16, WS_T2), DM, 1.f / (SC_H * SC_WD)}; pg8::gemm_phase<pg8::EpiBf16Plain, pg8::StaticOrder, true, true, false, true>(F.lds, g, S, E);
    }
    SEAM(PH_L0 + 9);
    LAYER_MIXER(1, PH_L1);
    if (SEL(8) && IN(PH_L1 + 7)) { FRESH();
        norm_phase<true, true>(F, X, INP(15) + 1024, WSP(float, WS_MOD) + (size_t)8 * 6144, 3, WSP(bf16, WS_XN8), INP(19), WSP(int, WS_TOKE), WSP(float, WS_TOKW), WSP(unsigned, WS_CNT), WSP(bf16, WS_T1), WSP(float, WS_MOD) + (size_t)8 * 6144 + 2 * 1024, X);
#pragma unroll 1
        for (int e = 0; e < NE; ++e) {
            conv_matrix_wg<SrcGU, true>(F, SrcGU{INP(20) + (size_t)e * 1024 * FF, INP(21) + (size_t)e * 1024 * FF, FF}, 1024, 1024, 2 * FF, WSP(unsigned char, WS_WGU8) + (size_t)e * 2 * FF * 1024, SC_WGU);
            conv_matrix_wg<SrcPlain, true>(F, SrcPlain{INP(22) + (size_t)e * FF * 1024, 1024}, FF, FF, 1024, WSP(unsigned char, WS_WD8) + (size_t)e * 1024 * FF, SC_WD);
        }
    }
    SEAM(PH_L1 + 7);
    if (SEL(11) && IN(PH_MOE)) { FRESH(); route_phase(F, WSP(unsigned, WS_CNT), WSP(int, WS_TOKE), WSP(int, WS_ROWTOK), WSP(int, WS_TOKSLOT), WSP(int, WS_TEXP)); }
    SEAM(PH_MOE);
    if (SEL(11) && IN(PH_MOE + 1)) { const int* texp = WSP(int, WS_TEXP); const int ntile = __builtin_amdgcn_readfirstlane(texp[0]);
        pg8::Gemm g{WSP(bf16, WS_XN8), WSP(bf16, WS_WGU8), 512, (size_t)2 * FF * 1024, WSP(int, WS_ROWTOK)};
        pg8::MoeOrder S; S.init(ntile * 256, 2 * FF, F.G, (int)blockIdx.x); S.load(texp);
        pg8::EpiSwigluF8 E{WSP(unsigned char, WS_H8)}; pg8::gemm_phase<pg8::EpiSwigluF8, pg8::MoeOrder, true, true, true, true>(F.lds, g, S, E); }
    SEAM(PH_MOE + 1);
    if (SEL(12) && IN(PH_MOE + 2)) { const int* texp = WSP(int, WS_TEXP); const int ntile = __builtin_amdgcn_readfirstlane(texp[0]);
        pg8::Gemm g{(const bf16*)WSP(unsigned char, WS_H8), WSP(bf16, WS_WD8), FF / 2, (size_t)1024 * FF, nullptr};
        pg8::MoeOrderD S; S.init_d(ntile, FF / 128, F.G, (int)blockIdx.x); S.load(texp);
        pg8::EpiMoeY E{WSP(bf16, WS_Y), WSP(bf16, WS_YP), S.mainM * 256, (size_t)(ntile - S.mainM) * 256 * DM, 1.f / (SC_H * SC_WD)};
        pg8::gemm_phase<pg8::EpiMoeY, pg8::MoeOrderD, true, true, false, true, true>(F.lds, g, S, E); }
    SEAM(PH_MOE + 2);
    if (SEL(13) && IN(PH_FINAL)) { FRESH(); final_phase(F, X, INP(23), WSP(bf16, WS_Y), WSP(bf16, WS_YP), WSP(int, WS_TEXP), WSP(int, WS_TOKSLOT), WSP(float, WS_TOKW), WSP(float, WS_MOD) + (size_t)8 * 6144 + 5 * 1024); }
#undef IN
#undef SEAM
}

extern "C" void kernel_launch(void* const* d_in, const int* in_sizes, int n_in, void* d_out, int out_size, void* d_ws, size_t ws_size, hipStream_t stream) {
    static int grid = 0;
    if (grid == 0) {
        if (n_in != 24 || out_size != M * DM || ws_size < WS_END) { fprintf(stderr, "kernel_launch: unexpected shapes (n_in %d out %d ws %zu)\n", n_in, out_size, ws_size); grid = -1; return; }
        int dev = 0, cus = 0, per_cu = 0;
        if (hipGetDevice(&dev) != hipSuccess || hipDeviceGetAttribute(&cus, hipDeviceAttributeMultiprocessorCount, dev) != hipSuccess) { grid = -1; return; }
        if (hipFuncSetAttribute((const void*)fwd_kernel, hipFuncAttributeMaxDynamicSharedMemorySize, LDS_BYTES) != hipSuccess) { fprintf(stderr, "kernel_launch: hipFuncSetAttribute failed\n"); grid = -1; return; }
        if (hipOccupancyMaxActiveBlocksPerMultiprocessor(&per_cu, (const void*)fwd_kernel, NWAVES * 64, LDS_BYTES) != hipSuccess || per_cu < 1)
            fprintf(stderr, "kernel_launch: occupancy query reports %d\n", per_cu);
        (void)hipGetLastError();
        grid = cus;
        if (grid != 256) fprintf(stderr, "kernel_launch: %d CUs (built for 256)\n", grid);
    }
    if (grid < 0) return;
    (void)hipMemsetAsync((char*)d_ws + WS_CTL, 0, CTL_ZERO_BYTES, stream);
    Args a{};
    for (int i = 0; i < 24; ++i) a.in[i] = (const float*)d_in[i];
    a.out = (float*)d_out; a.ws = (unsigned char*)d_ws;
#if MK_ONE_LAUNCH
    a.ph_lo = 0; a.ph_hi = N_PHASES;
    hipLaunchKernelGGL(fwd_kernel, dim3(grid), dim3(NWAVES * 64), LDS_BYTES, stream, a);
#else
    for (int p = 0; p < N_PHASES; ++p) { a.ph_lo = p; a.ph_hi = p + 1; hipLaunchKernelGGL(fwd_kernel, dim3(grid), dim3(NWAVES * 64), LDS_BYTES, stream, a); }
#endif
}
```

```cpp
#include <hip/hip_runtime.h>
#include <cstdio>
#include <cstdint>
#include <cmath>

#ifndef MK_ONE_LAUNCH
#define MK_ONE_LAUNCH 1
#endif

#define GAS __attribute__((address_space(1)))
#define LAS __attribute__((address_space(3)))
typedef unsigned short bf16;
typedef unsigned v4u __attribute__((ext_vector_type(4)));
typedef unsigned v2u __attribute__((ext_vector_type(2)));
typedef float f32x4 __attribute__((ext_vector_type(4)));
typedef float f32x2 __attribute__((ext_vector_type(2)));
typedef short bf16x8 __attribute__((ext_vector_type(8)));
typedef GAS unsigned gu32;
typedef int v8i __attribute__((ext_vector_type(8)));
typedef int v4i __attribute__((ext_vector_type(4)));
typedef v8i v8i_a16 __attribute__((aligned(16)));

constexpr int NB = 8, SEQ = 4096, DM = 1024, M = NB * SEQ, NH = 8, FF = 3584, NE = 8;
constexpr int INC = 2048;
constexpr int PA_P = 512, QM_P = 768, KM_P = 768, VM_P = 512, QF_P = 640, KF_P = 640, VF_P = 512, O_P = 1024;
constexpr float LOG2E = 1.4426950408889634f;
constexpr float C2M = 0.10206207261596575f * LOG2E;
constexpr float C2F = 0.125f * LOG2E;
constexpr float EPS = 1e-6f;

constexpr size_t MiB = 1u << 20;
constexpr size_t WS_CTL = 0, CTL_ZERO_BYTES = 1 * MiB;
constexpr size_t WS_MOD = 1 * MiB;
constexpr size_t WS_WIN = 4 * MiB, WS_WUQ = 12 * MiB, WS_WUKV = 13 * MiB, WS_WO = 14 * MiB, WS_WGU0 = 18 * MiB, WS_WD0 = 32 * MiB;
constexpr size_t WS_XN = 40 * MiB;
constexpr size_t WS_R = 104 * MiB;
constexpr size_t WS_PA = WS_R, WS_CQN = 168 * MiB, WS_CKVN = 184 * MiB, WS_QM = 200 * MiB, WS_KM = 248 * MiB, WS_VM = 296 * MiB,
                 WS_QF = 328 * MiB, WS_KF = 368 * MiB, WS_VF = 408 * MiB, WS_O = 440 * MiB, WS_ROPE = 504 * MiB;
constexpr size_t WS_SSQQ = WS_PA, WS_SSQKV = WS_PA + 1 * MiB, WS_FLOG = WS_PA + 2 * MiB, WS_SSQO = WS_PA + 4 * MiB;
constexpr size_t WS_H0 = WS_R;
constexpr size_t WS_WGU8 = WS_R, WS_WD8 = 160 * MiB, WS_H8 = 192 * MiB;
constexpr size_t WS_XN8 = WS_XN;
constexpr int MOE_MAXTILE = 136, MOE_MAXROW = MOE_MAXTILE * 256;
constexpr size_t H8_ROUND = (size_t)MOE_MAXROW * FF;
constexpr float SC_WGU = 32.f, SC_WD = 64.f, SC_H = 4.f;
constexpr size_t WS_T1 = 200 * MiB, WS_T2 = 328 * MiB;
constexpr size_t WS_YP = WS_R;
constexpr size_t WS_Y = 432 * MiB;
constexpr size_t WS_RT = 570 * MiB;
constexpr size_t WS_ROWTOK = WS_RT, WS_TOKSLOT = WS_RT + 512 * 1024, WS_TOKE = WS_RT + 1024 * 1024, WS_TOKW = WS_RT + 1280 * 1024, WS_CNT = WS_RT + 1536 * 1024, WS_TEXP = WS_RT + 1600 * 1024;
constexpr size_t WS_END = 572 * MiB;
constexpr int LCNT_OFF = 126976;
constexpr int CW_BAR = 4096;

constexpr int RING_BYTES = 131072;
constexpr int LDSCTL_OFF = RING_BYTES, MISC_OFF = LDSCTL_OFF + 320;
constexpr int LDS_BYTES = 147456;
constexpr int NWAVES = 8;

#define LDS_WAIT() asm volatile("s_waitcnt lgkmcnt(0)" ::: "memory")
#define VM_WAIT() asm volatile("s_waitcnt vmcnt(0)" ::: "memory")
__device__ __forceinline__ unsigned f2bf(float f) { unsigned u = __builtin_bit_cast(unsigned, f); return (u + 0x7fffu + ((u >> 16) & 1u)) >> 16; }
__device__ __forceinline__ unsigned pk2(float lo, float hi) { return f2bf(lo) | (f2bf(hi) << 16); }
__device__ __forceinline__ float bf2f(unsigned h) { return __builtin_bit_cast(float, h << 16); }
__device__ __forceinline__ float wave_sum(float v) {
#pragma unroll
    for (int o = 1; o < 64; o <<= 1) v += __shfl_xor(v, o);
    return v;
}

template <int NCH> __host__ __device__ __forceinline__ size_t kimg(int row, int h, int d) {
    const int b = row >> 12, t = row & 4095;
    return (((((size_t)(b * 64 + (t >> 6)) * NH + h) * NCH + (d >> 3)) << 9) + (size_t)(((t & 63) << 3) + (d & 7)));
}

__host__ __device__ __forceinline__ size_t vimg(int row, int h, int d) {
    const int b = row >> 12, t = row & 4095;
    return (((((size_t)(b * 64 + (t >> 6)) * NH + h) * 8 + ((d >> 5) * 4 + ((t >> 4) & 3))) << 9) + (size_t)(((t & 15) << 5) + (d & 31)));
}

namespace pg8 {
#define PG8_LAS __attribute__((address_space(3)))
typedef unsigned short bf16_t;
typedef unsigned u32x4 __attribute__((ext_vector_type(4)));
constexpr int BM = 256, BK = 64, HALF = 128, HTB = HALF * BK * 2, STAGE_BYTES = 8 * HTB, NXCD = 8, WGM = 8;

__host__ __device__ __forceinline__ int lds_byte(int r, int c) { const int st = (r >> 4) * 2 + (c >> 5), rr = r & 15, cc = c & 31, ob = rr * 64 + cc * 2; return st * 1024 + (ob ^ (((ob >> 9) & 1) << 5)); }
__host__ __device__ __forceinline__ void stage_rc(int b, int& R, int& C) { const int st = b / 1024, sb = b % 1024, swz = sb ^ (((sb >> 9) & 1) << 5); R = (st >> 1) * 16 + swz / 64; C = (st & 1) * 32 + (swz % 64) / 2; }
__host__ __device__ __forceinline__ int perm32(int rho) { const int n = rho >> 4, i = rho & 15; return 8 * (i >> 2) + 4 * n + (i & 3); }

__host__ __device__ __forceinline__ size_t btile_off(int n, int kbyte, int Kbytes) {
    const int ht = n >> 7, rp = n & 127, x = rp & 31;
    const int R = (rp & ~31) + 16 * ((x >> 2) & 1) + 4 * (x >> 3) + (x & 3);
    return ((size_t)ht * (Kbytes >> 7) + (kbyte >> 7)) * 16384 + (size_t)lds_byte(R, (kbyte & 127) >> 1);
}

struct Unit { int pm, pn, bsel, part, nt; };
struct Gemm { const bf16_t* A; const bf16_t* Bt; int K; size_t bstride; const int* rowidx; };

struct StaticOrder {
    int nM, nN, nwg, G, c;
    __host__ __device__ void init(int M_, int N_, int G_, int c_) { nM = M_ / BM; nN = N_ / BM; nwg = nM * nN; G = G_; c = c_; }
    __host__ __device__ bool next(int i, Unit& u) const {
        const long L = (long)i * G + c; if (L >= nwg) return false;
        int wgid = (int)L; { const int q = nwg / NXCD, r = nwg % NXCD, xcd = wgid % NXCD, off = wgid / NXCD; wgid = (xcd < r ? xcd * (q + 1) : r * (q + 1) + (xcd - r) * q) + off; }
        const int nig = WGM * nN, gid = wgid / nig, fm = gid * WGM, gsz = (nM - fm) < WGM ? (nM - fm) : WGM;
        u.pm = fm + ((wgid % nig) % gsz); u.pn = (wgid % nig) / gsz; u.bsel = 0; u.part = 0; u.nt = 0; return true;
    }
};

__device__ __forceinline__ unsigned cvt_pk_bf16(float lo, float hi) { unsigned r; asm volatile("v_cvt_pk_bf16_f32 %0, %1, %2" : "=v"(r) : "v"(lo), "v"(hi)); return r; }

template <class Epi, class Sched, bool ALIGN_EPI = false, bool SP2 = false, bool GATHER = false, bool F8 = false, bool SPLITK = false>
__device__ __forceinline__ void gemm_phase(PG8_LAS unsigned char* lds, const Gemm g, const Sched& S, const Epi& E) {
    int tid_ = threadIdx.x; asm volatile("" : "+v"(tid_));
    const int tid = tid_, wid = __builtin_amdgcn_readfirstlane(tid >> 6), lane = tid & 63, wr = wid >> 2, wc = wid & 3, fr = lane & 15, fq = lane >> 4;
    const int K = g.K, nt = K / BK;
    unsigned voffA[2], voffB[2];
#pragma unroll
    for (int i = 0; i < 2; ++i) { int R, C; stage_rc(tid * 16 + i * 8192, R, C); const int Rb = Epi::PERM ? ((R & ~31) + perm32(R & 31)) : R;
        voffA[i] = (unsigned)(R * K + C) * 2u; voffB[i] = (unsigned)(tid * 16 + i * 8192); (void)Rb; }
    asm volatile("" : "+v"(voffA[0]), "+v"(voffA[1]), "+v"(voffB[0]), "+v"(voffB[1]));
    const size_t kstep = (size_t)(BK * 2);
    const size_t kstepB = (size_t)HTB;
    const size_t hstep = (size_t)HALF * K * 2;
    const size_t tstep = 2 * hstep;
    const unsigned ldsw = (unsigned)wid * 1024u;
    int aoff = lds_byte(wr * 64 + fr, fq * 8), boff = lds_byte(wc * 32 + fr, fq * 8);
    asm volatile("" : "+v"(aoff), "+v"(boff));
#define PG8_SA(b, h) (((b) * 2 + (h)) * HTB)
#define PG8_SB(b, h) ((4 + (b) * 2 + (h)) * HTB)
#define PG8_STAGE(bufoff, gbase, voff) do { _Pragma("unroll") for (int _i = 0; _i < 2; ++_i) \
        __builtin_amdgcn_global_load_lds((const unsigned*)((const char*)(gbase) + (voff)[_i]), (PG8_LAS unsigned*)(lds + (bufoff) + ldsw + _i * 8192), 16, 0, 0); } while (0)
    unsigned gofC[2][2] = {{0u, 0u}, {0u, 0u}}, gofN[2][2] = {{0u, 0u}, {0u, 0u}}; int gR[2] = {0, 0}; unsigned gC[2] = {0u, 0u};
    if constexpr (GATHER) {
#pragma unroll
        for (int i = 0; i < 2; ++i) { int R, C; stage_rc(tid * 16 + i * 8192, R, C); gR[i] = R; gC[i] = (unsigned)C * 2u; }
        asm volatile("" : "+v"(gR[0]), "+v"(gR[1]), "+v"(gC[0]), "+v"(gC[1]));
    }
#define PG8_GOF(dst, unit) do { _Pragma("unroll") for (int _h = 0; _h < 2; ++_h) _Pragma("unroll") for (int _i = 0; _i < 2; ++_i) { int _t = g.rowidx[(unit).pm * BM + _h * HALF + gR[_i]]; _t = _t < 0 ? 0 : _t; \
        dst[_h][_i] = (unsigned)_t * (unsigned)(K * 2) + gC[_i]; } } while (0)
#define PG8_GTOK(dst, unit) do { _Pragma("unroll") for (int _h = 0; _h < 2; ++_h) _Pragma("unroll") for (int _i = 0; _i < 2; ++_i) dst[_h][_i] = (unsigned)g.rowidx[(unit).pm * BM + _h * HALF + gR[_i]]; } while (0)
#define PG8_GCVT(dst) do { _Pragma("unroll") for (int _h = 0; _h < 2; ++_h) _Pragma("unroll") for (int _i = 0; _i < 2; ++_i) { int _t = (int)dst[_h][_i]; _t = _t < 0 ? 0 : _t; dst[_h][_i] = (unsigned)_t * (unsigned)(K * 2) + gC[_i]; } } while (0)
#define PG8_STAGE_A(bufoff, tptr, h, kb, nx) do { if constexpr (GATHER) { _Pragma("unroll") for (int _i = 0; _i < 2; ++_i) { const unsigned _o = (nx) ? gofN[h][_i] : gofC[h][_i]; \
        __builtin_amdgcn_global_load_lds((const unsigned*)((const char*)g.A + (kb) + _o), (PG8_LAS unsigned*)(lds + (bufoff) + ldsw + _i * 8192), 16, 0, 0); } } \
        else PG8_STAGE(bufoff, (tptr) + (h) * hstep, voffA); } while (0)
#define PG8_LD32(p) __builtin_shufflevector(*(const PG8_LAS v4i*)(p), *(const PG8_LAS v4i*)((p) + 1024), 0, 1, 2, 3, 4, 5, 6, 7)
#define PG8_LDA(dst, b, h) do { if constexpr (F8) { _Pragma("unroll") for (int m = 0; m < 4; ++m) dst##8[m] = PG8_LD32(lds + PG8_SA(b, h) + aoff + m * 2048); } \
        else { _Pragma("unroll") for (int m = 0; m < 4; ++m) _Pragma("unroll") for (int k = 0; k < 2; ++k) dst[m][k] = *(const PG8_LAS bf16x8*)(lds + PG8_SA(b, h) + aoff + m * 2048 + k * 1024); } } while (0)
#define PG8_LDB(dst, b, h) do { if constexpr (F8) { _Pragma("unroll") for (int n = 0; n < 2; ++n) dst##8[n] = PG8_LD32(lds + PG8_SB(b, h) + boff + n * 2048); } \
        else { _Pragma("unroll") for (int n = 0; n < 2; ++n) _Pragma("unroll") for (int k = 0; k < 2; ++k) dst[n][k] = *(const PG8_LAS bf16x8*)(lds + PG8_SB(b, h) + boff + n * 2048 + k * 1024); } } while (0)
#define PG8_MMA(ai, bj, At, Bt) do { __builtin_amdgcn_s_setprio(1); if constexpr (F8) { _Pragma("unroll") for (int m = 0; m < 4; ++m) _Pragma("unroll") for (int n = 0; n < 2; ++n) \
            asm volatile("v_mfma_scale_f32_16x16x128_f8f6f4 %0, %1, %2, %0, %3, %4 op_sel_hi:[0,0,0]" : "+v"(acc[ai][bj][m][n]) : "v"(Bt##8[n]), "v"(At##8[m]), "v"((bj) == 0 ? f8scl : f8scl1), "v"(f8one)); } \
        else { _Pragma("unroll") for (int m = 0; m < 4; ++m) _Pragma("unroll") for (int n = 0; n < 2; ++n) _Pragma("unroll") for (int k = 0; k < 2; ++k) \
            acc[ai][bj][m][n] = __builtin_amdgcn_mfma_f32_16x16x32_bf16(Bt[n][k], At[m][k], acc[ai][bj][m][n], 0, 0, 0); } __builtin_amdgcn_s_setprio(0); } while (0)
#define PG8_WAIT_V(n) asm volatile("s_waitcnt vmcnt(" #n ")" ::: "memory")
#define PG8_WAIT_L(n) asm volatile("s_waitcnt lgkmcnt(" #n ")" ::: "memory")
#define PG8_WAIT_V8P(post) do { if (post) asm volatile("s_waitcnt vmcnt(%0)" :: "n"(8 + Epi::NS) : "memory"); else asm volatile("s_waitcnt vmcnt(8)" ::: "memory"); } while (0)
#define PG8_BAR __builtin_amdgcn_s_barrier()
#define PG8_SCHED __builtin_amdgcn_sched_barrier(0)
    Unit cur, nxt; int ui = 0;
    if (!S.next(0, cur)) return;
    f32x4 acc[2][2][4][2];
#pragma unroll
    for (int a = 0; a < 2; ++a)
#pragma unroll
        for (int b = 0; b < 2; ++b)
#pragma unroll
            for (int m = 0; m < 4; ++m)
#pragma unroll
                for (int n = 0; n < 2; ++n) acc[a][b][m][n] = (f32x4){0.f, 0.f, 0.f, 0.f};
    bf16x8 At[4][2], B0[2][2], B1[2][2]; v8i At8[4], B08[2], B18[2];
    int f8scl = 0x7F7F7F7F, f8scl1 = 0x7F7F7F7F, f8one = 0x7F7F7F7F;
    if constexpr (F8) { f8scl = Epi::SCL0; f8scl1 = Epi::SCL1; }
    asm volatile("" : "+v"(f8scl), "+v"(f8scl1), "+v"(f8one));
    int ntc = nt; size_t kofc = 0;
    size_t kofcB = 0; if constexpr (SPLITK) { ntc = cur.nt; kofc = (size_t)(cur.part * cur.nt) * kstep; kofcB = (size_t)(cur.part * cur.nt) * kstepB; }
    const char* cA = (const char*)g.A + (size_t)cur.pm * tstep + kofc; const char* cB = (const char*)g.Bt + (size_t)cur.bsel * g.bstride + (size_t)cur.pn * tstep + kofcB;
    if constexpr (GATHER) { PG8_GOF(gofC, cur); }
    if constexpr (SP2) {
        PG8_STAGE(PG8_SB(0, 0), cB, voffB); PG8_STAGE(PG8_SB(0, 1), cB + hstep, voffB); PG8_STAGE_A(PG8_SA(0, 0), cA, 0, 0, false); PG8_STAGE_A(PG8_SA(0, 1), cA, 1, 0, false);
        if (wr == 1) PG8_BAR;
        PG8_WAIT_V(2); PG8_BAR;
        PG8_STAGE(PG8_SB(1, 0), cB + kstepB, voffB); PG8_STAGE_A(PG8_SA(1, 0), cA + kstep, 0, kstep, false); PG8_STAGE(PG8_SB(1, 1), cB + hstep + kstepB, voffB);
        PG8_WAIT_V(6); PG8_BAR;
    } else {
        PG8_STAGE(PG8_SB(0, 0), cB, voffB); PG8_STAGE(PG8_SA(0, 0), cA, voffA); PG8_STAGE(PG8_SB(0, 1), cB + hstep, voffB); PG8_STAGE(PG8_SA(0, 1), cA + hstep, voffA);
        if (wr == 1) PG8_BAR;
        PG8_WAIT_V(4); PG8_BAR;
        PG8_STAGE(PG8_SB(1, 0), cB + kstepB, voffB); PG8_STAGE(PG8_SA(1, 0), cA + kstep, voffA); PG8_STAGE(PG8_SB(1, 1), cB + hstep + kstepB, voffB);
        PG8_WAIT_V(6); PG8_BAR;
    }
    for (;;) {
        const bool has_next = S.next(ui + 1, nxt);
        if constexpr (GATHER) { if (has_next) { PG8_GTOK(gofN, nxt); } }
        size_t kofn = 0, kofnB = 0; if constexpr (SPLITK) { if (has_next) { kofn = (size_t)(nxt.part * nxt.nt) * kstep; kofnB = (size_t)(nxt.part * nxt.nt) * kstepB; } }
        const char* nA = has_next ? (const char*)g.A + (size_t)nxt.pm * tstep + kofn : cA; const char* nB = has_next ? (const char*)g.Bt + (size_t)nxt.bsel * g.bstride + (size_t)nxt.pn * tstep + kofnB : cB;
#pragma unroll 1
        for (int t = 0; t < ntc; t += 2) {
            const bool last = (t == ntc - 2);
            const char* a1 = cA + (size_t)(t + 1) * kstep;
            const char* a2 = last ? nA : cA + (size_t)(t + 2) * kstep; const char* b2 = last ? nB : cB + (size_t)(t + 2) * kstepB;
            const char* a3 = a2 + kstep; const char* b3 = b2 + kstepB;
            if constexpr (GATHER) { if (last && has_next) { PG8_GCVT(gofN); } }
            if constexpr (Epi::MID) { if (t == nt / 2) E.mid(acc, cur, wr, wc, fr, fq); }
            const size_t k1 = (size_t)(t + 1) * kstep, k2 = last ? (size_t)0 : (size_t)(t + 2) * kstep, k3 = k2 + kstep; const bool nx = last && has_next;
            if constexpr (SP2) {
            const bool post = (t == 0) && (ui > 0);
            PG8_LDB(B0, 0, 0); PG8_LDB(B1, 0, 1); PG8_SCHED; PG8_LDA(At, 0, 0); PG8_STAGE_A(PG8_SA(1, 1), a1, 1, k1, false);
            PG8_WAIT_V8P(post); PG8_WAIT_L(0); PG8_BAR; PG8_MMA(0, 0, At, B0); PG8_MMA(0, 1, At, B1); PG8_BAR; PG8_SCHED;
            PG8_LDA(At, 0, 1); PG8_STAGE(PG8_SB(0, 0), b2, voffB); PG8_STAGE(PG8_SB(0, 1), b2 + hstep, voffB); PG8_STAGE_A(PG8_SA(0, 0), a2, 0, k2, nx);
            PG8_WAIT_V8P(post); PG8_WAIT_L(0); PG8_BAR; PG8_MMA(1, 0, At, B0); PG8_MMA(1, 1, At, B1); PG8_BAR; PG8_SCHED;
            PG8_LDB(B0, 1, 0); PG8_LDB(B1, 1, 1); PG8_SCHED; PG8_LDA(At, 1, 0); PG8_STAGE_A(PG8_SA(0, 1), a2, 1, k2, nx);
            PG8_WAIT_V(8); PG8_WAIT_L(0); PG8_BAR; PG8_MMA(0, 0, At, B0); PG8_MMA(0, 1, At, B1); PG8_BAR; PG8_SCHED;
            PG8_LDA(At, 1, 1); PG8_STAGE(PG8_SB(1, 0), b3, voffB); PG8_STAGE(PG8_SB(1, 1), b3 + hstep, voffB); PG8_STAGE_A(PG8_SA(1, 0), a3, 0, k3, nx);
            PG8_WAIT_V(8); PG8_WAIT_L(0); PG8_BAR; PG8_MMA(1, 0, At, B0); PG8_MMA(1, 1, At, B1); PG8_BAR; PG8_SCHED;
            } else {
            static_assert(!GATHER || SP2, "GATHER is wired into the SP2 loop only");
            PG8_LDB(B0, 0, 0); PG8_SCHED; PG8_LDA(At, 0, 0); PG8_STAGE(PG8_SA(1, 1), a1 + hstep, voffA);
            PG8_WAIT_L(8); PG8_BAR; PG8_WAIT_L(0); PG8_MMA(0, 0, At, B0); PG8_BAR; PG8_SCHED;
            PG8_LDB(B1, 0, 1); PG8_STAGE(PG8_SB(0, 0), b2, voffB);
            PG8_BAR; PG8_WAIT_L(0); PG8_MMA(0, 1, At, B1); PG8_BAR;
            PG8_LDA(At, 0, 1); PG8_STAGE(PG8_SA(0, 0), a2, voffA);
            PG8_BAR; PG8_WAIT_L(0); PG8_MMA(1, 0, At, B0); PG8_BAR; PG8_SCHED;
            PG8_STAGE(PG8_SB(0, 1), b2 + hstep, voffB);
            PG8_WAIT_V(6); PG8_BAR; PG8_MMA(1, 1, At, B1); PG8_BAR;
            PG8_LDB(B0, 1, 0); PG8_SCHED; PG8_LDA(At, 1, 0); PG8_STAGE(PG8_SA(0, 1), a2 + hstep, voffA);
            PG8_WAIT_L(8); PG8_BAR; PG8_WAIT_L(0); PG8_MMA(0, 0, At, B0); PG8_BAR; PG8_SCHED;
            PG8_LDB(B1, 1, 1); PG8_STAGE(PG8_SB(1, 0), b3, voffB);
            PG8_BAR; PG8_WAIT_L(0); PG8_MMA(0, 1, At, B1); PG8_BAR;
            PG8_LDA(At, 1, 1); PG8_STAGE(PG8_SA(1, 0), a3, voffA);
            PG8_BAR; PG8_WAIT_L(0); PG8_MMA(1, 0, At, B0); PG8_BAR; PG8_SCHED;
            PG8_STAGE(PG8_SB(1, 1), b3 + hstep, voffB);
            PG8_WAIT_V(6); PG8_BAR; PG8_MMA(1, 1, At, B1); PG8_BAR;
            }
        }
        if constexpr (ALIGN_EPI) { if (wr == 0) PG8_BAR; }
        if constexpr (F8) asm volatile("s_nop 15\n\ts_nop 15" ::: "memory");
        E(acc, cur, wr, wc, fr, fq);
        if (!has_next) break;
#pragma unroll
        for (int a = 0; a < 2; ++a)
#pragma unroll
            for (int b = 0; b < 2; ++b)
#pragma unroll
                for (int m = 0; m < 4; ++m)
#pragma unroll
                    for (int n = 0; n < 2; ++n) acc[a][b][m][n] = (f32x4){0.f, 0.f, 0.f, 0.f};
        cur = nxt; cA = nA; cB = nB; ++ui; if constexpr (SPLITK) ntc = cur.nt;
        if constexpr (GATHER) { _Pragma("unroll") for (int _h = 0; _h < 2; ++_h) _Pragma("unroll") for (int _i = 0; _i < 2; ++_i) gofC[_h][_i] = gofN[_h][_i]; }
        if constexpr (ALIGN_EPI) { if (wr == 1) PG8_BAR; }
    }
    PG8_WAIT_V(0);
    if constexpr (!ALIGN_EPI) { if (wr == 0) PG8_BAR; }
    PG8_BAR;
#undef PG8_SA
#undef PG8_SB
#undef PG8_STAGE
#undef PG8_STAGE_A
#undef PG8_GOF
#undef PG8_GTOK
#undef PG8_GCVT
#undef PG8_LDA
#undef PG8_LD32
#undef PG8_LDB
#undef PG8_MMA
#undef PG8_WAIT_V
#undef PG8_WAIT_L
#undef PG8_WAIT_V8P
#undef PG8_BAR
#undef PG8_SCHED
}

#define EPI_ROWS(...) _Pragma("unroll") for (int ai = 0; ai < 2; ++ai) _Pragma("unroll") for (int m = 0; m < 4; ++m) { const int row = row0 + ai * HALF + m * 16; \
        _Pragma("unroll") for (int bj = 0; bj < 2; ++bj) { const int c = bj * HALF + wc * 32 + 8 * fq; f32x4 v0 = acc[ai][bj][m][0], v1 = acc[ai][bj][m][1]; __VA_ARGS__ } }
__device__ __forceinline__ u32x4 pack8(f32x4 v0, f32x4 v1) { u32x4 w; w.x = cvt_pk_bf16(v0[0], v0[1]); w.y = cvt_pk_bf16(v0[2], v0[3]); w.z = cvt_pk_bf16(v1[0], v1[1]); w.w = cvt_pk_bf16(v1[2], v1[3]); return w; }

__device__ __forceinline__ float ssq8(f32x4 a, f32x4 b) { return (a[0] * a[0] + a[1] * a[1]) + (a[2] * a[2] + a[3] * a[3]) + (b[0] * b[0] + b[1] * b[1]) + (b[2] * b[2] + b[3] * b[3]); }
struct EpiInproj { static constexpr bool PERM = true; static constexpr bool MID = false; static constexpr int NS = 16;
    bf16_t *CQ, *CKV, *KM; float *SSQQ, *SSQKV, *FLOG; const float* ROPE; bf16_t *QF, *KF, *VF;
    __device__ __forceinline__ void operator()(const f32x4 (&acc)[2][2][4][2], const Unit& u, int wr, int wc, int fr, int fq_) const {
        int row0 = u.pm * BM + wr * 64 + fr, fq = fq_; asm volatile("" : "+v"(row0), "+v"(fq));
        if (u.pn == 0) {
#pragma unroll
            for (int ai = 0; ai < 2; ++ai)
#pragma unroll
                for (int m = 0; m < 4; ++m) { const int row = row0 + ai * HALF + m * 16; float ss = 0.f;
#pragma unroll
                    for (int bj = 0; bj < 2; ++bj) { const int c = bj * HALF + wc * 32 + 8 * fq; const f32x4 v0 = acc[ai][bj][m][0], v1 = acc[ai][bj][m][1];
                        *(u32x4*)(CQ + (size_t)row * 256 + c) = pack8(v0, v1); ss += ssq8(v0, v1); }
                    ss += __shfl_xor(ss, 16); ss += __shfl_xor(ss, 32);
                    if (fq == 0) SSQQ[(size_t)row * 4 + wc] = ss; }
        } else if (u.pn == 1) {
#pragma unroll
            for (int ai = 0; ai < 2; ++ai)
#pragma unroll
                for (int m = 0; m < 4; ++m) { const int row = row0 + ai * HALF + m * 16; const int c = wc * 32 + 8 * fq;
                    { const f32x4 v0 = acc[ai][0][m][0], v1 = acc[ai][0][m][1]; *(u32x4*)(CKV + (size_t)row * 128 + c) = pack8(v0, v1);
                      float ss = ssq8(v0, v1); ss += __shfl_xor(ss, 16); ss += __shfl_xor(ss, 32); if (fq == 0) SSQKV[(size_t)row * 4 + wc] = ss; }
                    const f32x4 v0 = acc[ai][1][m][0], v1 = acc[ai][1][m][1];
                    if (wc == 0) { const f32x4* rp = (const f32x4*)(ROPE + (size_t)row * 32 + 8 * fq); const f32x4 r0 = rp[0], r1 = rp[1]; f32x4 o0, o1;
                        o0[0] = v0[0] * r0[0] - v0[1] * r0[1]; o0[1] = v0[0] * r0[1] + v0[1] * r0[0]; o0[2] = v0[2] * r0[2] - v0[3] * r0[3]; o0[3] = v0[2] * r0[3] + v0[3] * r0[2];
                        o1[0] = v1[0] * r1[0] - v1[1] * r1[1]; o1[1] = v1[0] * r1[1] + v1[1] * r1[0]; o1[2] = v1[2] * r1[2] - v1[3] * r1[3]; o1[3] = v1[2] * r1[3] + v1[3] * r1[2];
                        const u32x4 w = pack8(o0, o1);
#pragma unroll
                        for (int h = 0; h < 8; ++h) *(u32x4*)(KM + kimg<12>(row, h, 64 + 8 * fq)) = w; }
                    else if (wc == 1 && fq == 0) { float* p = FLOG + (size_t)row * 8; *(f32x4*)p = v0; *(f32x4*)(p + 4) = v1; } }
        } else {
            const int grp = (u.pn >> 1) - 1, cb = (u.pn & 1) * 256;
            if (grp == 0)      { EPI_ROWS( const int cc = cb + c; v0 = v0 * C2F; v1 = v1 * C2F; *(u32x4*)(QF + (size_t)row * QF_P + (cc >> 6) * 80 + (cc & 63)) = pack8(v0, v1); ) }
            else if (grp == 1) { EPI_ROWS( const int cc = cb + c; *(u32x4*)(KF + kimg<10>(row, cc >> 6, cc & 63)) = pack8(v0, v1); ) }
            else               { EPI_ROWS( const int cc = cb + c; *(u32x4*)(VF + vimg(row, cc >> 6, cc & 63)) = pack8(v0, v1); ) }
        }
    }
};
struct EpiQ { static constexpr bool PERM = true; static constexpr bool MID = false; static constexpr int NS = 16;
    bf16_t* QM; const float* ROPE; const float* SSQ;
    __device__ __forceinline__ float rs(int row) const { const f32x4 p = *(const f32x4*)(SSQ + (size_t)row * 4); return C2M / sqrtf(((p[0] + p[1]) + (p[2] + p[3])) * (1.f / 256.f) + EPS); }
    __device__ __forceinline__ void operator()(const f32x4 (&acc)[2][2][4][2], const Unit& u, int wr, int wc, int fr, int fq) const {
        const int row0 = u.pm * BM + wr * 64 + fr;
        if (u.pn < 2) {
            EPI_ROWS( const int cc = u.pn * 256 + c; const float C2M = rs(row); v0 = v0 * C2M; v1 = v1 * C2M; *(u32x4*)(QM + (size_t)row * QM_P + (cc >> 6) * 96 + (cc & 63)) = pack8(v0, v1); )
        } else {
            EPI_ROWS( const int h = c >> 5, p0 = c & 31; const float C2M = rs(row); const f32x4* rp = (const f32x4*)(ROPE + (size_t)row * 32 + p0);
                const f32x4 r0 = rp[0], r1 = rp[1]; f32x4 o0, o1;
                o0[0] = v0[0] * r0[0] - v0[1] * r0[1]; o0[1] = v0[0] * r0[1] + v0[1] * r0[0]; o0[2] = v0[2] * r0[2] - v0[3] * r0[3]; o0[3] = v0[2] * r0[3] + v0[3] * r0[2];
                o1[0] = v1[0] * r1[0] - v1[1] * r1[1]; o1[1] = v1[0] * r1[1] + v1[1] * r1[0]; o1[2] = v1[2] * r1[2] - v1[3] * r1[3]; o1[3] = v1[2] * r1[3] + v1[3] * r1[2];
                o0 = o0 * C2M; o1 = o1 * C2M; *(u32x4*)(QM + (size_t)row * QM_P + h * 96 + 64 + p0) = pack8(o0, o1); )
        }
    }
};
struct EpiKV { static constexpr bool PERM = true; static constexpr bool MID = false; static constexpr int NS = 16;
    bf16_t *KM, *VM; const float* SSQ;
    __device__ __forceinline__ float rs(int row) const { const f32x4 p = *(const f32x4*)(SSQ + (size_t)row * 4); return 1.f / sqrtf(((p[0] + p[1]) + (p[2] + p[3])) * (1.f / 128.f) + EPS); }
    __device__ __forceinline__ void operator()(const f32x4 (&acc)[2][2][4][2], const Unit& u, int wr, int wc, int fr, int fq_) const {
        int row0 = u.pm * BM + wr * 64 + fr, fq = fq_; asm volatile("" : "+v"(row0), "+v"(fq));
        if (u.pn < 2) { EPI_ROWS( const int cc = u.pn * 256 + c; const float r = rs(row); v0 = v0 * r; v1 = v1 * r; *(u32x4*)(KM + kimg<12>(row, cc >> 6, cc & 63)) = pack8(v0, v1); ) }
        else          { EPI_ROWS( const int cc = (u.pn - 2) * 256 + c; const float r = rs(row); v0 = v0 * r; v1 = v1 * r; *(u32x4*)(VM + vimg(row, cc >> 6, cc & 63)) = pack8(v0, v1); ) }
    }
};
struct EpiResid { static constexpr bool PERM = true; static constexpr bool MID = false; static constexpr int NS = 0;
    const float* Xin; float* Xout; const float* gate  ; const float* rowscale; int rs_stride;
    __device__ __forceinline__ void operator()(const f32x4 (&acc)[2][2][4][2], const Unit& u, int wr, int wc, int fr, int fq) const {
        const int row0 = u.pm * BM + wr * 64 + fr; const int b = (u.pm * BM) >> 12;
        const float* gp = gate + (size_t)b * 6144 + u.pn * 256;
        EPI_ROWS( const f32x4 g0 = *(const f32x4*)(gp + c), g1 = *(const f32x4*)(gp + c + 4); const size_t off = (size_t)row * DM + u.pn * 256 + c;
            float rs = 1.f; if (rowscale) rs = rowscale[(size_t)row * rs_stride];
            const f32x4 x0 = *(const f32x4*)(Xin + off), x1 = *(const f32x4*)(Xin + off + 4);
            *(f32x4*)(Xout + off) = x0 + g0 * (v0 * rs); *(f32x4*)(Xout + off + 4) = x1 + g1 * (v1 * rs); )
    }
};
struct EpiSwiglu { static constexpr bool PERM = true; static constexpr bool MID = false; static constexpr int NS = 8;
    bf16_t* H;
    __device__ __forceinline__ void operator()(const f32x4 (&acc)[2][2][4][2], const Unit& u, int wr, int wc, int fr, int fq) const {
        const int row0 = u.pm * BM + wr * 64 + fr;
#pragma unroll
        for (int ai = 0; ai < 2; ++ai)
#pragma unroll
            for (int m = 0; m < 4; ++m) { const int row = row0 + ai * HALF + m * 16; f32x4 h[2];
#pragma unroll
                for (int n = 0; n < 2; ++n) { const f32x4 gv = acc[ai][0][m][n], uv = acc[ai][1][m][n];
#pragma unroll
                    for (int j = 0; j < 4; ++j) { const float e = __builtin_amdgcn_exp2f(-gv[j] * LOG2E); h[n][j] = gv[j] * __builtin_amdgcn_rcpf(1.f + e) * uv[j]; } }
                *(u32x4*)(H + (size_t)row * FF + u.pn * 128 + wc * 32 + 8 * fq) = pack8(h[0], h[1]); }
    }
};
struct EpiBf16Plain { static constexpr bool PERM = true; static constexpr bool MID = false; static constexpr int NS = 16; static constexpr int SCL0 = 0x7F7F7F7F, SCL1 = 0x7F7F7F7F;
    bf16_t* O; int ldc; float scale;
    __device__ __forceinline__ void operator()(const f32x4 (&acc)[2][2][4][2], const Unit& u, int wr, int wc, int fr, int fq) const {
        const int row0 = u.pm * BM + wr * 64 + fr;
        EPI_ROWS( v0 = v0 * scale; v1 = v1 * scale; *(u32x4*)(O + (size_t)row * ldc + u.pn * 256 + c) = pack8(v0, v1); )
    }
};
struct EpiWo { static constexpr bool PERM = true; static constexpr bool MID = true; static constexpr int NS = 16;
    bf16_t* O; const float* SSQ;
    __device__ __forceinline__ void sums(int row, float& s1, float& s2) const { const f32x4* p = (const f32x4*)(SSQ + (size_t)row * 16); const f32x4 a = p[0], b = p[1], c = p[2], d = p[3];
        s1 = ((a[0] + a[1]) + (a[2] + a[3])) + ((b[0] + b[1]) + (b[2] + b[3])); s2 = ((c[0] + c[1]) + (c[2] + c[3])) + ((d[0] + d[1]) + (d[2] + d[3])); }
    __device__ __forceinline__ void mid(f32x4 (&acc)[2][2][4][2], const Unit& u, int wr, int wc, int fr, int fq) const {
        int row0 = u.pm * BM + wr * 64 + fr; asm volatile("" : "+v"(row0));
#pragma unroll
        for (int ai = 0; ai < 2; ++ai)
#pragma unroll
            for (int m = 0; m < 4; ++m) { float s1, s2; sums(row0 + ai * HALF + m * 16, s1, s2); const float ratio = sqrtf((s2 * (1.f / 512.f) + EPS) / (s1 * (1.f / 512.f) + EPS));
#pragma unroll
                for (int bj = 0; bj < 2; ++bj)
#pragma unroll
                    for (int n = 0; n < 2; ++n) acc[ai][bj][m][n] = acc[ai][bj][m][n] * ratio;
                asm volatile("" : "+v"(acc[ai][0][m][0]), "+v"(acc[ai][0][m][1]), "+v"(acc[ai][1][m][0]), "+v"(acc[ai][1][m][1]) :: "memory"); }
    }
    __device__ __forceinline__ void operator()(const f32x4 (&acc)[2][2][4][2], const Unit& u, int wr, int wc, int fr, int fq) const {
        int row0 = u.pm * BM + wr * 64 + fr; asm volatile("" : "+v"(row0));
#pragma unroll
        for (int ai = 0; ai < 2; ++ai)
#pragma unroll
            for (int m = 0; m < 4; ++m) { const int row = row0 + ai * HALF + m * 16; float s1, s2; sums(row, s1, s2); const float r2 = 1.f / sqrtf(s2 * (1.f / 512.f) + EPS);
#pragma unroll
                for (int bj = 0; bj < 2; ++bj) { const int c = bj * HALF + wc * 32 + 8 * fq; *(u32x4*)(O + (size_t)row * DM + u.pn * 256 + c) = pack8(acc[ai][bj][m][0] * r2, acc[ai][bj][m][1] * r2); } }
    }
};
struct EpiSwigluF8 { static constexpr bool PERM = true; static constexpr bool MID = false; static constexpr int NS = 8; static constexpr int SCL0 = 0x7A7A7A7A, SCL1 = 0x7C7C7C7C;
    unsigned char* H;
    __device__ __forceinline__ void operator()(const f32x4 (&acc)[2][2][4][2], const Unit& u, int wr, int wc, int fr, int fq) const {
        const int row0 = u.pm * BM + wr * 64 + fr;
#pragma unroll
        for (int ai = 0; ai < 2; ++ai)
#pragma unroll
            for (int m = 0; m < 4; ++m) { const int row = row0 + ai * HALF + m * 16; float h[8];
#pragma unroll
                for (int n = 0; n < 2; ++n) { const f32x4 ga = acc[ai][0][m][n], ua = acc[ai][1][m][n];
#pragma unroll
                    for (int j = 0; j < 4; ++j) { const float e = __builtin_amdgcn_exp2f(ga[j]); const float hv = (ga[j] * ua[j]) * __builtin_amdgcn_rcpf(1.f + e);
                        h[4 * n + j] = __builtin_amdgcn_fmed3f(hv, -448.f, 448.f); } }
                int w0 = 0, w1 = 0;
                w0 = __builtin_amdgcn_cvt_pk_fp8_f32(h[0], h[1], w0, false); w0 = __builtin_amdgcn_cvt_pk_fp8_f32(h[2], h[3], w0, true);
                w1 = __builtin_amdgcn_cvt_pk_fp8_f32(h[4], h[5], w1, false); w1 = __builtin_amdgcn_cvt_pk_fp8_f32(h[6], h[7], w1, true);
                *(v2u*)(H + (size_t)row * FF + u.pn * 128 + wc * 32 + 8 * fq) = (v2u){(unsigned)w0, (unsigned)w1}; }
    }
};
struct MoeOrder : StaticOrder {
    int tend[8];
    __device__ __forceinline__ void load(const int* texp) {
#pragma unroll
        for (int e = 0; e < 8; ++e) tend[e] = __builtin_amdgcn_readfirstlane(texp[1 + e]); }
    __device__ __forceinline__ bool next(int i, Unit& u) const { if (!StaticOrder::next(i, u)) return false; int b = 0;
#pragma unroll
        for (int e = 0; e < 7; ++e) b += (u.pm >= tend[e]) ? 1 : 0;
        u.bsel = b; return true; }
};
struct EpiMoeDown { static constexpr bool PERM = true; static constexpr bool MID = false; static constexpr int NS = 0;
    float* X; const float* gate; const int* rowtok; const float* roww; float oscale;
    __device__ __forceinline__ void operator()(const f32x4 (&acc)[2][2][4][2], const Unit& u, int wr, int wc, int fr, int fq) const {
        const int row0 = u.pm * BM + wr * 64 + fr;
#pragma unroll
        for (int ai = 0; ai < 2; ++ai)
#pragma unroll
            for (int m = 0; m < 4; ++m) { const int slot = row0 + ai * HALF + m * 16; const int tok = rowtok[slot];
                if (tok >= 0) { const float w = roww[slot] * oscale; const float* gp = gate + (size_t)(tok >> 12) * 6144 + u.pn * 256; float* xp = X + (size_t)tok * DM + u.pn * 256;
#pragma unroll
                    for (int bj = 0; bj < 2; ++bj) { const int c = bj * HALF + wc * 32 + 8 * fq; const f32x4 v0 = acc[ai][bj][m][0], v1 = acc[ai][bj][m][1];
                        const f32x4 g0 = *(const f32x4*)(gp + c), g1 = *(const f32x4*)(gp + c + 4); const f32x4 x0 = *(const f32x4*)(xp + c), x1 = *(const f32x4*)(xp + c + 4);
                        *(f32x4*)(xp + c) = x0 + g0 * (v0 * w); *(f32x4*)(xp + c + 4) = x1 + g1 * (v1 * w); } } }
    }
};
struct MoeOrderD : MoeOrder {
    int mainU, mainM, tailSub, S, NT;
    __device__ __forceinline__ void init_d(int ntile, int NT_, int G_, int c_) {
        NT = NT_; const int per = G_ / 4; int tailM = (G_ % 4 == 0) ? ntile % per : 0; const int U = 4 * tailM;
        S = (7 * U <= G_ && NT_ % 14 == 0) ? 7 : ((2 * U <= G_ && NT_ % 4 == 0) ? 2 : 1); if (S == 1) tailM = 0;
        mainM = ntile - tailM; mainU = 4 * mainM; tailSub = 4 * tailM * S;
        StaticOrder::init(mainM * BM, 4 * BM, G_, c_); }
    __device__ __forceinline__ bool next(int i, Unit& u) const {
        const long L = (long)i * G + c;
        if (L < mainU) { StaticOrder::next(i, u); u.nt = NT; }
        else { const int j = (int)(L - mainU); if (j >= tailSub) return false;
            const int uu = j / S; u.part = j - uu * S; u.pm = mainM + (uu >> 2); u.pn = uu & 3; u.nt = NT / S; }
        int b = 0;
#pragma unroll
        for (int e = 0; e < 7; ++e) b += (u.pm >= tend[e]) ? 1 : 0;
        u.bsel = b; return true; }
};
struct EpiMoeY { static constexpr bool PERM = true; static constexpr bool MID = false; static constexpr int NS = 16; static constexpr int SCL0 = 0x7F7F7F7F, SCL1 = 0x7F7F7F7F;
    bf16_t* Y; bf16_t* Yp; int tail0; size_t pstride; float scale;
    __device__ __forceinline__ void operator()(const f32x4 (&acc)[2][2][4][2], const Unit& u, int wr, int wc, int fr, int fq) const {
        const int row0 = u.pm * BM + wr * 64 + fr;
        bf16_t* O = (u.part == 0) ? Y : Yp + (size_t)(u.part - 1) * pstride - (size_t)tail0 * DM;
        EPI_ROWS( v0 = v0 * scale; v1 = v1 * scale; *(u32x4*)(O + (size_t)row * DM + u.pn * 256 + c) = pack8(v0, v1); )
    }
};
}

#define XB_TMO      128
#define XB_XCNT(j)  (256  + 64 * (j))
#define XB_XSUB(j)  (1280 + 64 * (j))
#define XB_XGEN(j)  (2304 + 64 * (j))
#define XB_TOP      3328
#define XB_TOPGEN   3392
#define XCD_BAR_WORDS 3456
#define XB_SPIN_CAP (1u << 22)

__device__ __forceinline__ unsigned xb_ld(unsigned* p)              { return __hip_atomic_load(p, __ATOMIC_RELAXED, __HIP_MEMORY_SCOPE_AGENT); }
__device__ __forceinline__ unsigned xb_add(unsigned* p, unsigned v) { return __hip_atomic_fetch_add(p, v, __ATOMIC_RELAXED, __HIP_MEMORY_SCOPE_AGENT); }
__device__ __forceinline__ unsigned xb_xcc_id() { return (unsigned)__builtin_amdgcn_s_getreg((3 << 11) | 20) & 0xFu; }
#define XB_SPIN(cond, bar) do { unsigned _sp = 0; while (cond) { __builtin_amdgcn_s_sleep(1); \
    if ((++_sp & 255u) == 0u) { if (xb_ld(&(bar)[XB_TMO])) break; if (_sp > XB_SPIN_CAP) { atomicAdd(&(bar)[XB_TMO], 1u); break; } } } } while (0)

struct XcdBarrier { unsigned* bar; unsigned x; volatile LAS unsigned* st; };

__device__ __forceinline__ XcdBarrier xcd_barrier_post(unsigned* bar, volatile LAS unsigned* st) {
    XcdBarrier b; b.bar = bar; b.x = xb_xcc_id(); b.st = st;
    if (threadIdx.x == 0) (void)xb_add(&bar[XB_XCNT(b.x)], 1u);
    return b;
}
__device__ __forceinline__ void xcd_barrier_complete(unsigned* bar, unsigned x, unsigned& nloc, unsigned& nx) {
    const unsigned G = gridDim.x * gridDim.y * gridDim.z;
    unsigned sum, cnt, mine, sp = 0u;
    for (;;) {
        sum = 0u; cnt = 0u; mine = 0u;
#pragma unroll
        for (unsigned j = 0; j < 16; ++j) { const unsigned c = xb_ld(&bar[XB_XCNT(j)]); sum += c; cnt += (c > 0u) ? 1u : 0u; mine = (j == x) ? c : mine; }
        if (sum == G) break;
        __builtin_amdgcn_s_sleep(1);
        if ((++sp & 255u) == 0u) { if (xb_ld(&bar[XB_TMO])) break; if (sp > XB_SPIN_CAP) { atomicAdd(&bar[XB_TMO], 1u); break; } }
    }
    nloc = mine > 0u ? mine : 1u; nx = cnt > 0u ? cnt : 1u;
}
__device__ __forceinline__ void xcd_barrier(const XcdBarrier& b) {
    asm volatile("s_waitcnt vmcnt(0)" ::: "memory");
    __syncthreads();
    if (threadIdx.x == 0) {
        unsigned* bar = b.bar;
        __builtin_amdgcn_s_waitcnt(0);
        unsigned nloc = b.st[0], nx = b.st[1];
        if (nloc == 0u) { xcd_barrier_complete(bar, b.x, nloc, nx); b.st[0] = nloc; b.st[1] = nx; }
        const unsigned old = xb_add(&bar[XB_XSUB(b.x)], 1u);
        const unsigned gen = old / nloc;
        if (old + 1u == (gen + 1u) * nloc) {
            __builtin_amdgcn_fence(__ATOMIC_RELEASE, "agent");
            asm volatile("s_waitcnt vmcnt(0)" ::: "memory");
            const unsigned og = xb_add(&bar[XB_TOP], 1u);
            const unsigned tg = og / nx;
            if (og + 1u == (tg + 1u) * nx) xb_add(&bar[XB_TOPGEN], 1u);
            else XB_SPIN(xb_ld(&bar[XB_TOPGEN]) == tg, bar);
            __builtin_amdgcn_fence(__ATOMIC_ACQUIRE, "agent");
            xb_add(&bar[XB_XGEN(b.x)], 1u);
            asm volatile("s_waitcnt vmcnt(0)" ::: "memory");
        } else {
            XB_SPIN(xb_ld(&bar[XB_XGEN(b.x)]) == gen, bar);
            __builtin_amdgcn_fence(__ATOMIC_ACQUIRE, "agent");
            asm volatile("s_waitcnt vmcnt(0)" ::: "memory");
        }
    }
    __syncthreads();
}

struct Args {
    const float* in[24]; float* out; unsigned char* ws; int ph_lo, ph_hi;
};
struct Frame {
    LAS unsigned char* lds;
    int tid, lane, wave, vcu, G;
    unsigned char* ws;
};

template <class Src>
__device__ __forceinline__ void conv_item(const Src& src, int Ksrc, int Kpad, bf16* WT, LAS float* scr, int item, int lane, int nblk) {
    const int kb = item / nblk, nb = item % nblk, k0 = 64 * kb, n0 = 32 * nb;
    const float* colp = src(n0 + (lane & 31)); const int ld = src.ld;
#pragma unroll 8
    for (int i = 0; i < 32; ++i) { const int kk = 2 * i + (lane >> 5), k = k0 + kk; float v = 0.f; if (colp != nullptr && k < Ksrc) v = colp[(size_t)k * ld] * src.ksc(k); scr[kk * 33 + (lane & 31)] = v; }
    LDS_WAIT(); asm volatile("" ::: "memory");
    const int c = lane & 7;
#pragma unroll
    for (int j = 0; j < 4; ++j) { const int n = (lane >> 3) + 8 * j; const LAS float* s = scr + (8 * c) * 33 + n;
        v4u o; o.x = pk2(s[0 * 33], s[1 * 33]); o.y = pk2(s[2 * 33], s[3 * 33]); o.z = pk2(s[4 * 33], s[5 * 33]); o.w = pk2(s[6 * 33], s[7 * 33]);
        *(GAS v4u*)((unsigned char*)WT + pg8::btile_off(n0 + n, (k0 + 8 * c) * 2, Kpad * 2)) = o; }
    LDS_WAIT(); asm volatile("" ::: "memory");
}
template <class Src>
__device__ __forceinline__ void conv_matrix(Frame& F, const Src& src, int Ksrc, int Kpad, int Nout, bf16* WT, int rot = 0) {
    LAS float* scr = (LAS float*)(F.lds + F.wave * 16384);
    const int gw = F.vcu * NWAVES + F.wave, NGW = F.G * NWAVES, nblk = Nout / 32, nitems = (Kpad / 64) * nblk;
    for (int it = (gw + NGW - rot % NGW) % NGW; it < nitems; it += NGW) conv_item(src, Ksrc, Kpad, WT, scr, it, F.lane, nblk);
}
template <class Src>
__device__ __forceinline__ void conv_item64(const Src& src, int Ksrc, int Kpad, bf16* WT, LAS unsigned short* scr, int item, int lane, int nblk) {
    const int kb = item / nblk, nb = item % nblk, k0 = 64 * kb, n0 = 64 * nb;
    const int nn = (lane & 15) * 4, kq = lane >> 4;
    const float* colp = src(n0 + nn); const int ld = src.ld;
    f32x4 v[16];
#pragma unroll
    for (int i = 0; i < 16; ++i) { const int k = k0 + 4 * i + kq; v[i] = (k < Ksrc) ? *(const f32x4*)(colp + (size_t)k * ld) : (f32x4){0.f, 0.f, 0.f, 0.f}; }
#pragma unroll
    for (int i = 0; i < 16; ++i) { LAS unsigned* d = (LAS unsigned*)(scr + (4 * i + kq) * 66 + nn); d[0] = pk2(v[i].x, v[i].y); d[1] = pk2(v[i].z, v[i].w); }
    LDS_WAIT(); asm volatile("" ::: "memory");
    const int c = lane & 7;
#pragma unroll
    for (int j = 0; j < 8; ++j) { const int n = (lane >> 3) + 8 * j; const LAS unsigned short* sp = scr + (8 * c) * 66 + n;
        v4u o; o.x = (unsigned)sp[0 * 66] | ((unsigned)sp[1 * 66] << 16); o.y = (unsigned)sp[2 * 66] | ((unsigned)sp[3 * 66] << 16);
        o.z = (unsigned)sp[4 * 66] | ((unsigned)sp[5 * 66] << 16); o.w = (unsigned)sp[6 * 66] | ((unsigned)sp[7 * 66] << 16);
        *(GAS v4u*)(WT + (size_t)(n0 + n) * Kpad + k0 + 8 * c) = o; }
    LDS_WAIT(); asm volatile("" ::: "memory");
}
template <class Src>
__device__ __forceinline__ void conv_matrix64(Frame& F, const Src& src, int Ksrc, int Kpad, int Nout, bf16* WT) {
    LAS unsigned short* scr = (LAS unsigned short*)(F.lds + F.wave * 16384);
    const int gw = F.vcu * NWAVES + F.wave, NGW = F.G * NWAVES, nblk = Nout / 64, nitems = (Kpad / 64) * nblk;
    for (int it = gw; it < nitems; it += NGW) conv_item64(src, Ksrc, Kpad, WT, scr, it, F.lane, nblk);
}
template <class Src>
__device__ __forceinline__ void conv_item_f8(const Src& src, int Ksrc, int Kpad, unsigned char* WT, LAS unsigned* scr, int item, int lane, int nblk, float sc) {
    const int kb = item / nblk, nb = item % nblk, k0 = 128 * kb, n0 = 64 * nb;
    const int nn = (lane & 15) * 4, kq4 = lane >> 4;
    const float* colp = src(n0 + nn); const int ld = src.ld;
#pragma unroll 2
    for (int i = 0; i < 8; ++i) { const int kq = 4 * i + kq4, k = k0 + 4 * kq; f32x4 r[4];
#pragma unroll
        for (int q = 0; q < 4; ++q) r[q] = (k + q < Ksrc) ? *(const f32x4*)(colp + (size_t)(k + q) * ld) : (f32x4){0.f, 0.f, 0.f, 0.f};
#pragma unroll
        for (int j = 0; j < 4; ++j) { int w = 0; w = __builtin_amdgcn_cvt_pk_fp8_f32(r[0][j] * sc, r[1][j] * sc, w, false); w = __builtin_amdgcn_cvt_pk_fp8_f32(r[2][j] * sc, r[3][j] * sc, w, true); scr[kq * 65 + nn + j] = (unsigned)w; } }
    LDS_WAIT(); asm volatile("" ::: "memory");
    const int c = lane & 7;
#pragma unroll
    for (int j = 0; j < 8; ++j) { const int n = (lane >> 3) + 8 * j; const LAS unsigned* sp = scr + (4 * c) * 65 + n;
        v4u o; o.x = sp[0]; o.y = sp[65]; o.z = sp[130]; o.w = sp[195];
        *(GAS v4u*)(WT + (size_t)(n0 + n) * Kpad + k0 + 16 * c) = o; }
    LDS_WAIT(); asm volatile("" ::: "memory");
}
template <class Src>
__device__ __forceinline__ void conv_matrix_f8(Frame& F, const Src& src, int Ksrc, int Kpad, int Nout, unsigned char* WT, float sc) {
    LAS unsigned* scr = (LAS unsigned*)(F.lds + F.wave * 16384);
    const int gw = F.vcu * NWAVES + F.wave, NGW = F.G * NWAVES, nblk = Nout / 64, nitems = (Kpad / 128) * nblk;
    for (int it = gw; it < nitems; it += NGW) conv_item_f8(src, Ksrc, Kpad, WT, scr, it, F.lane, nblk, sc);
}
template <class Src, bool F8>
__device__ __forceinline__ void conv_matrix_wg(Frame& F, const Src& src, int Ksrc, int Kpad, int Nout, unsigned char* WT, float sc, int rot = 0) {
    constexpr int KT = F8 ? 128 : 64, RW = KT / 8;
    LAS unsigned short* l16 = (LAS unsigned short*)F.lds; LAS unsigned* l32 = (LAS unsigned*)F.lds;
    const int nblk = Nout / 256, nitems = (Kpad / KT) * nblk, ld = src.ld;
    for (int it = (F.vcu + F.G - rot % F.G) % F.G; it < nitems; it += F.G) {
        const int kb = it / nblk, nb = it % nblk, k0 = KT * kb, n0 = 256 * nb;
        const float* colp = src(n0 + 4 * F.lane); const float scn = sc * src.nsc(n0 + 4 * F.lane);
        f32x4 r[RW];
#pragma unroll
        for (int j = 0; j < RW; ++j) { const int k = k0 + F.wave * RW + j; r[j] = (k < Ksrc) ? *(const f32x4*)(colp + (size_t)k * ld) * src.ksc(k) : (f32x4){0.f, 0.f, 0.f, 0.f}; }
        if constexpr (F8) {
#pragma unroll
            for (int q4 = 0; q4 < RW / 4; ++q4) { const int kq = F.wave * (RW / 4) + q4;
#pragma unroll
                for (int j = 0; j < 4; ++j) { int w = 0; w = __builtin_amdgcn_cvt_pk_fp8_f32(r[4 * q4][j] * scn, r[4 * q4 + 1][j] * scn, w, false); w = __builtin_amdgcn_cvt_pk_fp8_f32(r[4 * q4 + 2][j] * scn, r[4 * q4 + 3][j] * scn, w, true);
                    l32[kq * 257 + 4 * F.lane + j] = (unsigned)w; } }
        } else {
#pragma unroll
            for (int j = 0; j < RW; ++j) { const int kk = F.wave * RW + j; LAS unsigned* d = (LAS unsigned*)(l16 + kk * 258 + 4 * F.lane); d[0] = pk2(r[j].x, r[j].y); d[1] = pk2(r[j].z, r[j].w); }
        }
        __syncthreads();
#pragma unroll
        for (int j = 0; j < 4; ++j) { const int task = F.tid + 512 * j, rr = task >> 3, c = task & 7; v4u o;
            if constexpr (F8) { const LAS unsigned* sp = l32 + (4 * c) * 257 + rr; o.x = sp[0]; o.y = sp[257]; o.z = sp[514]; o.w = sp[771];
                *(GAS v4u*)(WT + pg8::btile_off(n0 + rr, k0 + 16 * c, Kpad)) = o; }
            else { const LAS unsigned short* sp = l16 + (8 * c) * 258 + rr;
                o.x = (unsigned)sp[0] | ((unsigned)sp[258] << 16); o.y = (unsigned)sp[2 * 258] | ((unsigned)sp[3 * 258] << 16); o.z = (unsigned)sp[4 * 258] | ((unsigned)sp[5 * 258] << 16); o.w = (unsigned)sp[6 * 258] | ((unsigned)sp[7 * 258] << 16);
                *(GAS v4u*)(WT + pg8::btile_off(n0 + rr, (k0 + 8 * c) * 2, Kpad * 2)) = o; }
        }
        __syncthreads();
    }
}
struct SrcPlain { const float* W; int ld; __device__ __forceinline__ const float* operator()(int n) const { return W + n; } __device__ __forceinline__ float ksc(int) const { return 1.f; } __device__ __forceinline__ float nsc(int) const { return 1.f; } };
struct SrcPlainG { const float* W; int ld; const float* g1; const float* g2;
    __device__ __forceinline__ const float* operator()(int n) const { return W + n; } __device__ __forceinline__ float ksc(int k) const { return k < 512 ? g1[k] : g2[k - 512]; } __device__ __forceinline__ float nsc(int) const { return 1.f; } };
struct SrcWin { const float* W; int ld;
    __device__ __forceinline__ float ksc(int) const { return 1.f; }
    __device__ __forceinline__ const float* operator()(int n) const {
        int s;
        if (n < 384) s = n;
        else if (n < 416) { const int p = n - 384; s = 384 + (p >> 1) + 16 * (p & 1); }
        else if (n < 424) s = 1952 + (n - 416);
        else if (n < 512) return nullptr;
        else if (n < 1024) s = 416 + (n - 512);
        else if (n < 1536) s = 928 + (n - 1024);
        else s = 1440 + (n - 1536);
        return W + s; } };
struct SrcWuq { const float* W; int ld; const float* g;
    __device__ __forceinline__ float ksc(int k) const { return g[k]; }
    __device__ __forceinline__ const float* operator()(int n) const {
        int s;
        if (n < 512) s = (n >> 6) * 96 + (n & 63);
        else { const int r = n - 512, h = r >> 5, p = r & 31; s = h * 96 + 64 + (p >> 1) + 16 * (p & 1); }
        return W + s; } };
struct SrcWukv { const float* W; int ld; const float* g;
    __device__ __forceinline__ float ksc(int k) const { return g[k]; }
    __device__ __forceinline__ const float* operator()(int n) const {
        int s;
        if (n < 512) s = (n >> 6) * 128 + (n & 63);
        else { const int r = n - 512; s = (r >> 6) * 128 + 64 + (r & 63); }
        return W + s; } };
struct SrcGU { const float* Wg; const float* Wu; int ld;
    __device__ __forceinline__ float ksc(int) const { return 1.f; }
    __device__ __forceinline__ float nsc(int n) const { return ((n & 255) < 128) ? -LOG2E : -SC_H / (4.f * LOG2E); }
    __device__ __forceinline__ const float* operator()(int n) const { const int t = n >> 8, w = n & 255; return (w < 128) ? (Wg + t * 128 + w) : (Wu + t * 128 + (w - 128)); } };

__device__ __forceinline__ void mod_phase(Frame& F, const float* c, const float* ada_w, const float* ada_b, float* MOD) {
    LAS float* cact = (LAS float*)F.lds;
    LAS float* red = cact + 8 * 1024;
    for (int i = F.tid; i < 8 * 1024; i += NWAVES * 64) { const float v = c[i]; cact[i] = v / (1.f + __expf(-v)); }
    __syncthreads();
    for (int item = F.vcu; item < 192; item += F.G) {
        const int l = item / 96, j = (item % 96) * 64 + F.lane;
        const float* wp = ada_w + (size_t)l * 1024 * 6144 + j;
        float acc[8];
#pragma unroll
        for (int b = 0; b < 8; ++b) acc[b] = 0.f;
        const int kb = F.wave * 128;
#pragma unroll 4
        for (int k = kb; k < kb + 128; ++k) { const float w = wp[(size_t)k * 6144];
#pragma unroll
            for (int b = 0; b < 8; ++b) acc[b] += cact[b * 1024 + k] * w; }
#pragma unroll
        for (int b = 0; b < 8; ++b) red[(F.wave * 8 + b) * 64 + F.lane] = acc[b];
        __syncthreads();
        { const int b = F.wave; float s = ada_b[l * 6144 + j];
#pragma unroll
          for (int w = 0; w < 8; ++w) s += red[(w * 8 + b) * 64 + F.lane];
          MOD[((size_t)l * 8 + b) * 6144 + j] = s; }
        __syncthreads();
    }
}

template <bool ROUTER, bool RESID, bool F8OUT = ROUTER>
__device__ __forceinline__ void norm_phase(Frame& F, const float* X, const float* g, const float* modl  , int part  , bf16* XN,
                                           const float* router_w, int* TOKE, float* TOKW, unsigned* CNT, const bf16* T, const float* rgate  , float* Xout) {
    const int gw = F.vcu * NWAVES + F.wave, NGW = F.G * NWAVES;
    if constexpr (ROUTER) { if (F.tid < 16) ((LAS unsigned*)(F.lds + LCNT_OFF))[F.tid] = 0u; __syncthreads(); }
    f32x4 gv[4];
#pragma unroll
    for (int j = 0; j < 4; ++j) gv[j] = *(const f32x4*)(g + 4 * F.lane + 256 * j);
    f32x4 vn[4]; v2u tn[4];
#pragma unroll
    for (int j = 0; j < 4; ++j) { vn[j] = ((const f32x4*)(X + (size_t)gw * DM) + F.lane)[64 * j]; if constexpr (RESID) tn[j] = ((const v2u*)(T + (size_t)gw * DM) + F.lane)[64 * j]; }
    for (int m = gw; m < M; m += NGW) {
        const int b = m >> 12;
        const f32x4* sh = (const f32x4*)(modl + (size_t)b * 6144 + part * 1024) + F.lane;
        const f32x4* sc = (const f32x4*)(modl + (size_t)b * 6144 + (part + 1) * 1024) + F.lane;
        f32x4 v[4]; v2u tc[4]; float s = 0.f;
#pragma unroll
        for (int j = 0; j < 4; ++j) { v[j] = vn[j]; if constexpr (RESID) tc[j] = tn[j]; }
        { const int mn = (m + NGW < M) ? m + NGW : m;
#pragma unroll
          for (int j = 0; j < 4; ++j) { vn[j] = ((const f32x4*)(X + (size_t)mn * DM) + F.lane)[64 * j]; if constexpr (RESID) tn[j] = ((const v2u*)(T + (size_t)mn * DM) + F.lane)[64 * j]; } }
        if constexpr (RESID) {
            const f32x4* gr = (const f32x4*)(rgate + (size_t)b * 6144) + F.lane; f32x4* xo = (f32x4*)(Xout + (size_t)m * DM) + F.lane;
#pragma unroll
            for (int j = 0; j < 4; ++j) { const v2u t = tc[j]; const f32x4 gg = gr[64 * j];
                v[j].x += gg.x * bf2f(t.x & 0xffffu); v[j].y += gg.y * bf2f(t.x >> 16); v[j].z += gg.z * bf2f(t.y & 0xffffu); v[j].w += gg.w * bf2f(t.y >> 16); xo[64 * j] = v[j]; }
        }
#pragma unroll
        for (int j = 0; j < 4; ++j) s += (v[j].x * v[j].x + v[j].y * v[j].y) + (v[j].z * v[j].z + v[j].w * v[j].w);
        const float r = 1.f / sqrtf(wave_sum(s) * (1.f / DM) + EPS);
        v2u* o8 = (v2u*)(XN + (size_t)m * DM) + F.lane; unsigned* o4 = (unsigned*)((unsigned char*)XN + (size_t)m * DM) + F.lane;
#pragma unroll
        for (int j = 0; j < 4; ++j) { const f32x4 a = sh[64 * j], c1 = sc[64 * j]; v[j] = (v[j] * r) * gv[j]; v[j] = v[j] * (c1 + 1.f) + a;
            if constexpr (F8OUT) { int w = 0; w = __builtin_amdgcn_cvt_pk_fp8_f32(fminf(fmaxf(v[j].x, -448.f), 448.f), fminf(fmaxf(v[j].y, -448.f), 448.f), w, false);
                w = __builtin_amdgcn_cvt_pk_fp8_f32(fminf(fmaxf(v[j].z, -448.f), 448.f), fminf(fmaxf(v[j].w, -448.f), 448.f), w, true); o4[64 * j] = (unsigned)w; }
            else { v2u w; w.x = pk2(v[j].x, v[j].y); w.y = pk2(v[j].z, v[j].w); o8[64 * j] = w; } }
        if constexpr (ROUTER) {
            float lg[8];
#pragma unroll
            for (int e = 0; e < 8; ++e) lg[e] = 0.f;
#pragma unroll
            for (int j = 0; j < 4; ++j)
#pragma unroll
                for (int q = 0; q < 4; ++q) { const float* rw = router_w + (size_t)(4 * F.lane + 256 * j + q) * 8; const f32x4 w0 = *(const f32x4*)rw, w1 = *(const f32x4*)(rw + 4); const float hv = v[j][q];
                    lg[0] += hv * w0.x; lg[1] += hv * w0.y; lg[2] += hv * w0.z; lg[3] += hv * w0.w; lg[4] += hv * w1.x; lg[5] += hv * w1.y; lg[6] += hv * w1.z; lg[7] += hv * w1.w; }
#pragma unroll
            for (int e = 0; e < 8; ++e) lg[e] = wave_sum(lg[e]);
            int e0 = 0; float v0 = lg[0];
#pragma unroll
            for (int e = 1; e < 8; ++e) if (lg[e] > v0) { v0 = lg[e]; e0 = e; }
            int e1 = -1; float v1 = -INFINITY;
#pragma unroll
            for (int e = 0; e < 8; ++e) if (e != e0 && lg[e] > v1) { v1 = lg[e]; e1 = e; }
            const float w1 = 1.f / (1.f + __expf(v0 - v1)), w0 = 1.f - w1;
            if (F.lane == 0) { TOKE[m] = e0 | (e1 << 8); *(f32x2*)(TOKW + 2 * (size_t)m) = (f32x2){w0, w1};
                LAS unsigned* lc = (LAS unsigned*)(F.lds + LCNT_OFF);
                __hip_atomic_fetch_add(lc + e0, 1u, __ATOMIC_RELAXED, __HIP_MEMORY_SCOPE_WORKGROUP); __hip_atomic_fetch_add(lc + e1, 1u, __ATOMIC_RELAXED, __HIP_MEMORY_SCOPE_WORKGROUP); }
        }
    }
    if constexpr (ROUTER) { __syncthreads(); if (F.tid < 16) CNT[F.vcu * 16 + F.tid] = ((LAS unsigned*)(F.lds + LCNT_OFF))[F.tid]; }
}

__device__ __forceinline__ void rope_phase(Frame& F, const int* positions, float* ROPE) {
    const int gw = F.vcu * NWAVES + F.wave, NGW = F.G * NWAVES;
    const int i = F.lane & 15; const float invf = powf(10000.f, -(float)i / 16.f);
    for (int m4 = gw; m4 < M / 4; m4 += NGW) { const int m = 4 * m4 + (F.lane >> 4);
        const float ang = (float)positions[m] * invf; float sn, cs; sincosf(ang, &sn, &cs);
        *(f32x2*)(ROPE + (size_t)m * 32 + 2 * i) = (f32x2){cs, sn}; }
}
__device__ __forceinline__ float log_sigmoid(float x) { return fminf(x, 0.f) - log1pf(__expf(-fabsf(x))); }
__device__ __forceinline__ void scan_phase(Frame& F, const float* FLOG, const float* fb, bf16* QF, bf16* KF) {
    const int sc = (int)blockIdx.x - (F.G - 64);
    if (sc >= 0) {
        const int b = sc >> 3, h = sc & 7; const float bias = fb[h];
        const size_t m0 = (size_t)b * SEQ + 8 * F.tid;
        LAS float* wtot = (LAS float*)(F.lds + LCNT_OFF + 512);
        float lf[8]; float tot = 0.f;
#pragma unroll
        for (int j = 0; j < 8; ++j) { lf[j] = log_sigmoid(FLOG[(m0 + j) * 8 + h] + bias); tot += lf[j]; }
        float inc = tot;
#pragma unroll
        for (int o = 1; o < 64; o <<= 1) { const float t = __shfl_up(inc, o); if (F.lane >= o) inc += t; }
        if (F.lane == 63) wtot[F.wave] = inc;
        __syncthreads();
        float run = inc - tot;
        for (int w = 0; w < F.wave; ++w) run += wtot[w];
#pragma unroll
        for (int j = 0; j < 8; ++j) { run += lf[j]; const float L = run * LOG2E;
            const unsigned hi = f2bf(L); const float r1 = L - bf2f(hi); const unsigned mi = f2bf(r1); const float r2 = r1 - bf2f(mi); const unsigned lo = f2bf(r2);
            const unsigned one = 0x3f80u;
            v4u q0, k0; const v4u z = (v4u){0u, 0u, 0u, 0u};
            q0.x = hi | (mi << 16); q0.y = lo | (one << 16); q0.z = one | (one << 16); q0.w = 0u;
            k0.x = one | (one << 16); k0.y = one | ((hi ^ 0x8000u) << 16); k0.z = (mi ^ 0x8000u) | ((lo ^ 0x8000u) << 16); k0.w = 0u;
            bf16* qp = QF + (m0 + j) * QF_P + h * 80 + 64; bf16* kp = KF + kimg<10>((int)(m0 + j), h, 64); bf16* kp2 = KF + kimg<10>((int)(m0 + j), h, 72);
            *(v4u*)qp = q0; *(v4u*)(qp + 8) = z; *(v4u*)kp = k0; *(v4u*)kp2 = z; }
    }
    __syncthreads();
}

__device__ __forceinline__ void route_phase(Frame& F, const unsigned* CNT  , const int* TOKE, int* ROWTOK, int* TOKSLOT, int* TEXP  ) {
    LAS unsigned* sh = (LAS unsigned*)(F.lds + LCNT_OFF);
    const int gw = F.vcu * NWAVES + F.wave, NGW = F.G * NWAVES;
    if (F.tid < 8) sh[64 + F.tid] = 0u;
    { const int e = F.wave; unsigned tot = 0u, pre = 0u;
#pragma unroll
        for (int j = 0; j < 4; ++j) { const int wg = F.lane + 64 * j; const unsigned v = (wg < F.G) ? CNT[wg * 16 + e] : 0u; tot += v; pre += (wg < F.vcu) ? v : 0u; }
#pragma unroll
        for (int o = 1; o < 64; o <<= 1) { tot += __shfl_xor(tot, o); pre += __shfl_xor(pre, o); }
        if (F.lane == 0) { sh[e] = tot; sh[16 + e] = pre; } }
    __syncthreads();
    if (F.tid < 8) { unsigned st = 0u;
        for (int t2 = 0; t2 < F.tid; ++t2) st += (sh[t2] + 255u) & ~255u;
        sh[48 + F.tid] = st; sh[32 + F.tid] = st + sh[16 + F.tid]; }
    __syncthreads();
    if (F.lane < 16) { const int m = gw + F.lane * NGW;
        if (m < M) { const int te = TOKE[m]; const int e0 = te & 255, e1 = te >> 8;
            const unsigned i0 = __hip_atomic_fetch_add(sh + 64 + e0, 1u, __ATOMIC_RELAXED, __HIP_MEMORY_SCOPE_WORKGROUP), i1 = __hip_atomic_fetch_add(sh + 64 + e1, 1u, __ATOMIC_RELAXED, __HIP_MEMORY_SCOPE_WORKGROUP);
            const unsigned s0 = sh[32 + e0] + i0, s1 = sh[32 + e1] + i1;
            ROWTOK[s0] = m; ROWTOK[s1] = m; TOKSLOT[2 * m] = (int)s0; TOKSLOT[2 * m + 1] = (int)s1; } }
    if (F.vcu < 8) { const unsigned tot = sh[F.vcu], seg = sh[48 + F.vcu], end = (tot + 255u) & ~255u;
        for (unsigned r = tot + F.tid; r < end; r += NWAVES * 64) ROWTOK[seg + r] = -1; }
    if (F.vcu == 16 && F.tid == 0) { int t = 0;
        for (int e = 0; e < 8; ++e) { t += (int)((sh[e] + 255u) >> 8); TEXP[1 + e] = t; }
        TEXP[0] = t; }
    __syncthreads();
}

__device__ __forceinline__ void outnorm_phase(Frame& F, bf16* O, const float* g1, const float* g2) {
    const int gw = F.vcu * NWAVES + F.wave, NGW = F.G * NWAVES;
    float ga[8], gb[8];
#pragma unroll
    for (int j = 0; j < 8; ++j) { ga[j] = g1[8 * F.lane + j]; gb[j] = g2[8 * F.lane + j]; }
    for (int m = gw; m < M; m += NGW) {
        v4u* p = (v4u*)(O + (size_t)m * O_P) + F.lane;
        const v4u a = p[0], b = p[64];
        float fa[8], fbv[8]; float sa = 0.f, sb = 0.f;
#pragma unroll
        for (int j = 0; j < 4; ++j) { fa[2 * j] = bf2f(a[j] & 0xffffu); fa[2 * j + 1] = bf2f(a[j] >> 16); fbv[2 * j] = bf2f(b[j] & 0xffffu); fbv[2 * j + 1] = bf2f(b[j] >> 16); }
#pragma unroll
        for (int j = 0; j < 8; ++j) { sa += fa[j] * fa[j]; sb += fbv[j] * fbv[j]; }
        const float ra = 1.f / sqrtf(wave_sum(sa) * (1.f / 512.f) + EPS), rb = 1.f / sqrtf(wave_sum(sb) * (1.f / 512.f) + EPS);
        v4u oa, ob;
#pragma unroll
        for (int j = 0; j < 4; ++j) { oa[j] = pk2(fa[2 * j] * ra * ga[2 * j], fa[2 * j + 1] * ra * ga[2 * j + 1]); ob[j] = pk2(fbv[2 * j] * rb * gb[2 * j], fbv[2 * j + 1] * rb * gb[2 * j + 1]); }
        p[0] = oa; p[64] = ob;
    }
}

__device__ __forceinline__ void final_phase(Frame& F, float* X, const float* g, const bf16* Y, const bf16* Yp, const int* TEXP, const int* TOKSLOT, const float* TOKW, const float* gf  ) {
    const int gw = F.vcu * NWAVES + F.wave, NGW = F.G * NWAVES;
    int tail0, S; size_t pstride;
    { pg8::MoeOrderD O; O.init_d(__builtin_amdgcn_readfirstlane(TEXP[0]), FF / 128, F.G, 0); S = O.S; tail0 = O.mainM * 256; pstride = (size_t)(O.tailSub / (4 * O.S)) * 256 * DM; }
    f32x4 gv[4];
#pragma unroll
    for (int j = 0; j < 4; ++j) gv[j] = *(const f32x4*)(g + 4 * F.lane + 256 * j);
    for (int m = gw; m < M; m += NGW) {
        const int b = m >> 12;
        f32x4* xr = (f32x4*)(X + (size_t)m * DM) + F.lane;
        const int s0 = TOKSLOT[2 * m], s1 = TOKSLOT[2 * m + 1]; const float w0 = TOKW[2 * m], w1 = TOKW[2 * m + 1];
        const v2u* y0 = (const v2u*)(Y + (size_t)s0 * DM) + F.lane; const v2u* y1 = (const v2u*)(Y + (size_t)s1 * DM) + F.lane; const f32x4* gr = (const f32x4*)(gf + (size_t)b * 6144) + F.lane;
        f32x4 v[4]; float s = 0.f;
#pragma unroll
        for (int j = 0; j < 4; ++j) { v[j] = xr[64 * j]; const v2u a = y0[64 * j], c = y1[64 * j]; const f32x4 gg = gr[64 * j];
            v[j].x += gg.x * (w0 * bf2f(a.x & 0xffffu) + w1 * bf2f(c.x & 0xffffu)); v[j].y += gg.y * (w0 * bf2f(a.x >> 16) + w1 * bf2f(c.x >> 16));
            v[j].z += gg.z * (w0 * bf2f(a.y & 0xffffu) + w1 * bf2f(c.y & 0xffffu)); v[j].w += gg.w * (w0 * bf2f(a.y >> 16) + w1 * bf2f(c.y >> 16));
        }
        if (S > 1 && (s0 >= tail0 || s1 >= tail0)) {
#pragma unroll 1
            for (int k = 0; k < 2; ++k) { const int sk = k ? s1 : s0; const float wk = k ? w1 : w0; if (sk < tail0) continue;
#pragma unroll 1
                for (int p = 1; p < S; ++p) { const v2u* yp = (const v2u*)(Yp + (size_t)(p - 1) * pstride + (size_t)(sk - tail0) * DM) + F.lane;
#pragma unroll
                    for (int j = 0; j < 4; ++j) { const v2u a = yp[64 * j]; const f32x4 gg = gr[64 * j];
                        v[j].x += gg.x * (wk * bf2f(a.x & 0xffffu)); v[j].y += gg.y * (wk * bf2f(a.x >> 16)); v[j].z += gg.z * (wk * bf2f(a.y & 0xffffu)); v[j].w += gg.w * (wk * bf2f(a.y >> 16)); } } } }
#pragma unroll
        for (int j = 0; j < 4; ++j) s += (v[j].x * v[j].x + v[j].y * v[j].y) + (v[j].z * v[j].z + v[j].w * v[j].w);
        const float r = 1.f / sqrtf(wave_sum(s) * (1.f / DM) + EPS);
#pragma unroll
        for (int j = 0; j < 4; ++j) xr[64 * j] = (v[j] * r) * gv[j];
    }
}

typedef __bf16 bf16x2_t __attribute__((ext_vector_type(2)));
template <int DQK>
__device__ __forceinline__ void attn_naive_unit(Frame& F, const bf16* Q, int qpitch, const bf16* K, int kpitch, const bf16* V, int vpitch, bf16* O  , int b, int h, int qb) {
    LAS unsigned* Ksh = (LAS unsigned*)F.lds;
    LAS float* Vsh = (LAS float*)(F.lds + 64 * DQK * 2);
    const int tid = F.tid, qpos = qb * 512 + tid; const size_t row = (size_t)b * SEQ + qpos;
    unsigned q[DQK / 2]; float o[64];
    { const bf16* qp = Q + row * qpitch + h * DQK;
#pragma unroll
      for (int d8 = 0; d8 < DQK / 8; ++d8) { const v4u w = *(const v4u*)(qp + 8 * d8);
#pragma unroll
          for (int j = 0; j < 4; ++j) q[4 * d8 + j] = w[j]; } }
#pragma unroll
    for (int d = 0; d < 64; ++d) o[d] = 0.f;
    float mrun = -INFINITY, l = 0.f;
    const int ntile = 8 * (qb + 1);
    for (int t = 0; t < ntile; ++t) {
        __syncthreads();
        for (int idx = tid; idx < 64 * DQK / 8; idx += NWAVES * 64) { const int r = idx / (DQK / 8), c8 = idx % (DQK / 8);
            const v4u w = *(const v4u*)(K + ((size_t)b * SEQ + t * 64 + r) * kpitch + h * DQK + 8 * c8); *(LAS v4u*)(Ksh + r * (DQK / 2) + 4 * c8) = w; }
        { const int r = tid >> 3, c8 = tid & 7; const v4u w = *(const v4u*)(V + ((size_t)b * SEQ + t * 64 + r) * vpitch + h * 64 + 8 * c8); LAS float* d = Vsh + r * 64 + 8 * c8;
#pragma unroll
          for (int j = 0; j < 4; ++j) { d[2 * j] = bf2f(w[j] & 0xffffu); d[2 * j + 1] = bf2f(w[j] >> 16); } }
        __syncthreads();
        const int kbase = t * 64;
#pragma unroll 1
        for (int gk = 0; gk < 16; ++gk) {
            float s[4]; float mx = -INFINITY;
#pragma unroll
            for (int j = 0; j < 4; ++j) { const LAS unsigned* kr = Ksh + (gk * 4 + j) * (DQK / 2); float a = 0.f;
#pragma unroll
                for (int d = 0; d < DQK / 2; ++d) a = __builtin_amdgcn_fdot2_f32_bf16(__builtin_bit_cast(bf16x2_t, q[d]), __builtin_bit_cast(bf16x2_t, kr[d]), a, false);
                s[j] = (kbase + gk * 4 + j <= qpos) ? a : -INFINITY; mx = fmaxf(mx, s[j]); asm volatile("" ::: "memory"); }
            const float mnew = fmaxf(mrun, mx);
            if (mnew > -INFINITY) {
                const float alpha = __builtin_amdgcn_exp2f(mrun - mnew);
                l *= alpha;
#pragma unroll
                for (int d = 0; d < 64; ++d) o[d] *= alpha;
#pragma unroll
                for (int j = 0; j < 4; ++j) { const float p = __builtin_amdgcn_exp2f(s[j] - mnew); l += p; const LAS float* vr = Vsh + (gk * 4 + j) * 64;
#pragma unroll
                    for (int dc = 0; dc < 4; ++dc) {
#pragma unroll
                        for (int d = 0; d < 16; ++d) o[dc * 16 + d] += p * vr[dc * 16 + d];
                        asm volatile("" ::: "memory"); } }
                mrun = mnew;
            }
        }
    }
    const float rl = 1.f / l;
    bf16* op = O + row * O_P + h * 64;
#pragma unroll
    for (int d8 = 0; d8 < 8; ++d8) { v4u w;
#pragma unroll
        for (int j = 0; j < 4; ++j) w[j] = pk2(o[8 * d8 + 2 * j] * rl, o[8 * d8 + 2 * j + 1] * rl);
        *(v4u*)(op + 8 * d8) = w; }
    __syncthreads();
}

namespace att {
using f32x16 = __attribute__((ext_vector_type(16))) float;
using s16x4 = __attribute__((ext_vector_type(4))) short;
using u32x4 = __attribute__((ext_vector_type(4))) unsigned;
typedef __attribute__((address_space(3))) const char* lds_cptr;
typedef short v4i16_t __attribute__((ext_vector_type(4)));
__device__ __forceinline__ int crow(int r, int hi) { return (r & 3) + 8 * (r >> 2) + 4 * hi; }
__device__ __forceinline__ void glds16(const void* gsrc, unsigned lds_dst) { unsigned keep;
    asm volatile("s_mov_b32 %0, m0\n\ts_mov_b32 m0, %2\n\ts_nop 0\n\tglobal_load_lds_dwordx4 %1, off\n\ts_mov_b32 m0, %0" : "=&s"(keep) : "v"(gsrc), "s"(lds_dst) : "memory"); }
__device__ __forceinline__ unsigned cvtpk(float lo, float hi) { unsigned r; asm("v_cvt_pk_bf16_f32 %0, %1, %2" : "=v"(r) : "v"(lo), "v"(hi)); return r; }
#define ATT_WAIT_BAR(N) asm volatile("s_waitcnt vmcnt(" #N ") lgkmcnt(0)\n\ts_barrier" ::: "memory")
constexpr float THR = 8.f;

__device__ __forceinline__ float max3f(float a, float b, float c) { float r; asm("v_max3_f32 %0, %1, %2, %3" : "=v"(r) : "v"(a), "v"(b), "v"(c)); return r; }
__device__ __forceinline__ float max2f(float a, float b) { float r; asm("v_max_f32_e32 %0, %1, %2" : "=v"(r) : "v"(a), "v"(b)); return r; }
__device__ __forceinline__ float fadd_s(float a, float b) { float r; asm("v_add_f32_e32 %0, %1, %2" : "=v"(r) : "v"(a), "v"(b)); return r; }
__device__ __forceinline__ float fsub_s(float a, float b) { float r; asm("v_sub_f32_e32 %0, %1, %2" : "=v"(r) : "v"(a), "v"(b)); return r; }
__device__ __forceinline__ float fmul_s(float a, float b) { float r; asm("v_mul_f32_e32 %0, %1, %2" : "=v"(r) : "v"(a), "v"(b)); return r; }

template <int DQK>
__device__ __forceinline__ void attn_unit(const bf16* Q, const bf16* K, const bf16* V, bf16* O, float* SSQO  , int b, int h, int qb, char* shm) {
    constexpr int NK = DQK / 16, NCH = DQK / 8, NX = NCH - 8, KBYTES = NCH * 1024, SLOT = KBYTES + 8192, PITCH = 8 * DQK;
    constexpr int LDS_WS = 3 * SLOT, LDS_OST = LDS_WS + 8 * 256;
    int tid_ = threadIdx.x; asm volatile("" : "+v"(tid_));
    const int tid = tid_, lane = tid & 63, r32 = lane & 31, hi = lane >> 5; const int wid = __builtin_amdgcn_readfirstlane(tid >> 6);
    const long rowbase = (long)b * SEQ; const int q0 = qb * 256;
    const bf16* Qw = Q + (rowbase + q0 + wid * 32) * PITCH + h * DQK;
    const unsigned lds0 = (unsigned)(uintptr_t)shm;
    float* wsf = (float*)(shm + LDS_WS) + wid * 64;
    const int NT = 4 * (qb + 1);
    constexpr long KTILE = (long)NH * NCH * 512;
    const bf16* ksrc0 = K + kimg<NCH>((int)rowbase + (NT - 1) * 64, h, wid * 8) + lane * 8;
    constexpr long VTILE = (long)NH * 8 * 512;
    const bf16* vsrc = V + vimg((int)rowbase + (NT - 1) * 64, h, 0) + wid * 512 + lane * 8;
#define ATT_DMA(back, slotoff) do { const unsigned _d = (unsigned)__builtin_amdgcn_readfirstlane(lds0 + (slotoff)); \
        glds16(ksrc0 - (long)(back) * KTILE, _d + wid * 1024); if (wid < NX) glds16(ksrc0 - (long)(back) * KTILE + 8 * 512, _d + (8 + wid) * 1024); \
        glds16(vsrc - (long)(back) * VTILE, _d + KBYTES + wid * 1024); } while (0)
    ATT_DMA(0, 0); ATT_DMA(1, SLOT);
    bf16x8 qr[NK];
#pragma unroll
    for (int d0 = 0; d0 < NK; ++d0) qr[d0] = *reinterpret_cast<const bf16x8*>(&Qw[(long)r32 * PITCH + d0 * 16 + hi * 8]);
#pragma unroll
    for (int d0 = 0; d0 < NK; ++d0) asm volatile("" : "+v"(qr[d0]));
    asm volatile("s_waitcnt vmcnt(0)" ::: "memory");
    float mhat = 0.f, l_reg = 0.f; f32x16 o[2]; o[0] = f32x16{}; o[1] = f32x16{};
    const int jdiag = wid >> 1;
    const lds_cptr kp0 = (lds_cptr)shm + hi * 1024 + r32 * 16;
    const lds_cptr vp0 = (lds_cptr)shm + KBYTES + ((lane >> 4) & 1) * 32 + (lane & 3) * 8 + (4 * hi + ((lane & 15) >> 2)) * 64;
    f32x16 p0, p1; s16x4 vlo[8], vhi[8];
#define ATT_A(slot) do { \
        bf16x8 kf[2 * NK]; \
        _Pragma("unroll") for (int d0 = 0; d0 < NK; ++d0) { kf[2 * d0] = *(const __attribute__((address_space(3))) bf16x8*)(kp0 + (slot) + d0 * 2048); kf[2 * d0 + 1] = *(const __attribute__((address_space(3))) bf16x8*)(kp0 + (slot) + d0 * 2048 + 512); } \
        __builtin_amdgcn_sched_barrier(0); \
        _Pragma("unroll") for (int i = 0; i < 8; ++i) { \
            vlo[i] = __builtin_bit_cast(s16x4, __builtin_amdgcn_ds_read_tr16_b64_v4i16((__attribute__((address_space(3))) v4i16_t*)(vp0 + (slot) + (i >> 2) * 4096 + (i & 3) * 1024))); \
            vhi[i] = __builtin_bit_cast(s16x4, __builtin_amdgcn_ds_read_tr16_b64_v4i16((__attribute__((address_space(3))) v4i16_t*)(vp0 + (slot) + (i >> 2) * 4096 + (i & 3) * 1024 + 512))); } \
        __builtin_amdgcn_sched_barrier(0); \
        f32x16 c; \
        _Pragma("unroll") for (int r = 0; r < 16; ++r) c[r] = -mhat; \
        _Pragma("unroll") for (int i = 0; i < 2 * NK; ++i) asm volatile("" : "+v"(kf[i])); \
        p0 = __builtin_amdgcn_mfma_f32_32x32x16_bf16(kf[0], qr[0], c, 0, 0, 0); p1 = __builtin_amdgcn_mfma_f32_32x32x16_bf16(kf[1], qr[0], c, 0, 0, 0); \
        _Pragma("unroll") for (int d0 = 1; d0 < NK; ++d0) { p0 = __builtin_amdgcn_mfma_f32_32x32x16_bf16(kf[2 * d0], qr[d0], p0, 0, 0, 0); p1 = __builtin_amdgcn_mfma_f32_32x32x16_bf16(kf[2 * d0 + 1], qr[d0], p1, 0, 0, 0); } \
        _Pragma("unroll") for (int i = 0; i < 8; ++i) { asm volatile("" : "+v"(vlo[i])); asm volatile("" : "+v"(vhi[i])); } \
        asm volatile("s_nop 15\n\ts_nop 7" : "+v"(p0), "+v"(p1));        \
    } while (0)
#define ATT_B(MODE) do { \
        if (MODE == 1) { int qrel = wid * 32 + r32; asm volatile("" : "+v"(qrel)); const int kb = 64 * jdiag + 4 * hi; \
            _Pragma("unroll") for (int r = 0; r < 16; ++r) { const int kv = kb + (r & 3) + 8 * (r >> 2); if (kv > qrel) p0[r] = -INFINITY; if (kv + 32 > qrel) p1[r] = -INFINITY; } } \
        float rm; \
        { float a0 = max3f(p0[0], p0[1], p1[0]), a1 = max3f(p0[2], p0[3], p1[1]), a2 = max3f(p0[4], p0[5], p1[2]), a3 = max3f(p0[6], p0[7], p1[3]); \
          a0 = max3f(a0, p0[8], p0[9]); a1 = max3f(a1, p0[10], p0[11]); a2 = max3f(a2, p0[12], p0[13]); a3 = max3f(a3, p0[14], p0[15]); \
          a0 = max3f(a0, p1[4], p1[5]); a1 = max3f(a1, p1[6], p1[7]); a2 = max3f(a2, p1[8], p1[9]); a3 = max3f(a3, p1[10], p1[11]); \
          a0 = max3f(a0, p1[12], p1[13]); a1 = max3f(a1, p1[14], p1[15]); rm = max2f(max2f(a0, a1), max2f(a2, a3)); } \
        asm volatile("s_nop 1" : "+v"(rm));                                     \
        { auto rr = __builtin_amdgcn_permlane32_swap(__float_as_uint(rm), __float_as_uint(rm), false, false); float r0_ = __uint_as_float(rr[0]), r1_ = __uint_as_float(rr[1]); asm volatile("s_nop 1" : "+v"(r0_), "+v"(r1_)); rm = max2f(r0_, r1_); } \
        if (MODE == 1) { mhat += rm; \
            _Pragma("unroll") for (int r = 0; r < 16; ++r) { p0[r] = fsub_s(p0[r], rm); p1[r] = fsub_s(p1[r], rm); } } \
        else if (__builtin_expect(__any(rm > THR), 0)) { const float dl = fmaxf(rm, 0.f); mhat += dl; \
            _Pragma("unroll") for (int r = 0; r < 16; ++r) { p0[r] = fsub_s(p0[r], dl); p1[r] = fsub_s(p1[r], dl); } \
            const float f = __builtin_amdgcn_exp2f(-dl); l_reg *= f; if (hi == 0) wsf[r32] = f; \
            asm volatile("s_waitcnt lgkmcnt(0)" ::: "memory"); \
            _Pragma("unroll") for (int r4 = 0; r4 < 4; ++r4) { const f32x4 fv = *(const f32x4*)(wsf + 8 * r4 + 4 * hi); \
                _Pragma("unroll") for (int j = 0; j < 4; ++j) { o[0][4 * r4 + j] = fmul_s(o[0][4 * r4 + j], fv[j]); o[1][4 * r4 + j] = fmul_s(o[1][4 * r4 + j], fv[j]); } } } \
        _Pragma("unroll") for (int r = 0; r < 16; ++r) { p0[r] = __builtin_amdgcn_exp2f(p0[r]); p1[r] = __builtin_amdgcn_exp2f(p1[r]); } \
        asm volatile("s_nop 1" : "+v"(p0), "+v"(p1));                      \
        float sa0 = 0.f, sa1 = 0.f, sa2 = 0.f, sa3 = 0.f; \
        _Pragma("unroll") for (int r = 0; r < 16; r += 4) { \
            sa0 = fadd_s(sa0, p0[r]); sa1 = fadd_s(sa1, p0[r + 1]); sa2 = fadd_s(sa2, p0[r + 2]); sa3 = fadd_s(sa3, p0[r + 3]); \
            sa0 = fadd_s(sa0, p1[r]); sa1 = fadd_s(sa1, p1[r + 1]); sa2 = fadd_s(sa2, p1[r + 2]); sa3 = fadd_s(sa3, p1[r + 3]); } \
        l_reg += fadd_s(fadd_s(sa0, sa1), fadd_s(sa2, sa3)); \
        u32x4 pw[4]; \
        _Pragma("unroll") for (int j = 0; j < 4; ++j) { pw[0][j] = cvtpk(p0[2 * j], p0[2 * j + 1]); pw[1][j] = cvtpk(p0[8 + 2 * j], p0[8 + 2 * j + 1]); pw[2][j] = cvtpk(p1[2 * j], p1[2 * j + 1]); pw[3][j] = cvtpk(p1[8 + 2 * j], p1[8 + 2 * j + 1]); } \
        asm volatile("s_nop 3" : "+v"(pw[0]), "+v"(pw[1]), "+v"(pw[2]), "+v"(pw[3]), "+v"(o[0]), "+v"(o[1]));     \
        _Pragma("unroll") for (int ks = 0; ks < 4; ++ks) _Pragma("unroll") for (int d0 = 0; d0 < 2; ++d0) { const int i = d0 * 4 + ks; \
            const bf16x8 vf = (bf16x8){vlo[i][0], vlo[i][1], vlo[i][2], vlo[i][3], vhi[i][0], vhi[i][1], vhi[i][2], vhi[i][3]}; \
            o[d0] = __builtin_amdgcn_mfma_f32_32x32x16_bf16(__builtin_bit_cast(bf16x8, pw[ks]), vf, o[d0], 0, 0, 0); } \
    } while (0)
#define ATT_SYNC(k) do { if ((k) + 1 < NT) { if (wid < NX) ATT_WAIT_BAR(3); else ATT_WAIT_BAR(2); } else ATT_WAIT_BAR(0); } while (0)
    const bool late = wid >= 4;
    if (late) { ATT_SYNC(0); ATT_DMA(2, 2 * SLOT); }
#pragma unroll
    for (int s = 0; s < 4; ++s) {
        if (!late) { ATT_SYNC(s); if (s + 2 < NT) ATT_DMA(s + 2, ((s + 2) % 3) * SLOT); }
        const int jb = 3 - s;
        if (jb <= jdiag) ATT_A((s % 3) * SLOT);
        if (late && s + 1 < NT) { ATT_SYNC(s + 1); if (s + 3 < NT) ATT_DMA(s + 3, (s % 3) * SLOT); }
        if (jb == jdiag) ATT_B(1); else if (jb < jdiag) ATT_B(0);
    }
    int slot = SLOT, slot2 = 0;
#pragma unroll 1
    for (int s = 4; s < NT; ++s) {
        if (!late) { ATT_SYNC(s); if (s + 2 < NT) ATT_DMA(s + 2, slot2); }
        ATT_A(slot);
        if (late && s + 1 < NT) { ATT_SYNC(s + 1); if (s + 3 < NT) ATT_DMA(s + 3, slot); }
        ATT_B(0);
        slot = (slot == 2 * SLOT) ? 0 : slot + SLOT; slot2 = (slot2 == 2 * SLOT) ? 0 : slot2 + SLOT;
    }
#undef ATT_SYNC
#undef ATT_A
#undef ATT_B
    { auto rr = __builtin_amdgcn_permlane32_swap(__float_as_uint(l_reg), __float_as_uint(l_reg), false, false); l_reg = __uint_as_float(rr[0]) + __uint_as_float(rr[1]); }
    if (hi == 0) wsf[32 + r32] = l_reg; asm volatile("s_waitcnt lgkmcnt(0)" ::: "memory");
    float rli[16];
#pragma unroll
    for (int r = 0; r < 16; ++r) rli[r] = __builtin_amdgcn_rcpf(wsf[32 + crow(r, hi)]);
    bf16* Ow = O + (rowbase + q0 + wid * 32) * O_P + h * 64;
    { bf16* stg = (bf16*)(shm + LDS_OST) + wid * 2048;
#pragma unroll
      for (int r = 0; r < 16; ++r) { const int orow = crow(r, hi);
#pragma unroll
          for (int d0 = 0; d0 < 2; ++d0) stg[orow * 64 + d0 * 32 + r32] = (bf16)f2bf(o[d0][r] * rli[r]); }
      asm volatile("s_waitcnt lgkmcnt(0)" ::: "memory");
#pragma unroll
      for (int i = 0; i < 4; ++i) { const int row = i * 8 + (lane >> 3), ch = lane & 7; const u32x4 v = *(const u32x4*)(stg + row * 64 + ch * 8); *(u32x4*)(Ow + (long)row * O_P + ch * 8) = v;
          float ss = 0.f;
#pragma unroll
          for (int j = 0; j < 4; ++j) { const float lo_ = bf2f(v[j] & 0xffffu), hi_ = bf2f(v[j] >> 16); ss += lo_ * lo_ + hi_ * hi_; }
          ss += __shfl_xor(ss, 1); ss += __shfl_xor(ss, 2); ss += __shfl_xor(ss, 4);
          if (ch == 0) SSQO[(size_t)(rowbase + q0 + wid * 32 + row) * 16 + h] = ss; } }
    asm volatile("s_waitcnt lgkmcnt(0)\n\ts_barrier" ::: "memory");
#undef ATT_DMA
}
}

constexpr int PH_PRO = 0, PH_L0 = 1, PH_L1 = 11, PH_MOE = 19, PH_FINAL = 22, N_PHASES = 23;

__device__ __forceinline__ void weights_phase(Frame& F, const Args& args) {
    unsigned char* ws = args.ws;
#pragma unroll 1
    for (int l = 0; l < 2; ++l) {
        conv_matrix(F, SrcWin{args.in[6] + (size_t)l * 1024 * 1960, 1960}, 1024, 1024, INC, (bf16*)(ws + WS_WIN) + (size_t)l * INC * 1024, 1024 * l);
        conv_matrix(F, SrcWuq{args.in[8] + (size_t)l * 256 * 768, 768, args.in[7] + l * 256}, 256, 256, 768, (bf16*)(ws + WS_WUQ) + (size_t)l * 768 * 256, 96 * l);
        conv_matrix(F, SrcWukv{args.in[10] + (size_t)l * 128 * 1024, 1024, args.in[9] + l * 128}, 128, 128, 1024, (bf16*)(ws + WS_WUKV) + (size_t)l * 1024 * 128, 192 + 64 * l);
    }
    __syncthreads();
#pragma unroll 1
    for (int l = 0; l < 2; ++l)
        conv_matrix_wg<SrcPlainG, false>(F, SrcPlainG{args.in[14] + (size_t)l * 1024 * 1024, 1024, args.in[12] + l * 512, args.in[13] + l * 512}, 1024, 1024, 1024, ws + WS_WO + (size_t)l * 1024 * 1024 * 2, 1.f, 40 + 64 * l);
    conv_matrix_wg<SrcGU, true>(F, SrcGU{args.in[16], args.in[17], FF}, 1024, 1024, 2 * FF, ws + WS_WGU0, SC_WGU, 168);
    conv_matrix_wg<SrcPlain, true>(F, SrcPlain{args.in[18], 1024}, FF, FF, 1024, ws + WS_WD0, SC_WD, 136);
}

__global__ void __launch_bounds__(NWAVES * 64, 2) fwd_kernel(Args args) {
    extern __shared__ __attribute__((aligned(16))) unsigned char lds[];
    Frame F;
    F.lds = (LAS unsigned char*)lds;
    F.tid = threadIdx.x; F.lane = F.tid & 63; F.wave = __builtin_amdgcn_readfirstlane(F.tid >> 6);
    F.G = gridDim.x; { const int bx = blockIdx.x; F.vcu = (F.G % 8 == 0) ? (bx % 8) * (F.G / 8) + bx / 8 : bx; }
    F.ws = args.ws;
    unsigned char* ws = args.ws;
    for (int u = F.tid; u < (LDS_BYTES - LDSCTL_OFF) / 4; u += NWAVES * 64) ((LAS unsigned*)(F.lds + LDSCTL_OFF))[u] = 0u;
    __syncthreads();
#if MK_ONE_LAUNCH
    XcdBarrier bar = xcd_barrier_post((unsigned*)(ws + WS_CTL) + CW_BAR, (volatile LAS unsigned*)(F.lds + MISC_OFF) + 8);
#define SEAM(k) do { if (lo <= (k) && (k) + 1 < hi) xcd_barrier(bar); } while (0)
#else
#define SEAM(k) do { } while (0)
#endif
    const int lo = args.ph_lo, hi = args.ph_hi;
#ifndef PHSEL
#define PHSEL 0xFFFFu
#endif
#define IN(k) (lo <= (k) && (k) < hi)
#define SEL(kind) (((PHSEL) >> (kind)) & 1u)

#define FRESH() do { int t_ = threadIdx.x; asm volatile("" : "+v"(t_)); F.tid = t_; F.lane = t_ & 63; F.wave = __builtin_amdgcn_readfirstlane(t_ >> 6); } while (0)
#define INP(k) (args.in[k])
#define WSP(T, off) ((T*)(ws + (off)))
    float* X = args.out;

    if (SEL(0) && IN(PH_PRO)) { FRESH();
        rope_phase(F, (const int*)INP(2), WSP(float, WS_ROPE));
        mod_phase(F, INP(1), INP(3), INP(4), WSP(float, WS_MOD));
    }
    SEAM(PH_PRO);

#define LAYER_MIXER(l, pb) do { \
          \
        if (SEL(1) && IN(pb + 0)) { FRESH(); \
            if (l == 0) { norm_phase<false, false>(F, INP(0), INP(5), WSP(float, WS_MOD), 0, WSP(bf16, WS_XN), nullptr, nullptr, nullptr, nullptr, nullptr, nullptr, nullptr); weights_phase(F, args); } \
            else norm_phase<false, true>(F, X, INP(5) + 1024, WSP(float, WS_MOD) + (size_t)8 * 6144, 0, WSP(bf16, WS_XN), nullptr, nullptr, nullptr, nullptr, WSP(bf16, WS_T2), WSP(float, WS_MOD) + 5 * 1024, X); } \
        SEAM(pb + 0); \
          \
        if (SEL(2) && IN(pb + 1)) { \
            pg8::Gemm g{WSP(bf16, WS_XN), WSP(bf16, WS_WIN) + (size_t)l * INC * 1024, 1024, 0, nullptr}; pg8::StaticOrder S; S.init(M, INC, F.G, (int)blockIdx.x); \
            pg8::EpiInproj E{WSP(bf16, WS_CQN), WSP(bf16, WS_CKVN), WSP(bf16, WS_KM), WSP(float, WS_SSQQ), WSP(float, WS_SSQKV), WSP(float, WS_FLOG), WSP(float, WS_ROPE), WSP(bf16, WS_QF), WSP(bf16, WS_KF), WSP(bf16, WS_VF)}; \
            pg8::gemm_phase<pg8::EpiInproj, pg8::StaticOrder, true, true>(F.lds, g, S, E); } \
        SEAM(pb + 1); \
          \
        if (SEL(4) && IN(pb + 3)) { FRESH(); scan_phase(F, WSP(float, WS_FLOG), INP(11) + l * 8, WSP(bf16, WS_QF), WSP(bf16, WS_KF)); \
            { pg8::Gemm g{WSP(bf16, WS_CQN), WSP(bf16, WS_WUQ) + (size_t)l * 768 * 256, 256, 0, nullptr}; pg8::StaticOrder S; S.init(M, 768, F.G, (int)blockIdx.x); \
              pg8::EpiQ E{WSP(bf16, WS_QM), WSP(float, WS_ROPE), WSP(float, WS_SSQQ)}; pg8::gemm_phase<pg8::EpiQ, pg8::StaticOrder, true, true>(F.lds, g, S, E); } \
            { int kkv = 128; asm volatile("" : "+s"(kkv)); pg8::Gemm g{WSP(bf16, WS_CKVN), WSP(bf16, WS_WUKV) + (size_t)l * 1024 * 128, kkv, 0, nullptr}; pg8::StaticOrder S; S.init(M, 1024, F.G, (int)blockIdx.x); \
              pg8::EpiKV E{WSP(bf16, WS_KM), WSP(bf16, WS_VM), WSP(float, WS_SSQKV)}; pg8::gemm_phase<pg8::EpiKV, pg8::StaticOrder, true, true>(F.lds, g, S, E); } } \
        SEAM(pb + 3); \
          \
        if (SEL(5) && IN(pb + 4)) { \
            const int bh = F.vcu >> 2, s4 = F.vcu & 3, b = bh >> 3, h = bh & 7; \
            _Pragma("unroll 1") for (int i = 0; i < 4; ++i) { const int p = (i & 2) ? 7 - s4 : s4, qb = (i & 1) ? 15 - p : p; \
                att::attn_unit<96>(WSP(bf16, WS_QM), WSP(bf16, WS_KM), WSP(bf16, WS_VM), WSP(bf16, WS_O), WSP(float, WS_SSQO), b, h, qb, (char*)lds); } \
            _Pragma("unroll 1") for (int i = 0; i < 4; ++i) { const int p = (i & 2) ? 7 - s4 : s4, qb = (i & 1) ? 15 - p : p; \
                att::attn_unit<80>(WSP(bf16, WS_QF), WSP(bf16, WS_KF), WSP(bf16, WS_VF), WSP(bf16, WS_O) + 512, WSP(float, WS_SSQO) + 8, b, h, qb, (char*)lds); } } \
        SEAM(pb + 4); \
          \
        if (SEL(7) && IN(pb + 6)) { \
            pg8::Gemm g{WSP(bf16, WS_O), WSP(bf16, WS_WO) + (size_t)l * 1024 * 1024, 1024, 0, nullptr}; pg8::StaticOrder S; S.init(M, 1024, F.G, (int)blockIdx.x); \
            pg8::EpiWo E{WSP(bf16, WS_T1), WSP(float, WS_SSQO)}; \
            pg8::gemm_phase<pg8::EpiWo, pg8::StaticOrder, true, true>(F.lds, g, S, E); } \
        SEAM(pb + 6); \
    } while (0)

    LAYER_MIXER(0, PH_L0);
    if (SEL(8) && IN(PH_L0 + 7)) { FRESH(); norm_phase<false, true, true>(F, INP(0), INP(15), WSP(float, WS_MOD), 3, WSP(bf16, WS_XN8), nullptr, nullptr, nullptr, nullptr, WSP(bf16, WS_T1), WSP(float, WS_MOD) + 2 * 1024, X); }
    SEAM(PH_L0 + 7);
    if (SEL(9) && IN(PH_L0 + 8)) {
        pg8::Gemm g{WSP(bf16, WS_XN8), WSP(bf16, WS_WGU0), 512, 0, nullptr}; pg8::StaticOrder S; S.init(M, 2 * FF, F.G, (int)blockIdx.x);
        pg8::EpiSwigluF8 E{WSP(unsigned char, WS_H0)}; pg8::gemm_phase<pg8::EpiSwigluF8, pg8::StaticOrder, true, true, false, true>(F.lds, g, S, E);
    }
    SEAM(PH_L0 + 8);
    if (SEL(10) && IN(PH_L0 + 9)) {
        pg8::Gemm g{WSP(bf16, WS_H0), WSP(bf16, WS_WD0), FF / 2, 0, nullptr}; pg8::StaticOrder S; S.init(M, 1024, F.G, (int)blockIdx.x);
        pg8::EpiBf16Plain E{WSP(bf16, WS_T2), DM, 1.f / (SC_H * SC_WD)}; pg8::gemm_phase<pg8::EpiBf16Plain, pg8::StaticOrder, true, true, false, true>(F.lds, g, S, E);
    }
    SEAM(PH_L0 + 9);
    LAYER_MIXER(1, PH_L1);
    if (SEL(8) && IN(PH_L1 + 7)) { FRESH();
        norm_phase<true, true>(F, X, INP(15) + 1024, WSP(float, WS_MOD) + (size_t)8 * 6144, 3, WSP(bf16, WS_XN8), INP(19), WSP(int, WS_TOKE), WSP(float, WS_TOKW), WSP(unsigned, WS_CNT), WSP(bf16, WS_T1), WSP(float, WS_MOD) + (size_t)8 * 6144 + 2 * 1024, X);
#pragma unroll 1
        for (int e = 0; e < NE; ++e) {
            conv_matrix_wg<SrcGU, true>(F, SrcGU{INP(20) + (size_t)e * 1024 * FF, INP(21) + (size_t)e * 1024 * FF, FF}, 1024, 1024, 2 * FF, WSP(unsigned char, WS_WGU8) + (size_t)e * 2 * FF * 1024, SC_WGU);
            conv_matrix_wg<SrcPlain, true>(F, SrcPlain{INP(22) + (size_t)e * FF * 1024, 1024}, FF, FF, 1024, WSP(unsigned char, WS_WD8) + (size_t)e * 1024 * FF, SC_WD);
        }
    }
    SEAM(PH_L1 + 7);
    if (SEL(11) && IN(PH_MOE)) { FRESH(); route_phase(F, WSP(unsigned, WS_CNT), WSP(int, WS_TOKE), WSP(int, WS_ROWTOK), WSP(int, WS_TOKSLOT), WSP(int, WS_TEXP)); }
    SEAM(PH_MOE);
    if (SEL(11) && IN(PH_MOE + 1)) { const int* texp = WSP(int, WS_TEXP); const int ntile = __builtin_amdgcn_readfirstlane(texp[0]);
        pg8::Gemm g{WSP(bf16, WS_XN8), WSP(bf16, WS_WGU8), 512, (size_t)2 * FF * 1024, WSP(int, WS_ROWTOK)};
        pg8::MoeOrder S; S.init(ntile * 256, 2 * FF, F.G, (int)blockIdx.x); S.load(texp);
        pg8::EpiSwigluF8 E{WSP(unsigned char, WS_H8)}; pg8::gemm_phase<pg8::EpiSwigluF8, pg8::MoeOrder, true, true, true, true>(F.lds, g, S, E); }
    SEAM(PH_MOE + 1);
    if (SEL(12) && IN(PH_MOE + 2)) { const int* texp = WSP(int, WS_TEXP); const int ntile = __builtin_amdgcn_readfirstlane(texp[0]);
        pg8::Gemm g{(const bf16*)WSP(unsigned char, WS_H8), WSP(bf16, WS_WD8), FF / 2, (size_t)1024 * FF, nullptr};
        pg8::MoeOrderD S; S.init_d(ntile, FF / 128, F.G, (int)blockIdx.x); S.load(texp);
        pg8::EpiMoeY E{WSP(bf16, WS_Y), WSP(bf16, WS_YP), S.mainM * 256, (size_t)(ntile - S.mainM) * 256 * DM, 1.f / (SC_H * SC_WD)};
        pg8::gemm_phase<pg8::EpiMoeY, pg8::MoeOrderD, true, true, false, true, true>(F.lds, g, S, E); }
    SEAM(PH_MOE + 2);
    if (SEL(13) && IN(PH_FINAL)) { FRESH(); final_phase(F, X, INP(23), WSP(bf16, WS_Y), WSP(bf16, WS_YP), WSP(int, WS_TEXP), WSP(int, WS_TOKSLOT), WSP(float, WS_TOKW), WSP(float, WS_MOD) + (size_t)8 * 6144 + 5 * 1024); }
#undef IN
#undef SEAM
}

extern "C" void kernel_launch(void* const* d_in, const int* in_sizes, int n_in, void* d_out, int out_size, void* d_ws, size_t ws_size, hipStream_t stream) {
    static int grid = 0;
    if (grid == 0) {
        if (n_in != 24 || out_size != M * DM || ws_size < WS_END) { fprintf(stderr, "kernel_launch: unexpected shapes (n_in %d out %d ws %zu)\n", n_in, out_size, ws_size); grid = -1; return; }
        int dev = 0, cus = 0, per_cu = 0;
        if (hipGetDevice(&dev) != hipSuccess || hipDeviceGetAttribute(&cus, hipDeviceAttributeMultiprocessorCount, dev) != hipSuccess) { grid = -1; return; }
        if (hipFuncSetAttribute((const void*)fwd_kernel, hipFuncAttributeMaxDynamicSharedMemorySize, LDS_BYTES) != hipSuccess) { fprintf(stderr, "kernel_launch: hipFuncSetAttribute failed\n"); grid = -1; return; }
        if (hipOccupancyMaxActiveBlocksPerMultiprocessor(&per_cu, (const void*)fwd_kernel, NWAVES * 64, LDS_BYTES) != hipSuccess || per_cu < 1)
            fprintf(stderr, "kernel_launch: occupancy query reports %d\n", per_cu);
        (void)hipGetLastError();
        grid = cus;
        if (grid != 256) fprintf(stderr, "kernel_launch: %d CUs (built for 256)\n", grid);
    }
    if (grid < 0) return;
    (void)hipMemsetAsync((char*)d_ws + WS_CTL, 0, CTL_ZERO_BYTES, stream);
    Args a{};
    for (int i = 0; i < 24; ++i) a.in[i] = (const float*)d_in[i];
    a.out = (float*)d_out; a.ws = (unsigned char*)d_ws;
#if MK_ONE_LAUNCH
    a.ph_lo = 0; a.ph_hi = N_PHASES;
    hipLaunchKernelGGL(fwd_kernel, dim3(grid), dim3(NWAVES * 64), LDS_BYTES, stream, a);
#else
    for (int p = 0; p < N_PHASES; ++p) { a.ph_lo = p; a.ph_hi = p + 1; hipLaunchKernelGGL(fwd_kernel, dim3(grid), dim3(NWAVES * 64), LDS_BYTES, stream, a); }
#endif
}
```
